# Optimizing an MI355X kernel written in HIP

```python
import math
import jax, jax.numpy as jnp
from jax import lax
import numpy as np

D_MODEL = 2048
BATCH = 2
SEQ = 8192
DEPTH = 1

EPS = 1e-6
Q_BLOCK = 128

DA_HEADS = 8
DA_QK_DIM = 64
DA_V_DIM = 128

DL_GROUPS = ((128, 1), (512, 4), (2048, 16))
DL_N_GROUPS = 3
DL_HEADS_PER_GROUP = 4
DL_HEAD_DIM = 128

DA_Q_COLS = DA_HEADS * 2 * DA_QK_DIM
DA_K_COLS = DA_HEADS * 2 * DA_QK_DIM
DA_V_COLS = DA_HEADS * DA_V_DIM
DL_COLS = DL_N_GROUPS * DL_HEADS_PER_GROUP * DL_HEAD_DIM
GATE_COLS = D_MODEL
N_IN = DA_Q_COLS + DA_K_COLS + DA_V_COLS + 3 * DL_COLS + 2 * GATE_COLS
DA_OUT = DA_HEADS * DA_V_DIM
DL_OUT = DL_HEADS_PER_GROUP * DL_HEAD_DIM

MOE_GROUPS = 4
MOE_EXPERTS_PER_GROUP = 8
MOE_N_EXPERTS = MOE_GROUPS * MOE_EXPERTS_PER_GROUP
MOE_TOP_K = 2
MOE_D_FF = 1024
MOE_BLOCK = 128

kernel_name = "hybrid_diffattn_dilated_hiermoe_block"


def rmsnorm(t, gain):
    tf = t.astype(jnp.float32)
    tf = tf * lax.rsqrt(jnp.mean(tf * tf, axis=-1, keepdims=True) + EPS)
    return (tf * gain.astype(jnp.float32)).astype(t.dtype)


def alibi_slopes(n):
    return jnp.asarray(np.array([2.0 ** (-8.0 * (h + 1) / n) for h in range(n)], dtype=np.float32))


def diff_attention(q, k, v, lam, lam_init, sub_gain, slopes):
    B, S, H, _, dk = q.shape
    dv = v.shape[-1]
    nblk = S // Q_BLOCK
    scale = dk ** -0.5
    kpos = jnp.arange(S)
    qb = q.reshape(B, nblk, Q_BLOCK, H, 2, dk).transpose(1, 0, 2, 3, 4, 5)

    def block(args):
        i, qblk = args
        qpos = i * Q_BLOCK + jnp.arange(Q_BLOCK)
        dist = (qpos[:, None] - kpos[None, :]).astype(jnp.float32)
        s = jnp.einsum('bqhmd,bkhmd->bhmqk', qblk, k).astype(jnp.float32) * scale
        s = s - slopes[None, :, None, None, None] * dist
        s = jnp.where(dist >= 0, s, -jnp.inf)
        p = jax.nn.softmax(s, axis=-1)
        a = p[:, :, 0] - lam * p[:, :, 1]
        return jnp.einsum('bhqk,bkhd->bqhd', a.astype(v.dtype), v)

    o = lax.map(block, (jnp.arange(nblk), qb))
    o = o.transpose(1, 0, 2, 3, 4).reshape(B, S, H, dv)
    return rmsnorm(o, sub_gain) * (1.0 - lam_init)


def dilated_group(q, k, v, window, dilation, slopes):
    B, S, H, dh = q.shape
    span = window // dilation
    L = S // dilation
    nb = -(-L // span)
    Lp = nb * span

    def to_sub(t):
        t = t.reshape(B, L, dilation, H, dh).transpose(0, 2, 1, 3, 4)
        t = jnp.pad(t, ((0, 0), (0, 0), (0, Lp - L), (0, 0), (0, 0)))
        return t.reshape(B, dilation, nb, span, H, dh)

    def with_prev(t):
        prev = jnp.pad(t, ((0, 0), (0, 0), (1, 0), (0, 0), (0, 0), (0, 0)))[:, :, :-1]
        return jnp.concatenate([prev, t], axis=3)

    qs = to_sub(q)
    kc = with_prev(to_sub(k))
    vc = with_prev(to_sub(v))
    s = jnp.einsum('brnqhd,brnkhd->brnhqk', qs, kc).astype(jnp.float32) * (dh ** -0.5)
    qi = jnp.arange(span)
    kj = jnp.arange(2 * span)
    step = qi[:, None] + span - kj[None, :]
    blk = jnp.arange(nb)
    valid = (step >= 0) & (step <= span) & ((blk[:, None, None] * span - span + kj[None, None, :]) >= 0)
    s = s - slopes[:, None, None] * (dilation * step).astype(jnp.float32)
    s = jnp.where(valid[:, None], s, -jnp.inf)
    m = jnp.max(s, axis=-1, keepdims=True)
    p = jnp.exp(s - m)
    den = jnp.sum(p, axis=-1, keepdims=True)
    o = jnp.einsum('brnhqk,brnkhd->brnqhd', (p / den).astype(v.dtype), vc)
    lse = (m + jnp.log(den))[..., 0]
    o = o.reshape(B, dilation, Lp, H, dh)[:, :, :L].transpose(0, 2, 1, 3, 4).reshape(B, S, H, dh)
    lse = lse.transpose(0, 1, 2, 4, 3).reshape(B, dilation, Lp, H)[:, :, :L]
    lse = lse.transpose(0, 2, 1, 3).reshape(B, S, H)
    return o, lse


def hier_moe(h, w_group_router, w_expert_router, w_gate_up, w_down):
    B, S, D = h.shape
    T = B * S
    TK = T * MOE_TOP_K
    xt = h.reshape(T, D)
    g_prob = jax.nn.softmax((xt @ w_group_router).astype(jnp.float32), axis=-1)
    g_w, g_idx = lax.top_k(g_prob, 1)
    e_logits = (xt @ w_expert_router).astype(jnp.float32).reshape(T, MOE_GROUPS, MOE_EXPERTS_PER_GROUP)
    e_in_group = jnp.take_along_axis(e_logits, g_idx[:, :, None], axis=1)[:, 0]
    e_top, e_local = lax.top_k(e_in_group, MOE_TOP_K)
    e_w = jax.nn.softmax(e_top, axis=-1) * g_w
    e_idx = g_idx * MOE_EXPERTS_PER_GROUP + e_local

    flat_e = e_idx.reshape(-1)
    order = jnp.argsort(flat_e)
    sorted_e = flat_e[order]
    tok = order // MOE_TOP_K
    sizes = jnp.bincount(flat_e, length=MOE_N_EXPERTS).astype(jnp.int32)
    start = jnp.cumsum(sizes) - sizes
    padded = ((sizes + MOE_BLOCK - 1) // MOE_BLOCK) * MOE_BLOCK
    pad_end = jnp.cumsum(padded)
    pad_start = pad_end - padded
    dest = pad_start[sorted_e] + (jnp.arange(TK) - start[sorted_e])
    n_blocks = -(-TK // MOE_BLOCK) + MOE_N_EXPERTS
    x_pad = jnp.zeros((n_blocks * MOE_BLOCK, D), xt.dtype).at[dest].set(xt[tok])
    blk_expert = jnp.minimum(
        jnp.searchsorted(pad_end, jnp.arange(n_blocks) * MOE_BLOCK, side='right'),
        MOE_N_EXPERTS - 1)

    def expert_block(args):
        e, xb = args
        gate, up = jnp.split(xb @ w_gate_up[e], 2, axis=-1)
        return (jax.nn.silu(gate) * up) @ w_down[e]

    y_pad = lax.map(expert_block, (blk_expert, x_pad.reshape(n_blocks, MOE_BLOCK, D)))
    ys = y_pad.reshape(n_blocks * MOE_BLOCK, D)[dest]
    ys = ys * e_w.reshape(-1)[order][:, None].astype(ys.dtype)
    y = jnp.zeros_like(xt).at[tok].add(ys)
    return y.reshape(B, S, D)


def setup_inputs(seed: int = 0) -> dict:
    key = jax.random.key(seed)
    ks = jax.random.split(key, 20)
    f32 = jnp.float32

    def nrm(k, shape, scale):
        return jax.random.normal(k, shape, f32) * scale

    def gain(k, shape):
        return 1.0 + 0.05 * jax.random.normal(k, shape, f32)

    return {
        "x": jax.random.normal(ks[0], (BATCH, SEQ, D_MODEL), f32),
        "norm_mix": gain(ks[1], (DEPTH, D_MODEL)),
        "w_in": nrm(ks[2], (DEPTH, D_MODEL, N_IN), D_MODEL ** -0.5),
        "da_q_norm": gain(ks[3], (DEPTH, DA_QK_DIM)),
        "da_k_norm": gain(ks[4], (DEPTH, DA_QK_DIM)),
        "da_lambda_q": nrm(ks[5], (DEPTH, 2, DA_QK_DIM), 0.1),
        "da_lambda_k": nrm(ks[6], (DEPTH, 2, DA_QK_DIM), 0.1),
        "da_sub_norm": gain(ks[7], (DEPTH, DA_V_DIM)),
        "dl_q_norm": gain(ks[8], (DEPTH, DL_HEAD_DIM)),
        "dl_k_norm": gain(ks[9], (DEPTH, DL_HEAD_DIM)),
        "w_branch_a": nrm(ks[10], (DEPTH, DA_OUT, D_MODEL), DA_OUT ** -0.5),
        "w_branch_b": nrm(ks[11], (DEPTH, DL_OUT, D_MODEL), DL_OUT ** -0.5),
        "w_out": nrm(ks[12], (DEPTH, D_MODEL, D_MODEL), D_MODEL ** -0.5),
        "norm_ffn": gain(ks[13], (DEPTH, D_MODEL)),
        "w_group_router": nrm(ks[14], (DEPTH, D_MODEL, MOE_GROUPS), D_MODEL ** -0.5),
        "w_expert_router": nrm(ks[15], (DEPTH, D_MODEL, MOE_N_EXPERTS), D_MODEL ** -0.5),
        "w_gate_up": nrm(ks[16], (DEPTH, MOE_N_EXPERTS, D_MODEL, 2 * MOE_D_FF), D_MODEL ** -0.5),
        "w_down": nrm(ks[17], (DEPTH, MOE_N_EXPERTS, MOE_D_FF, D_MODEL), MOE_D_FF ** -0.5),
    }


def reference(x, norm_mix, w_in, da_q_norm, da_k_norm, da_lambda_q, da_lambda_k, da_sub_norm,
              dl_q_norm, dl_k_norm, w_branch_a, w_branch_b, w_out, norm_ffn,
              w_group_router, w_expert_router, w_gate_up, w_down):
    B, S, D = x.shape
    da_slopes = alibi_slopes(DA_HEADS)
    dl_slopes = alibi_slopes(DL_N_GROUPS * DL_HEADS_PER_GROUP)
    offs = np.cumsum([0, DA_Q_COLS, DA_K_COLS, DA_V_COLS, DL_COLS, DL_COLS, DL_COLS, GATE_COLS, GATE_COLS])

    for l in range(DEPTH):
        lam_init = 0.8 - 0.6 * math.exp(-0.3 * l)
        h = rmsnorm(x, norm_mix[l])
        proj = h @ w_in[l]
        cols = [proj[..., int(offs[i]):int(offs[i + 1])] for i in range(8)]
        da_q = rmsnorm(cols[0].reshape(B, S, DA_HEADS, 2, DA_QK_DIM), da_q_norm[l])
        da_k = rmsnorm(cols[1].reshape(B, S, DA_HEADS, 2, DA_QK_DIM), da_k_norm[l])
        da_v = cols[2].reshape(B, S, DA_HEADS, DA_V_DIM)
        dl_q = rmsnorm(cols[3].reshape(B, S, DL_N_GROUPS, DL_HEADS_PER_GROUP, DL_HEAD_DIM), dl_q_norm[l])
        dl_k = rmsnorm(cols[4].reshape(B, S, DL_N_GROUPS, DL_HEADS_PER_GROUP, DL_HEAD_DIM), dl_k_norm[l])
        dl_v = cols[5].reshape(B, S, DL_N_GROUPS, DL_HEADS_PER_GROUP, DL_HEAD_DIM)
        gate_a, gate_b = cols[6], cols[7]

        lq = da_lambda_q[l].astype(jnp.float32)
        lk = da_lambda_k[l].astype(jnp.float32)
        lam = jnp.exp(jnp.sum(lq[0] * lk[0])) - jnp.exp(jnp.sum(lq[1] * lk[1])) + lam_init
        o_a = diff_attention(da_q, da_k, da_v, lam, lam_init, da_sub_norm[l], da_slopes)
        o_a = o_a.reshape(B, S, DA_OUT)

        outs, lses = [], []
        for g, (window, dilation) in enumerate(DL_GROUPS):
            o_g, lse_g = dilated_group(dl_q[:, :, g], dl_k[:, :, g], dl_v[:, :, g], window, dilation,
                                       dl_slopes[g * DL_HEADS_PER_GROUP:(g + 1) * DL_HEADS_PER_GROUP])
            outs.append(o_g)
            lses.append(lse_g)
        w_grp = jax.nn.softmax(jnp.stack(lses, axis=0), axis=0)
        o_b = jnp.einsum('gbsh,gbshd->bshd', w_grp.astype(x.dtype), jnp.stack(outs, axis=0))
        o_b = o_b.reshape(B, S, DL_OUT)

        mixed = jax.nn.sigmoid(gate_a) * (o_a @ w_branch_a[l]) + jax.nn.sigmoid(gate_b) * (o_b @ w_branch_b[l])
        x = x + mixed @ w_out[l]

        x = x + hier_moe(rmsnorm(x, norm_ffn[l]), w_group_router[l], w_expert_router[l],
                         w_gate_up[l], w_down[l])
    return x
```

```cpp
#define MK_N_LAUNCHES 12
#include <hip/hip_runtime.h>
#include <cstdio>
#include <cstdint>
namespace pg8 {
#define PG8_LAS __attribute__((address_space(3)))
typedef unsigned short bf16_t;
typedef short bf16x8 __attribute__((ext_vector_type(8)));
typedef float f32x4 __attribute__((ext_vector_type(4)));
typedef unsigned u32x4 __attribute__((ext_vector_type(4)));
constexpr int BM = 256, BK = 64, HALF = 128, HTB = HALF * BK * 2  , STAGE_BYTES = 8 * HTB, NXCD = 8, WGM = 8;

__host__ __device__ __forceinline__ int lds_byte(int r, int c) { const int st = (r >> 4) * 2 + (c >> 5), rr = r & 15, cc = c & 31, ob = rr * 64 + cc * 2; return st * 1024 + (ob ^ (((ob >> 9) & 1) << 5)); }
__host__ __device__ __forceinline__ void stage_rc(int b, int& R, int& C) { const int st = b / 1024, sb = b % 1024, swz = sb ^ (((sb >> 9) & 1) << 5); R = (st >> 1) * 16 + swz / 64; C = (st & 1) * 32 + (swz % 64) / 2; }
__host__ __device__ __forceinline__ int perm32(int rho) { const int n = rho >> 4, i = rho & 15; return 8 * (i >> 2) + 4 * n + (i & 3); }

struct Unit { int pm, pn, e; };
struct Gemm { const bf16_t* A; const bf16_t* Bt; int M, N, K; size_t estride; };

struct StaticOrder {
    int nM, nN, nwg, G, c;
    __host__ __device__ void init(int M, int N, int G_, int c_) { nM = M / BM; nN = N / BM; nwg = nM * nN; G = G_; c = c_; }
    __host__ __device__ bool next(int i, Unit& u) const {
        const long L = (long)i * G + c; if (L >= nwg) return false;
        int wgid = (int)L; { const int q = nwg / NXCD, r = nwg % NXCD, xcd = wgid % NXCD, off = wgid / NXCD; wgid = (xcd < r ? xcd * (q + 1) : r * (q + 1) + (xcd - r) * q) + off; }
        const int nig = WGM * nN, gid = wgid / nig, fm = gid * WGM, gsz = (nM - fm) < WGM ? (nM - fm) : WGM;
        u.pm = fm + ((wgid % nig) % gsz); u.pn = (wgid % nig) / gsz; u.e = 0; return true;
    }
    __device__ __forceinline__ void a_ready(const Unit&) const {}
    __device__ __forceinline__ void done(const Unit&) const {}
};

__device__ __forceinline__ unsigned cvt_pk_bf16(float lo, float hi) { unsigned r; asm volatile("v_cvt_pk_bf16_f32 %0, %1, %2" : "=v"(r) : "v"(lo), "v"(hi)); return r; }
__device__ __forceinline__ float bf2f(unsigned short b) { return __uint_as_float((unsigned)b << 16); }
__device__ __forceinline__ void unpack8(const u32x4 w, float (&f)[8]) {
    f[0] = __uint_as_float(w.x << 16); f[1] = __uint_as_float(w.x & 0xffff0000u); f[2] = __uint_as_float(w.y << 16); f[3] = __uint_as_float(w.y & 0xffff0000u);
    f[4] = __uint_as_float(w.z << 16); f[5] = __uint_as_float(w.z & 0xffff0000u); f[6] = __uint_as_float(w.w << 16); f[7] = __uint_as_float(w.w & 0xffff0000u);
}
__device__ __forceinline__ u32x4 pack8(const f32x4 v0, const f32x4 v1) { u32x4 w; w.x = cvt_pk_bf16(v0[0], v0[1]); w.y = cvt_pk_bf16(v0[2], v0[3]); w.z = cvt_pk_bf16(v1[0], v1[1]); w.w = cvt_pk_bf16(v1[2], v1[3]); return w; }

struct EpiProj {
    static constexpr bool PERM = true, AFTER_DRAIN = false;
    bf16_t* O; int ldc;
    const float* gains;
    PG8_LAS float* xch;
    float c2_da, c2_dl, eps;
    __device__ __forceinline__ void operator()(const f32x4 (&acc)[2][2][4][2], const Unit& u, int wr, int wc, int fr, int fq) const {
        const int pn = u.pn;
        const int kind = (pn < 8) ? 1 : (pn < 12) ? 0 : (pn < 24) ? 2 : (pn < 30) ? 0 : 3;
        const int rowl0 = wr * 64 + fr;
        bf16_t* base = O + (size_t)(u.pm * BM + rowl0) * ldc + pn * BM + wc * 32 + 8 * fq;
        if (kind == 1 || kind == 2) {
#pragma unroll
            for (int ai = 0; ai < 2; ++ai)
#pragma unroll
                for (int m = 0; m < 4; ++m)
#pragma unroll
                    for (int bj = 0; bj < 2; ++bj) {
                        const f32x4 a = acc[ai][bj][m][0], b = acc[ai][bj][m][1];
                        float s = (a[0] * a[0] + a[1] * a[1]) + (a[2] * a[2] + a[3] * a[3]) + (b[0] * b[0] + b[1] * b[1]) + (b[2] * b[2] + b[3] * b[3]);
                        s += __shfl_xor(s, 16); s += __shfl_xor(s, 32);
                        if (fq == 0) xch[(ai * HALF + rowl0 + m * 16) * 8 + bj * 4 + wc] = s;
                    }
            asm volatile("s_waitcnt lgkmcnt(0)" ::: "memory"); __builtin_amdgcn_s_barrier(); asm volatile("" ::: "memory");
            const bool isq = (pn < 4) || (pn >= 12 && pn < 18);
            const int goff = (kind == 1) ? ((isq ? 0 : 64) + (wc & 1) * 32 + 8 * fq) : ((isq ? 128 : 256) + wc * 32 + 8 * fq);
            const float* gp = gains + goff;
            const f32x4 g0 = *(const f32x4*)gp, g1 = *(const f32x4*)(gp + 4);
            const float sc = isq ? (kind == 1 ? c2_da : c2_dl) : 1.0f;
            const float inv = (kind == 1) ? (1.0f / 64.0f) : (1.0f / 128.0f);
#pragma unroll
            for (int ai = 0; ai < 2; ++ai)
#pragma unroll
                for (int m = 0; m < 4; ++m) {
                    const PG8_LAS f32x4* xr = (const PG8_LAS f32x4*)(xch + (ai * HALF + rowl0 + m * 16) * 8);
#pragma unroll
                    for (int bj = 0; bj < 2; ++bj) {
                        const f32x4 t = xr[bj];
                        const float tot = (kind == 1) ? ((wc < 2) ? (t[0] + t[1]) : (t[2] + t[3])) : ((t[0] + t[1]) + (t[2] + t[3]));
                        const float rs = __builtin_amdgcn_rsqf(tot * inv + eps) * sc;
                        const f32x4 v0 = acc[ai][bj][m][0] * rs * g0, v1 = acc[ai][bj][m][1] * rs * g1;
                        *(u32x4*)(base + (size_t)(ai * HALF + m * 16) * ldc + bj * HALF) = pack8(v0, v1);
                    }
                }
        } else {
#pragma unroll
            for (int ai = 0; ai < 2; ++ai)
#pragma unroll
                for (int m = 0; m < 4; ++m)
#pragma unroll
                    for (int bj = 0; bj < 2; ++bj) {
                        f32x4 v0 = acc[ai][bj][m][0], v1 = acc[ai][bj][m][1];
                        if (kind == 3) {
#pragma unroll
                            for (int j = 0; j < 4; ++j) { v0[j] = __builtin_amdgcn_rcpf(1.0f + __builtin_amdgcn_exp2f(-1.4426950408889634f * v0[j])); v1[j] = __builtin_amdgcn_rcpf(1.0f + __builtin_amdgcn_exp2f(-1.4426950408889634f * v1[j])); }
                        }
                        *(u32x4*)(base + (size_t)(ai * HALF + m * 16) * ldc + bj * HALF) = pack8(v0, v1);
                    }
        }
    }
};

template <int ADD> struct EpiGate {
    static constexpr bool PERM = true, AFTER_DRAIN = false;
    bf16_t* MIX; int ldm; const bf16_t* G; int ldg;
    __device__ __forceinline__ void operator()(const f32x4 (&acc)[2][2][4][2], const Unit& u, int wr, int wc, int fr, int fq) const {
        const int row0 = u.pm * BM + wr * 64 + fr, col0 = u.pn * BM + wc * 32 + 8 * fq;
#pragma unroll
        for (int ai = 0; ai < 2; ++ai)
#pragma unroll
            for (int m = 0; m < 4; ++m) {
                const size_t r = (size_t)(row0 + ai * HALF + m * 16);
#pragma unroll
                for (int bj = 0; bj < 2; ++bj) {
                    float g[8]; unpack8(*(const u32x4*)(G + r * ldg + col0 + bj * HALF), g);
                    f32x4 v0 = acc[ai][bj][m][0], v1 = acc[ai][bj][m][1];
                    v0[0] *= g[0]; v0[1] *= g[1]; v0[2] *= g[2]; v0[3] *= g[3]; v1[0] *= g[4]; v1[1] *= g[5]; v1[2] *= g[6]; v1[3] *= g[7];
                    bf16_t* p = MIX + r * ldm + col0 + bj * HALF;
                    if (ADD) { float o[8]; unpack8(*(const u32x4*)p, o); v0[0] += o[0]; v0[1] += o[1]; v0[2] += o[2]; v0[3] += o[3]; v1[0] += o[4]; v1[1] += o[5]; v1[2] += o[6]; v1[3] += o[7]; }
                    *(u32x4*)p = pack8(v0, v1);
                }
            }
    }
};

struct EpiRes {
    static constexpr bool PERM = false, AFTER_DRAIN = false;
    const float* X; float* Out; int ldc;
    __device__ __forceinline__ void operator()(const f32x4 (&acc)[2][2][4][2], const Unit& u, int wr, int wc, int fr, int fq) const {
        const int row0 = u.pm * BM + wr * 64 + fr, col0 = u.pn * BM + wc * 32 + 4 * fq;
#pragma unroll
        for (int ai = 0; ai < 2; ++ai)
#pragma unroll
            for (int m = 0; m < 4; ++m) {
                const size_t off = (size_t)(row0 + ai * HALF + m * 16) * ldc + col0;
#pragma unroll
                for (int bj = 0; bj < 2; ++bj)
#pragma unroll
                    for (int n = 0; n < 2; ++n) { const f32x4 xv = *(const f32x4*)(X + off + bj * HALF + n * 16); *(f32x4*)(Out + off + bj * HALF + n * 16) = xv + acc[ai][bj][m][n]; }
            }
    }
};

struct EpiSwiglu {
    static constexpr bool PERM = true, AFTER_DRAIN = false;
    bf16_t* H; int ldh;
    __device__ __forceinline__ void operator()(const f32x4 (&acc)[2][2][4][2], const Unit& u, int wr, int wc, int fr, int fq) const {
        const int row0 = u.pm * BM + wr * 64 + fr, col0 = u.pn * HALF + wc * 32 + 8 * fq;
#pragma unroll
        for (int ai = 0; ai < 2; ++ai)
#pragma unroll
            for (int m = 0; m < 4; ++m) {
                f32x4 v[2];
#pragma unroll
                for (int n = 0; n < 2; ++n)
#pragma unroll
                    for (int j = 0; j < 4; ++j) { const float gt = acc[ai][0][m][n][j], up = acc[ai][1][m][n][j]; v[n][j] = gt * __builtin_amdgcn_rcpf(1.0f + __builtin_amdgcn_exp2f(-1.4426950408889634f * gt)) * up; }
                *(u32x4*)(H + (size_t)(row0 + ai * HALF + m * 16) * ldh + col0) = pack8(v[0], v[1]);
            }
    }
};

struct EpiPlain {
    static constexpr bool PERM = true, AFTER_DRAIN = false;
    bf16_t* O; int ldc;
    __device__ __forceinline__ void operator()(const f32x4 (&acc)[2][2][4][2], const Unit& u, int wr, int wc, int fr, int fq) const {
        const int row0 = u.pm * BM + wr * 64 + fr, col0 = u.pn * BM + wc * 32 + 8 * fq;
#pragma unroll
        for (int ai = 0; ai < 2; ++ai)
#pragma unroll
            for (int m = 0; m < 4; ++m)
#pragma unroll
                for (int bj = 0; bj < 2; ++bj) *(u32x4*)(O + (size_t)(row0 + ai * HALF + m * 16) * ldc + col0 + bj * HALF) = pack8(acc[ai][bj][m][0], acc[ai][bj][m][1]);
    }
};

struct GroupOrder {
    int nT, G, c; const PG8_LAS int* tile_e;
    __device__ __forceinline__ bool next(int i, Unit& u) const {
        const int L = i * G + c; if (L >= nT * 8) return false;
        const int wgid = (L & 7) * nT + (L >> 3);
        u.pm = wgid >> 3; u.pn = wgid & 7; u.e = __builtin_amdgcn_readfirstlane(tile_e[u.pm]); return true;
    }
    __device__ __forceinline__ void a_ready(const Unit&) const {}
    __device__ __forceinline__ void done(const Unit&) const {}
};
template <class Epi, class Sched, bool ALIGN_EPI = false, bool SP2 = false>
__device__ __forceinline__ void gemm_phase(PG8_LAS unsigned char* lds, const Gemm g, const Sched& S, const Epi& E) {
    const int tid = threadIdx.x, wid = __builtin_amdgcn_readfirstlane(tid >> 6), lane = tid & 63, wr = wid >> 2, wc = wid & 3, fr = lane & 15, fq = lane >> 4;
    const int K = g.K, nt = K / BK;
    unsigned voffA[2], voffB[2];
#pragma unroll
    for (int i = 0; i < 2; ++i) { int R, C; stage_rc(tid * 16 + i * 8192, R, C); const int Rb = Epi::PERM ? ((R & ~31) + perm32(R & 31)) : R;
        voffA[i] = (unsigned)(R * K + C) * 2u; voffB[i] = (unsigned)(Rb * K + C) * 2u; }
    const size_t kstep = (size_t)(BK * 2);
    const size_t hstep = (size_t)HALF * K * 2;
    const size_t tstep = 2 * hstep;
    const unsigned ldsw = (unsigned)wid * 1024u;
    const int aoff = lds_byte(wr * 64 + fr, fq * 8), boff = lds_byte(wc * 32 + fr, fq * 8);
#define PG8_SA(b, h) (((b) * 2 + (h)) * HTB)
#define PG8_SB(b, h) ((4 + (b) * 2 + (h)) * HTB)
#define PG8_STAGE(bufoff, gbase, voff) do { _Pragma("unroll") for (int _i = 0; _i < 2; ++_i) \
        __builtin_amdgcn_global_load_lds((const unsigned*)((const char*)(gbase) + (voff)[_i]), (PG8_LAS unsigned*)(lds + (bufoff) + ldsw + _i * 8192), 16, 0, 0); } while (0)
#define PG8_LDA(dst, b, h) do { _Pragma("unroll") for (int m = 0; m < 4; ++m) _Pragma("unroll") for (int k = 0; k < 2; ++k) dst[m][k] = *(const PG8_LAS bf16x8*)(lds + PG8_SA(b, h) + aoff + m * 2048 + k * 1024); } while (0)
#define PG8_LDB(dst, b, h) do { _Pragma("unroll") for (int n = 0; n < 2; ++n) _Pragma("unroll") for (int k = 0; k < 2; ++k) dst[n][k] = *(const PG8_LAS bf16x8*)(lds + PG8_SB(b, h) + boff + n * 2048 + k * 1024); } while (0)
#define PG8_MMA(ai, bj, At, Bt) do { __builtin_amdgcn_s_setprio(1); _Pragma("unroll") for (int m = 0; m < 4; ++m) _Pragma("unroll") for (int n = 0; n < 2; ++n) _Pragma("unroll") for (int k = 0; k < 2; ++k) \
        acc[ai][bj][m][n] = __builtin_amdgcn_mfma_f32_16x16x32_bf16(Bt[n][k], At[m][k], acc[ai][bj][m][n], 0, 0, 0); __builtin_amdgcn_s_setprio(0); } while (0)
#define PG8_WAIT_V(n) asm volatile("s_waitcnt vmcnt(" #n ")" ::: "memory")
#define PG8_WAIT_L(n) asm volatile("s_waitcnt lgkmcnt(" #n ")" ::: "memory")
#define PG8_BAR __builtin_amdgcn_s_barrier()
#define PG8_SCHED __builtin_amdgcn_sched_barrier(0)
    Unit cur, nxt; int ui = 0;
    if (!S.next(0, cur)) return;
    f32x4 acc[2][2][4][2];
#pragma unroll
    for (int a = 0; a < 2; ++a)
#pragma unroll
        for (int b = 0; b < 2; ++b)
#pragma unroll
            for (int m = 0; m < 4; ++m)
#pragma unroll
                for (int n = 0; n < 2; ++n) acc[a][b][m][n] = (f32x4){0.f, 0.f, 0.f, 0.f};
    bf16x8 At[4][2], B0[2][2], B1[2][2];
    const char* cA = (const char*)g.A + (size_t)cur.pm * tstep; const char* cB = (const char*)g.Bt + (size_t)cur.pn * tstep + (size_t)cur.e * g.estride;
    S.a_ready(cur);
    if constexpr (SP2) {
        PG8_STAGE(PG8_SB(0, 0), cB, voffB); PG8_STAGE(PG8_SB(0, 1), cB + hstep, voffB); PG8_STAGE(PG8_SA(0, 0), cA, voffA); PG8_STAGE(PG8_SA(0, 1), cA + hstep, voffA);
        if (wr == 1) PG8_BAR;
        PG8_WAIT_V(2); PG8_BAR;
        PG8_STAGE(PG8_SB(1, 0), cB + kstep, voffB); PG8_STAGE(PG8_SA(1, 0), cA + kstep, voffA); PG8_STAGE(PG8_SB(1, 1), cB + hstep + kstep, voffB);
        PG8_WAIT_V(6); PG8_BAR;
    } else {
        PG8_STAGE(PG8_SB(0, 0), cB, voffB); PG8_STAGE(PG8_SA(0, 0), cA, voffA); PG8_STAGE(PG8_SB(0, 1), cB + hstep, voffB); PG8_STAGE(PG8_SA(0, 1), cA + hstep, voffA);
        if (wr == 1) PG8_BAR;
        PG8_WAIT_V(4); PG8_BAR;
        PG8_STAGE(PG8_SB(1, 0), cB + kstep, voffB); PG8_STAGE(PG8_SA(1, 0), cA + kstep, voffA); PG8_STAGE(PG8_SB(1, 1), cB + hstep + kstep, voffB);
        PG8_WAIT_V(6); PG8_BAR;
    }
    for (;;) {
        const bool has_next = S.next(ui + 1, nxt);
        const char* nA = has_next ? (const char*)g.A + (size_t)nxt.pm * tstep : cA; const char* nB = has_next ? (const char*)g.Bt + (size_t)nxt.pn * tstep + (size_t)nxt.e * g.estride : cB;
        for (int t = 0; t < nt; t += 2) {
            const bool last = (t == nt - 2);
            const char* a1 = cA + (size_t)(t + 1) * kstep;
            const char* a2 = last ? nA : cA + (size_t)(t + 2) * kstep; const char* b2 = last ? nB : cB + (size_t)(t + 2) * kstep;
            const char* a3 = a2 + kstep; const char* b3 = b2 + kstep;
            if (last && has_next) S.a_ready(nxt);
            if constexpr (SP2) {
            PG8_LDB(B0, 0, 0); PG8_LDB(B1, 0, 1); PG8_SCHED; PG8_LDA(At, 0, 0); PG8_STAGE(PG8_SA(1, 1), a1 + hstep, voffA);
            PG8_WAIT_V(8); PG8_WAIT_L(0); PG8_BAR; PG8_MMA(0, 0, At, B0); PG8_MMA(0, 1, At, B1); PG8_BAR; PG8_SCHED;
            PG8_LDA(At, 0, 1); PG8_STAGE(PG8_SB(0, 0), b2, voffB); PG8_STAGE(PG8_SB(0, 1), b2 + hstep, voffB); PG8_STAGE(PG8_SA(0, 0), a2, voffA);
            PG8_WAIT_V(8); PG8_WAIT_L(0); PG8_BAR; PG8_MMA(1, 0, At, B0); PG8_MMA(1, 1, At, B1); PG8_BAR; PG8_SCHED;
            PG8_LDB(B0, 1, 0); PG8_LDB(B1, 1, 1); PG8_SCHED; PG8_LDA(At, 1, 0); PG8_STAGE(PG8_SA(0, 1), a2 + hstep, voffA);
            PG8_WAIT_V(8); PG8_WAIT_L(0); PG8_BAR; PG8_MMA(0, 0, At, B0); PG8_MMA(0, 1, At, B1); PG8_BAR; PG8_SCHED;
            PG8_LDA(At, 1, 1); PG8_STAGE(PG8_SB(1, 0), b3, voffB); PG8_STAGE(PG8_SB(1, 1), b3 + hstep, voffB); PG8_STAGE(PG8_SA(1, 0), a3, voffA);
            PG8_WAIT_V(8); PG8_WAIT_L(0); PG8_BAR; PG8_MMA(1, 0, At, B0); PG8_MMA(1, 1, At, B1); PG8_BAR; PG8_SCHED;
            } else {
            PG8_LDB(B0, 0, 0); PG8_SCHED; PG8_LDA(At, 0, 0); PG8_STAGE(PG8_SA(1, 1), a1 + hstep, voffA);
            PG8_WAIT_L(8); PG8_BAR; PG8_WAIT_L(0); PG8_MMA(0, 0, At, B0); PG8_BAR; PG8_SCHED;
            PG8_LDB(B1, 0, 1); PG8_STAGE(PG8_SB(0, 0), b2, voffB);
            PG8_BAR; PG8_WAIT_L(0); PG8_MMA(0, 1, At, B1); PG8_BAR;
            PG8_LDA(At, 0, 1); PG8_STAGE(PG8_SA(0, 0), a2, voffA);
            PG8_BAR; PG8_WAIT_L(0); PG8_MMA(1, 0, At, B0); PG8_BAR; PG8_SCHED;
            PG8_STAGE(PG8_SB(0, 1), b2 + hstep, voffB);
            PG8_WAIT_V(6); PG8_BAR; PG8_MMA(1, 1, At, B1); PG8_BAR;
            PG8_LDB(B0, 1, 0); PG8_SCHED; PG8_LDA(At, 1, 0); PG8_STAGE(PG8_SA(0, 1), a2 + hstep, voffA);
            PG8_WAIT_L(8); PG8_BAR; PG8_WAIT_L(0); PG8_MMA(0, 0, At, B0); PG8_BAR; PG8_SCHED;
            PG8_LDB(B1, 1, 1); PG8_STAGE(PG8_SB(1, 0), b3, voffB);
            PG8_BAR; PG8_WAIT_L(0); PG8_MMA(0, 1, At, B1); PG8_BAR;
            PG8_LDA(At, 1, 1); PG8_STAGE(PG8_SA(1, 0), a3, voffA);
            PG8_BAR; PG8_WAIT_L(0); PG8_MMA(1, 0, At, B0); PG8_BAR; PG8_SCHED;
            PG8_STAGE(PG8_SB(1, 1), b3 + hstep, voffB);
            PG8_WAIT_V(6); PG8_BAR; PG8_MMA(1, 1, At, B1); PG8_BAR;
            }
        }
        if constexpr (ALIGN_EPI) { if (wr == 0) PG8_BAR; }
        if constexpr (!Epi::AFTER_DRAIN) { E(acc, cur, wr, wc, fr, fq); S.done(cur); }
        if (!has_next) break;
#pragma unroll
        for (int a = 0; a < 2; ++a)
#pragma unroll
            for (int b = 0; b < 2; ++b)
#pragma unroll
                for (int m = 0; m < 4; ++m)
#pragma unroll
                    for (int n = 0; n < 2; ++n) acc[a][b][m][n] = (f32x4){0.f, 0.f, 0.f, 0.f};
        cur = nxt; cA = nA; cB = nB; ++ui;
        if constexpr (ALIGN_EPI) { if (wr == 1) PG8_BAR; }
    }
    PG8_WAIT_V(0);
    if constexpr (!ALIGN_EPI) { if (wr == 0) PG8_BAR; }
    PG8_BAR;
    if constexpr (Epi::AFTER_DRAIN) { E.fused(acc, cur, wr, wc, fr, fq, lds, wid, lane); S.done(cur); }
#undef PG8_SA
#undef PG8_SB
#undef PG8_STAGE
#undef PG8_LDA
#undef PG8_LDB
#undef PG8_MMA
#undef PG8_WAIT_V
#undef PG8_WAIT_L
#undef PG8_BAR
#undef PG8_SCHED
}
}
#include <cmath>
namespace att {
typedef unsigned short bf16_t;
typedef short bf16x8 __attribute__((ext_vector_type(8)));
typedef short s16x4 __attribute__((ext_vector_type(4)));
typedef short v4i16_t __attribute__((ext_vector_type(4)));
typedef float f32x16 __attribute__((ext_vector_type(16)));
typedef unsigned u32x4 __attribute__((ext_vector_type(4)));
#define ATT_LAS __attribute__((address_space(3)))
constexpr int SLOT = 16384, LDS_K = 0, LDS_V = 2 * SLOT, LDS_WS = 4 * SLOT, ATT_LDS_BYTES = LDS_WS + 8 * 256;
constexpr float THR = 8.0f;
__device__ __forceinline__ int crow(int r, int hi) { return (r & 3) + 8 * (r >> 2) + 4 * hi; }
__device__ __forceinline__ void glds16(const void* gsrc, unsigned lds_dst) { unsigned keep;
    asm volatile("s_mov_b32 %0, m0\n\ts_mov_b32 m0, %2\n\ts_nop 0\n\tglobal_load_lds_dwordx4 %1, off\n\ts_mov_b32 m0, %0" : "=&s"(keep) : "v"(gsrc), "s"(lds_dst) : "memory"); }
typedef float f32x2_t __attribute__((ext_vector_type(2))); typedef __bf16 bf16x2_t __attribute__((ext_vector_type(2)));
__device__ __forceinline__ unsigned cvtpk(float lo, float hi) { f32x2_t v = {lo, hi}; bf16x2_t b = __builtin_convertvector(v, bf16x2_t); return __builtin_bit_cast(unsigned, b); }
__device__ __forceinline__ s16x4 vtr(ATT_LAS const char* p) { return __builtin_bit_cast(s16x4, __builtin_amdgcn_ds_read_tr16_b64_v4i16((ATT_LAS v4i16_t*)p)); }
__device__ __forceinline__ float swapmax(float m) { auto rr = __builtin_amdgcn_permlane32_swap(__float_as_uint(m), __float_as_uint(m), false, false); return fmaxf(__uint_as_float(rr[0]), __uint_as_float(rr[1])); }
__device__ __forceinline__ float swapsum(float m) { auto rr = __builtin_amdgcn_permlane32_swap(__float_as_uint(m), __float_as_uint(m), false, false); return __uint_as_float(rr[0]) + __uint_as_float(rr[1]); }

template <int DK>
__device__ __forceinline__ void attn_unit(const bf16_t* Qp, const bf16_t* Kp, const bf16_t* Vp, long rstride, int i0, int t_lo, int t_hi, int win, float slope2,
                                          bf16_t* Op, long ostride, float* lsep, long lstride, ATT_LAS unsigned char* lds) {
    constexpr int NKS = DK / 16;
    constexpr int NKW = DK / 64;
    const int tid = threadIdx.x, lane = tid & 63, r32 = lane & 31, hi = lane >> 5; const int wid = __builtin_amdgcn_readfirstlane(tid >> 6);
    const int qrow = i0 + 32 * wid + r32;
    const unsigned lds0 = (unsigned)(uintptr_t)lds;
    ATT_LAS float* wsf = (ATT_LAS float*)(lds + LDS_WS) + wid * 64;
    const bf16_t* ksrc[NKW]; const bf16_t* vsrc[2];
#pragma unroll
    for (int i = 0; i < NKW; ++i) ksrc[i] = Kp + (long)lane * rstride + (wid + 8 * i) * 8;
#pragma unroll
    for (int i = 0; i < 2; ++i) { const int p = wid + 8 * i; vsrc[i] = Vp + (long)(16 * (p & 3) + (lane >> 2)) * rstride + (p >> 2) * 32 + (lane & 3) * 8; }
    const long tstride = 64 * rstride;
#define ATT_DMA(t, slot) do { \
        _Pragma("unroll") for (int i_ = 0; i_ < NKW; ++i_) glds16(ksrc[i_] + (long)(t) * tstride, (unsigned)__builtin_amdgcn_readfirstlane(lds0 + LDS_K + (slot) * SLOT + (wid + 8 * i_) * 1024)); \
        _Pragma("unroll") for (int i_ = 0; i_ < 2; ++i_)   glds16(vsrc[i_] + (long)(t) * tstride, (unsigned)__builtin_amdgcn_readfirstlane(lds0 + LDS_V + (slot) * SLOT + (wid + 8 * i_) * 1024)); } while (0)
    ATT_DMA(t_lo, 0);
    bf16x8 qr[NKS];
#pragma unroll
    for (int d0 = 0; d0 < NKS; ++d0) qr[d0] = *reinterpret_cast<const bf16x8*>(Qp + (long)qrow * rstride + d0 * 16 + hi * 8);
    float m_run = -1e30f, l_run = 0.f;
    f32x16 o[4];
#pragma unroll
    for (int d = 0; d < 4; ++d)
#pragma unroll
        for (int r = 0; r < 16; ++r) o[d][r] = 0.f;
    ATT_LAS const char* kp0 = (ATT_LAS const char*)(lds + LDS_K) + hi * 1024 + r32 * 16;
    ATT_LAS const char* vp0 = (ATT_LAS const char*)(lds + LDS_V) + ((lane >> 4) & 1) * 32 + (lane & 3) * 8 + (4 * hi + ((lane & 15) >> 2)) * 64;
    for (int t = t_lo; t < t_hi; ++t) {
        const int slot = (t - t_lo) & 1;
        asm volatile("s_waitcnt vmcnt(0) lgkmcnt(0)\n\ts_barrier" ::: "memory");
        if (t + 1 < t_hi) ATT_DMA(t + 1, slot ^ 1);
        f32x16 p0, p1;
        { const float tb = slope2 * (float)(64 * t + 4 * hi - i0), s32 = 32.f * slope2;
#pragma unroll
          for (int r = 0; r < 16; ++r) { p0[r] = tb + slope2 * (float)((r & 3) + 8 * (r >> 2)); p1[r] = p0[r] + s32; } }
        { ATT_LAS const char* kp = kp0 + slot * SLOT;
#pragma unroll
          for (int d0 = 0; d0 < NKS; ++d0) {
              const bf16x8 b0 = *(ATT_LAS const bf16x8*)(kp + d0 * 2048), b1 = *(ATT_LAS const bf16x8*)(kp + d0 * 2048 + 512);
              p0 = __builtin_amdgcn_mfma_f32_32x32x16_bf16(b0, qr[d0], p0, 0, 0, 0); p1 = __builtin_amdgcn_mfma_f32_32x32x16_bf16(b1, qr[d0], p1, 0, 0, 0); } }
        if (64 * t + 63 > i0 || 64 * t < i0 + 255 - win) {
            const int kb = 64 * t + 4 * hi, lo = qrow - win;
#pragma unroll
            for (int r = 0; r < 16; ++r) { const int kv = kb + (r & 3) + 8 * (r >> 2);
                if (kv > qrow || kv < lo) p0[r] = -INFINITY; if (kv + 32 > qrow || kv + 32 < lo) p1[r] = -INFINITY; }
        }
        float rm = fmaxf(p0[0], p1[0]);
#pragma unroll
        for (int r = 1; r < 16; ++r) rm = fmaxf(rm, fmaxf(p0[r], p1[r]));
        rm = swapmax(rm);
        if (__any(rm > m_run + THR)) {
            const float mn = fmaxf(m_run, rm), alpha = __builtin_amdgcn_exp2f(m_run - mn);
            m_run = mn; l_run *= alpha;
            if (hi == 0) wsf[r32] = alpha;
#pragma unroll
            for (int r = 0; r < 16; ++r) { const float a = wsf[crow(r, hi)];
#pragma unroll
                for (int d = 0; d < 4; ++d) o[d][r] *= a; }
        }
        float sacc = 0.f;
#pragma unroll
        for (int r = 0; r < 16; ++r) { p0[r] = __builtin_amdgcn_exp2f(p0[r] - m_run); p1[r] = __builtin_amdgcn_exp2f(p1[r] - m_run); sacc += p0[r] + p1[r]; }
        l_run += sacc;
        bf16x8 pa[4];
        { u32x4 w;
          w.x = cvtpk(p0[0], p0[1]); w.y = cvtpk(p0[2], p0[3]); w.z = cvtpk(p0[4], p0[5]); w.w = cvtpk(p0[6], p0[7]); pa[0] = __builtin_bit_cast(bf16x8, w);
          w.x = cvtpk(p0[8], p0[9]); w.y = cvtpk(p0[10], p0[11]); w.z = cvtpk(p0[12], p0[13]); w.w = cvtpk(p0[14], p0[15]); pa[1] = __builtin_bit_cast(bf16x8, w);
          w.x = cvtpk(p1[0], p1[1]); w.y = cvtpk(p1[2], p1[3]); w.z = cvtpk(p1[4], p1[5]); w.w = cvtpk(p1[6], p1[7]); pa[2] = __builtin_bit_cast(bf16x8, w);
          w.x = cvtpk(p1[8], p1[9]); w.y = cvtpk(p1[10], p1[11]); w.z = cvtpk(p1[12], p1[13]); w.w = cvtpk(p1[14], p1[15]); pa[3] = __builtin_bit_cast(bf16x8, w); }
        { ATT_LAS const char* vp = vp0 + slot * SLOT;
#pragma unroll
          for (int d0 = 0; d0 < 4; ++d0)
#pragma unroll
              for (int ks = 0; ks < 4; ++ks) {
                  const s16x4 lo = vtr(vp + d0 * 4096 + ks * 1024), hv = vtr(vp + d0 * 4096 + ks * 1024 + 512);
                  const bf16x8 vf = (bf16x8){lo[0], lo[1], lo[2], lo[3], hv[0], hv[1], hv[2], hv[3]};
                  o[d0] = __builtin_amdgcn_mfma_f32_32x32x16_bf16(pa[ks], vf, o[d0], 0, 0, 0); } }
    }
#undef ATT_DMA
    const float l_tot = swapsum(l_run);
    if (hi == 0) wsf[32 + r32] = l_tot;
    if (lsep != nullptr && hi == 0) lsep[(long)qrow * lstride] = m_run + __builtin_amdgcn_logf(l_tot) - slope2 * (float)(qrow - i0);
    asm volatile("s_waitcnt vmcnt(0) lgkmcnt(0)\n\ts_barrier" ::: "memory");
    {
        ATT_LAS unsigned short* stg = (ATT_LAS unsigned short*)(lds + wid * 8192);
#pragma unroll
        for (int r = 0; r < 16; ++r) { const int orow = crow(r, hi); const float rl = __builtin_amdgcn_rcpf(wsf[32 + orow]);
#pragma unroll
            for (int d0 = 0; d0 < 4; ++d0) stg[orow * 128 + d0 * 32 + r32] = (unsigned short)(cvtpk(o[d0][r] * rl, 0.f) & 0xffffu); }
        asm volatile("s_waitcnt lgkmcnt(0)" ::: "memory");
        bf16_t* Ow = Op + (long)(i0 + 32 * wid) * ostride;
#pragma unroll
        for (int i = 0; i < 8; ++i) { const int row = i * 4 + (lane >> 4), ch = lane & 15; const u32x4 v = *(ATT_LAS const u32x4*)(stg + row * 128 + ch * 8); *(u32x4*)(Ow + (long)row * ostride + ch * 8) = v; }
    }
    asm volatile("s_waitcnt lgkmcnt(0)\n\ts_barrier" ::: "memory");
}
}
constexpr int NWAVES = 8;
constexpr int BATCH = 2, SEQ = 8192, DM = 2048, M = BATCH * SEQ;
constexpr int NIN = 11776;
constexpr int C_DAQ = 0, C_DAK = 1024, C_DAV = 2048, C_DLQ = 3072, C_DLK = 4608, C_DLV = 6144, C_GA = 7680, C_GB = 9728;
constexpr int NE = 32, DFF = 1024, TK = 2 * M;
constexpr int XS_ROWS = TK + NE * 256;
constexpr float EPS = 1e-6f, LOG2E = 1.4426950408889634f;
constexpr float LAM_INIT = 0.2f;

#ifndef MK_N_LAUNCHES
#define MK_N_LAUNCHES 1
#endif
constexpr int N_PHASES = 12;

constexpr size_t MiB = 1u << 20;
constexpr size_t WS_CTL = 0, CTL_ZERO_BYTES = 256 * 1024;
constexpr size_t WS_WR   = 1 * MiB;
constexpr size_t WS_GAIN = 1 * MiB + 512 * 1024;
constexpr size_t WS_ROUTE = 2 * MiB;
constexpr size_t WS_LSE  = 3 * MiB;
constexpr size_t WS_WIN  = 4 * MiB;
constexpr size_t WS_WA   = 50 * MiB;
constexpr size_t WS_WB   = 54 * MiB;
constexpr size_t WS_WO   = 56 * MiB;
constexpr size_t WS_WGU  = 64 * MiB;
constexpr size_t WS_WD   = 320 * MiB;
constexpr size_t WS_XN   = 448 * MiB;
constexpr size_t WS_ODA  = 512 * MiB;
constexpr size_t WS_ODL  = 576 * MiB;
constexpr size_t WS_OA   = 624 * MiB;
constexpr size_t WS_OB   = 656 * MiB;
constexpr size_t WS_MIX  = 672 * MiB;
constexpr size_t WS_PROJ = 736 * MiB;
constexpr size_t WS_XS   = WS_PROJ;
constexpr size_t WS_HB   = WS_PROJ + 160 * MiB;
constexpr size_t WS_END  = WS_PROJ + 368 * MiB;
static_assert((size_t)XS_ROWS * 2048 * 2 <= 160 * MiB && (size_t)XS_ROWS * 1024 * 2 <= 80 * MiB && (size_t)M * NIN * 2 <= 368 * MiB, "ws map");
constexpr int CW_TMO = 0, CW_CODE = 1;
constexpr int CW_BAR = 4096;
constexpr int CW_CNT = 16384, CW_FILL = 16384 + 64;
constexpr int CW_DBG = 20480;

constexpr int RING_OFF = 0, RING_BYTES = 131072;
constexpr int LDSCTL_OFF = RING_BYTES, MISC_OFF = LDSCTL_OFF + 320;
constexpr int TILE_E_OFF = LDSCTL_OFF + 1024;
constexpr int XCH_OFF = LDSCTL_OFF + 2048;
constexpr int LDS_BYTES = 147456;
static_assert(XCH_OFF + 8192 <= LDS_BYTES && att::ATT_LDS_BYTES <= RING_BYTES, "LDS map");

#define GAS __attribute__((address_space(1)))
#define LAS __attribute__((address_space(3)))
typedef unsigned short bf16;
typedef unsigned v4u __attribute__((ext_vector_type(4)));
typedef float f32x4 __attribute__((ext_vector_type(4)));
typedef short bf16x8 __attribute__((ext_vector_type(8)));
typedef GAS unsigned gu32;
typedef GAS unsigned long long gu64;
#define RLX_AGENT __ATOMIC_RELAXED, __HIP_MEMORY_SCOPE_AGENT
#define LDS_WAIT() asm volatile("s_waitcnt lgkmcnt(0)" ::: "memory")
#define VM_WAIT() asm volatile("s_waitcnt vmcnt(0)" ::: "memory")
__device__ __forceinline__ unsigned long long rt() { return __builtin_amdgcn_s_memrealtime(); }
__device__ __forceinline__ unsigned f2bf(float f) { unsigned u = __builtin_bit_cast(unsigned, f); return (u + 0x7fffu + ((u >> 16) & 1u)) >> 16; }
__device__ __forceinline__ unsigned pk2(float lo, float hi) { return f2bf(lo) | (f2bf(hi) << 16); }

#define XB_TMO      128
#define XB_XCNT(j)  (256  + 64 * (j))
#define XB_XSUB(j)  (1280 + 64 * (j))
#define XB_XGEN(j)  (2304 + 64 * (j))
#define XB_TOP      3328
#define XB_TOPGEN   3392
#define XCD_BAR_WORDS 3456
#define XB_SPIN_CAP (1u << 18)

__device__ __forceinline__ unsigned xb_ld(unsigned* p)              { return __hip_atomic_load(p, __ATOMIC_RELAXED, __HIP_MEMORY_SCOPE_AGENT); }
__device__ __forceinline__ unsigned xb_add(unsigned* p, unsigned v) { return __hip_atomic_fetch_add(p, v, __ATOMIC_RELAXED, __HIP_MEMORY_SCOPE_AGENT); }
__device__ __forceinline__ unsigned xb_xcc_id() { return (unsigned)__builtin_amdgcn_s_getreg((3 << 11) | 20) & 0xFu; }
#define XB_SPIN(cond, bar) do { unsigned _sp = 0; while (cond) { __builtin_amdgcn_s_sleep(1); \
    if ((++_sp & 255u) == 0u) { if (xb_ld(&(bar)[XB_TMO])) break; if (_sp > XB_SPIN_CAP) { atomicAdd(&(bar)[XB_TMO], 1u); break; } } } } while (0)

struct XcdBarrier {
    unsigned* bar; unsigned x;
    volatile LAS unsigned* st;
};

__device__ __forceinline__ XcdBarrier xcd_barrier_post(unsigned* bar, volatile LAS unsigned* st) {
    XcdBarrier b; b.bar = bar; b.x = xb_xcc_id(); b.st = st;
    if (threadIdx.x == 0) (void)xb_add(&bar[XB_XCNT(b.x)], 1u);
    return b;
}
__device__ __forceinline__ void xcd_barrier_complete(unsigned* bar, unsigned x, unsigned& nloc, unsigned& nx) {
    const unsigned G = gridDim.x * gridDim.y * gridDim.z;
    unsigned sum, cnt, mine, sp = 0u;
    for (;;) {
        sum = 0u; cnt = 0u; mine = 0u;
#pragma unroll
        for (unsigned j = 0; j < 16; ++j) { const unsigned c = xb_ld(&bar[XB_XCNT(j)]); sum += c; cnt += (c > 0u) ? 1u : 0u; mine = (j == x) ? c : mine; }
        if (sum == G) break;
        __builtin_amdgcn_s_sleep(1);
        if ((++sp & 255u) == 0u) { if (xb_ld(&bar[XB_TMO])) break; if (sp > XB_SPIN_CAP) { atomicAdd(&bar[XB_TMO], 1u); break; } }
    }
    nloc = mine > 0u ? mine : 1u; nx = cnt > 0u ? cnt : 1u;
}

__device__ __forceinline__ void xcd_barrier(const XcdBarrier& b) {
    asm volatile("s_waitcnt vmcnt(0)" ::: "memory");
    __syncthreads();
    if (threadIdx.x == 0) {
        unsigned* bar = b.bar;
        __builtin_amdgcn_s_waitcnt(0);
        unsigned nloc = b.st[0], nx = b.st[1];
        if (nloc == 0u) { xcd_barrier_complete(bar, b.x, nloc, nx); b.st[0] = nloc; b.st[1] = nx; }
        const unsigned old = xb_add(&bar[XB_XSUB(b.x)], 1u);
        const unsigned gen = old / nloc;
        if (old + 1u == (gen + 1u) * nloc) {
            __builtin_amdgcn_fence(__ATOMIC_RELEASE, "agent");
            asm volatile("s_waitcnt vmcnt(0)" ::: "memory");
            const unsigned og = xb_add(&bar[XB_TOP], 1u);
            const unsigned tg = og / nx;
            if (og + 1u == (tg + 1u) * nx) xb_add(&bar[XB_TOPGEN], 1u);
            else XB_SPIN(xb_ld(&bar[XB_TOPGEN]) == tg, bar);
            __builtin_amdgcn_fence(__ATOMIC_ACQUIRE, "agent");
            xb_add(&bar[XB_XGEN(b.x)], 1u);
            asm volatile("s_waitcnt vmcnt(0)" ::: "memory");
        } else {
            XB_SPIN(xb_ld(&bar[XB_XGEN(b.x)]) == gen, bar);
            __builtin_amdgcn_fence(__ATOMIC_ACQUIRE, "agent");
            asm volatile("s_waitcnt vmcnt(0)" ::: "memory");
        }
    }
    __syncthreads();
}
struct Frame {
    LAS unsigned char* lds;
    volatile LAS unsigned* MISC;
    gu32* ctl;
    int tid, lane, wave;
    int vcu, G;
    unsigned char* ws;
    const float *x, *norm_mix, *w_in, *da_qn, *da_kn, *da_lq, *da_lk, *da_sn, *dl_qn, *dl_kn, *w_a, *w_b, *w_out, *norm_ffn, *w_gr, *w_er, *w_gu, *w_dn;
    float* out;
};
__device__ __forceinline__ float wave_sum(float v) {
#pragma unroll
    for (int o = 1; o < 64; o <<= 1) v += __shfl_xor(v, o);
    return v;
}
__device__ __forceinline__ void p0_transpose_item(const float* W, int K, int N, bf16* WT, int k0, int n0, int dst_row0, LAS float* scr, int lane) {
#pragma unroll 8
    for (int i = 0; i < 32; ++i) { const int kk = 2 * i + (lane >> 5); scr[kk * 33 + (lane & 31)] = W[(size_t)(k0 + kk) * N + n0 + (lane & 31)]; }
    LDS_WAIT(); asm volatile("" ::: "memory");
    const int c = lane & 7;
#pragma unroll
    for (int j = 0; j < 4; ++j) { const int n = (lane >> 3) + 8 * j; const LAS float* s = scr + (8 * c) * 33 + n;
        v4u o; o.x = pk2(s[0 * 33], s[1 * 33]); o.y = pk2(s[2 * 33], s[3 * 33]); o.z = pk2(s[4 * 33], s[5 * 33]); o.w = pk2(s[6 * 33], s[7 * 33]);
        *(GAS v4u*)(WT + (size_t)(dst_row0 + n) * K + k0 + 8 * c) = o; }
    LDS_WAIT(); asm volatile("" ::: "memory");
}
__device__ __forceinline__ void p0_prologue(Frame& F) {
    LAS float* scr = (LAS float*)(F.lds + RING_OFF + F.wave * 16384);
    const int gw = F.vcu * NWAVES + F.wave, NGW = F.G * NWAVES;
    constexpr int I_IN = (DM / 64) * (NIN / 32), I_A = (1024 / 64) * (DM / 32), I_B = (512 / 64) * (DM / 32), I_O = (DM / 64) * (DM / 32);
    constexpr int I_GU1 = (DM / 64) * (2048 / 32), I_GU = NE * I_GU1, I_D1 = (DFF / 64) * (DM / 32), I_D = NE * I_D1;
    constexpr int NITEMS = I_IN + I_A + I_B + I_O + I_GU + I_D;
    bf16* WIN = (bf16*)(F.ws + WS_WIN); bf16* WA = (bf16*)(F.ws + WS_WA); bf16* WB = (bf16*)(F.ws + WS_WB); bf16* WO = (bf16*)(F.ws + WS_WO); bf16* WGU = (bf16*)(F.ws + WS_WGU); bf16* WD = (bf16*)(F.ws + WS_WD);
    for (int it = gw; it < NITEMS; it += NGW) {
        int r = it;
        if (r < I_IN) { const int nblk = NIN / 32, kb = r / nblk, nb = r % nblk; p0_transpose_item(F.w_in, DM, NIN, WIN, 64 * kb, 32 * nb, 32 * nb, scr, F.lane); continue; } r -= I_IN;
        if (r < I_A)  { const int nblk = DM / 32, kb = r / nblk, nb = r % nblk; p0_transpose_item(F.w_a, 1024, DM, WA, 64 * kb, 32 * nb, 32 * nb, scr, F.lane); continue; } r -= I_A;
        if (r < I_B)  { const int nblk = DM / 32, kb = r / nblk, nb = r % nblk; p0_transpose_item(F.w_b, 512, DM, WB, 64 * kb, 32 * nb, 32 * nb, scr, F.lane); continue; } r -= I_B;
        if (r < I_O)  { const int nblk = DM / 32, kb = r / nblk, nb = r % nblk; p0_transpose_item(F.w_out, DM, DM, WO, 64 * kb, 32 * nb, 32 * nb, scr, F.lane); continue; } r -= I_O;
        if (r < I_GU) { const int e = r / I_GU1, q = r % I_GU1, nblk = 2048 / 32, kb = q / nblk, nb = q % nblk, n0 = 32 * nb, j = n0 & 1023, up = n0 >> 10;
                        p0_transpose_item(F.w_gu + (size_t)e * DM * 2048, DM, 2048, WGU + (size_t)e * 2048 * DM, 64 * kb, n0, 256 * (j >> 7) + 128 * up + (j & 127), scr, F.lane); continue; } r -= I_GU;
        { const int e = r / I_D1, q = r % I_D1, nblk = DM / 32, kb = q / nblk, nb = q % nblk;
          p0_transpose_item(F.w_dn + (size_t)e * DFF * DM, DFF, DM, WD + (size_t)e * DM * DFF, 64 * kb, 32 * nb, 32 * nb, scr, F.lane); }
    }
    bf16* XN = (bf16*)(F.ws + WS_XN);
    {
        f32x4 g[8];
#pragma unroll
        for (int j = 0; j < 8; ++j) g[j] = *((const GAS f32x4*)F.norm_mix + F.lane + 64 * j);
        for (int m = gw; m < M; m += NGW) {
            const GAS f32x4* xr = (const GAS f32x4*)(F.x + (size_t)m * DM) + F.lane;
            f32x4 v[8]; float s = 0.f;
#pragma unroll
            for (int j = 0; j < 8; ++j) { v[j] = xr[64 * j]; s += (v[j].x * v[j].x + v[j].y * v[j].y) + (v[j].z * v[j].z + v[j].w * v[j].w); }
            const float rstd = 1.0f / sqrtf(wave_sum(s) * (1.f / DM) + EPS);
            GAS unsigned long long* o8 = (GAS unsigned long long*)(XN + (size_t)m * DM) + F.lane;
#pragma unroll
            for (int j = 0; j < 8; ++j) { const f32x4 t = v[j] * rstd * g[j]; o8[64 * j] = (unsigned long long)pk2(t.x, t.y) | ((unsigned long long)pk2(t.z, t.w) << 32); }
        }
    }
    if (F.vcu == 0 && F.tid < 384) { float* GN = (float*)(F.ws + WS_GAIN); const int t = F.tid; GN[t] = (t < 64) ? F.da_qn[t] : (t < 128) ? F.da_kn[t - 64] : (t < 256) ? F.dl_qn[t - 128] : F.dl_kn[t - 256]; }
    { float* WR = (float*)(F.ws + WS_WR);
      for (int i = (F.vcu * NWAVES * 64) + F.tid; i < DM * 48; i += F.G * NWAVES * 64) { const int k = i / 48, c = i % 48; const float gn = F.norm_ffn[k];
          WR[i] = (c < 32) ? F.w_er[k * 32 + c] * gn : (c < 36) ? F.w_gr[k * 4 + (c - 32)] * gn : 0.f; } }
}
__device__ __forceinline__ void p2_attention(Frame& F) {
    const bf16* PROJ = (const bf16*)(F.ws + WS_PROJ);
    bf16* ODA = (bf16*)(F.ws + WS_ODA); bf16* ODL = (bf16*)(F.ws + WS_ODL); float* LSE = (float*)(F.ws + WS_LSE);
    if (F.G == 256) {
        const int bhm = F.vcu >> 3, s = F.vcu & 7, b = bhm >> 4, h = (bhm >> 1) & 7, mp = bhm & 1;
        const bf16* base = PROJ + (size_t)b * SEQ * NIN;
        const float slope2 = exp2f(-(float)(h + 1)) * LOG2E;
        for (int i = 0; i < 4; ++i) {
            const int qb = (i == 0) ? 31 - s : (i == 1) ? 16 + s : (i == 2) ? 15 - s : s;
            att::attn_unit<64>(base + C_DAQ + h * 128 + mp * 64, base + C_DAK + h * 128 + mp * 64, base + C_DAV + h * 128, (long)NIN, 256 * qb, 0, 4 * (qb + 1), 1 << 30, slope2,
                               ODA + (size_t)mp * M * 1024 + (size_t)b * SEQ * 1024 + h * 128, 1024L, nullptr, 0L, F.lds + RING_OFF);
        }
    }
    for (int u = F.vcu; u < 768; u += F.G) {
        const int b = u / 384, rem = u % 384, g = rem / 128, rem2 = rem % 128, h = rem2 / 32, j = rem2 % 32;
        const int d = (g == 0) ? 1 : (g == 1) ? 4 : 16, nblk = 32 / d, r = j / nblk, iblk = j % nblk, hh = g * 4 + h;
        const bf16* base = PROJ + ((size_t)b * SEQ + r) * NIN + hh * 128;
        const float slope2 = exp2f(-8.0f * (float)(hh + 1) / 12.0f) * (float)d * LOG2E;
        att::attn_unit<128>(base + C_DLQ, base + C_DLK, base + C_DLV, (long)NIN * d, 256 * iblk, (4 * iblk - 2 < 0) ? 0 : 4 * iblk - 2, 4 * iblk + 4, 128, slope2,
                            ODL + (size_t)g * M * 512 + ((size_t)b * SEQ + r) * 512 + h * 128, 512L * d, LSE + (size_t)g * M * 4 + ((size_t)b * SEQ + r) * 4 + h, 4L * d, F.lds + RING_OFF);
    }
}
__device__ __forceinline__ void p3_merge(Frame& F) {
    const int gw = F.vcu * NWAVES + F.wave, NGW = F.G * NWAVES, lane = F.lane;
    const bf16* ODA = (const bf16*)(F.ws + WS_ODA); const bf16* ODL = (const bf16*)(F.ws + WS_ODL); const float* LSE = (const float*)(F.ws + WS_LSE);
    bf16* OA = (bf16*)(F.ws + WS_OA); bf16* OB = (bf16*)(F.ws + WS_OB);
    const float s0 = wave_sum(F.da_lq[lane] * F.da_lk[lane]), s1 = wave_sum(F.da_lq[64 + lane] * F.da_lk[64 + lane]);
    const float lam = expf(s0) - expf(s1) + LAM_INIT;
    float sg[16];
#pragma unroll
    for (int j = 0; j < 16; ++j) sg[j] = F.da_sn[(lane & 7) * 16 + j] * (1.0f - LAM_INIT);
    for (int m = gw; m < M; m += NGW) {
        {
            const v4u* p0 = (const v4u*)(ODA + (size_t)m * 1024 + lane * 16); const v4u* p1 = (const v4u*)(ODA + (size_t)M * 1024 + (size_t)m * 1024 + lane * 16);
            float a[16], b[16]; pg8::unpack8(p0[0], *(float(*)[8])&a[0]); pg8::unpack8(p0[1], *(float(*)[8])&a[8]); pg8::unpack8(p1[0], *(float(*)[8])&b[0]); pg8::unpack8(p1[1], *(float(*)[8])&b[8]);
            float ss = 0.f;
#pragma unroll
            for (int j = 0; j < 16; ++j) { a[j] = a[j] - lam * b[j]; ss += a[j] * a[j]; }
            ss += __shfl_xor(ss, 1); ss += __shfl_xor(ss, 2); ss += __shfl_xor(ss, 4);
            const float rstd = 1.0f / sqrtf(ss * (1.f / 128.f) + EPS);
            v4u o0, o1;
            o0.x = pk2(a[0] * rstd * sg[0], a[1] * rstd * sg[1]); o0.y = pk2(a[2] * rstd * sg[2], a[3] * rstd * sg[3]); o0.z = pk2(a[4] * rstd * sg[4], a[5] * rstd * sg[5]); o0.w = pk2(a[6] * rstd * sg[6], a[7] * rstd * sg[7]);
            o1.x = pk2(a[8] * rstd * sg[8], a[9] * rstd * sg[9]); o1.y = pk2(a[10] * rstd * sg[10], a[11] * rstd * sg[11]); o1.z = pk2(a[12] * rstd * sg[12], a[13] * rstd * sg[13]); o1.w = pk2(a[14] * rstd * sg[14], a[15] * rstd * sg[15]);
            v4u* q = (v4u*)(OA + (size_t)m * 1024 + lane * 16); q[0] = o0; q[1] = o1;
        }
        {
            const int h = lane >> 4;
            const float l0 = LSE[(size_t)m * 4 + h], l1 = LSE[(size_t)M * 4 + (size_t)m * 4 + h], l2 = LSE[(size_t)2 * M * 4 + (size_t)m * 4 + h];
            const float mx = fmaxf(l0, fmaxf(l1, l2)); float w0 = exp2f(l0 - mx), w1 = exp2f(l1 - mx), w2 = exp2f(l2 - mx); const float inv = 1.0f / (w0 + w1 + w2); w0 *= inv; w1 *= inv; w2 *= inv;
            float a[8], b[8], c[8];
            pg8::unpack8(*(const v4u*)(ODL + (size_t)m * 512 + lane * 8), a); pg8::unpack8(*(const v4u*)(ODL + (size_t)M * 512 + (size_t)m * 512 + lane * 8), b); pg8::unpack8(*(const v4u*)(ODL + (size_t)2 * M * 512 + (size_t)m * 512 + lane * 8), c);
            v4u o;
            o.x = pk2(w0 * a[0] + w1 * b[0] + w2 * c[0], w0 * a[1] + w1 * b[1] + w2 * c[1]); o.y = pk2(w0 * a[2] + w1 * b[2] + w2 * c[2], w0 * a[3] + w1 * b[3] + w2 * c[3]);
            o.z = pk2(w0 * a[4] + w1 * b[4] + w2 * c[4], w0 * a[5] + w1 * b[5] + w2 * c[5]); o.w = pk2(w0 * a[6] + w1 * b[6] + w2 * c[6], w0 * a[7] + w1 * b[7] + w2 * c[7]);
            *(v4u*)(OB + (size_t)m * 512 + lane * 8) = o;
        }
    }
}
__device__ __forceinline__ void p7_router(Frame& F) {
    typedef float f32x4v __attribute__((ext_vector_type(4)));
    LAS float* LG = (LAS float*)(F.lds);
    LAS float* SS = (LAS float*)(F.lds + 24576);
    LAS float* RS = (LAS float*)(F.lds + 25088);
    const float* WR = (const float*)(F.ws + WS_WR);
    int* EIDX = (int*)(F.ws + WS_ROUTE); float* EW = (float*)(F.ws + WS_ROUTE + 131072);
    bf16* XN2 = (bf16*)(F.ws + WS_XN);
    const int lane = F.lane, wave = F.wave, rg = wave & 3, kh = wave >> 2, i = lane & 15, kq = lane >> 4;
    f32x4 gn[8];
#pragma unroll
    for (int j = 0; j < 8; ++j) gn[j] = *((const GAS f32x4*)F.norm_ffn + lane + 64 * j);
    for (int it = F.vcu; it < M / 64; it += F.G) {
        const int row0 = 64 * it;
        const float* xr = F.out + (size_t)(row0 + 16 * rg + i) * DM + 1024 * kh + 4 * kq;
        const float* wr = WR + (size_t)(1024 * kh + 4 * kq) * 48 + i;
        f32x4v a0 = {0.f, 0.f, 0.f, 0.f}, a1 = a0, a2 = a0; float ssq = 0.f;
        for (int t = 0; t < 64; ++t) {
            const f32x4 xv = *(const f32x4*)(xr + 16 * t);
            ssq += (xv.x * xv.x + xv.y * xv.y) + (xv.z * xv.z + xv.w * xv.w);
#pragma unroll
            for (int c = 0; c < 4; ++c) { const float* w = wr + (size_t)(16 * t + c) * 48; const float xa = xv[c];
                a0 = __builtin_amdgcn_mfma_f32_16x16x4f32(xa, w[0], a0, 0, 0, 0); a1 = __builtin_amdgcn_mfma_f32_16x16x4f32(xa, w[16], a1, 0, 0, 0); a2 = __builtin_amdgcn_mfma_f32_16x16x4f32(xa, w[32], a2, 0, 0, 0); }
        }
        ssq += __shfl_xor(ssq, 16); ssq += __shfl_xor(ssq, 32);
#pragma unroll
        for (int reg = 0; reg < 4; ++reg) { LAS float* p = LG + (kh * 64 + 16 * rg + 4 * kq + reg) * 48 + i; p[0] = a0[reg]; p[16] = a1[reg]; p[32] = a2[reg]; }
        if (kq == 0) SS[kh * 64 + 16 * rg + i] = ssq;
        __syncthreads();
        if (F.tid < 64) {
            const int r = F.tid; const float rstd = 1.0f / sqrtf((SS[r] + SS[64 + r]) * (1.f / DM) + EPS);
            const LAS float* l0 = LG + r * 48; const LAS float* l1 = LG + (64 + r) * 48;
            float gl[4];
#pragma unroll
            for (int j = 0; j < 4; ++j) gl[j] = (l0[32 + j] + l1[32 + j]) * rstd;
            int g = 0; float gmax = gl[0];
#pragma unroll
            for (int j = 1; j < 4; ++j) if (gl[j] > gmax) { gmax = gl[j]; g = j; }
            float gs = 0.f;
#pragma unroll
            for (int j = 0; j < 4; ++j) gs += expf(gl[j] - gmax);
            const float gw = 1.0f / gs;
            float t0 = -INFINITY, t1 = -INFINITY; int i0 = 0, i1 = 0;
#pragma unroll
            for (int j = 0; j < 8; ++j) { const float v = (l0[8 * g + j] + l1[8 * g + j]) * rstd;
                if (v > t0) { t1 = t0; i1 = i0; t0 = v; i0 = j; } else if (v > t1) { t1 = v; i1 = j; } }
            const float e1 = expf(t1 - t0), w0 = gw / (1.0f + e1), w1 = gw * e1 / (1.0f + e1);
            const int e0i = 8 * g + i0, e1i = 8 * g + i1, row = row0 + r;
            EIDX[2 * row] = e0i; EIDX[2 * row + 1] = e1i; EW[2 * row] = w0; EW[2 * row + 1] = w1;
            atomicAdd((unsigned*)(F.ctl + CW_CNT) + e0i, 1u); atomicAdd((unsigned*)(F.ctl + CW_CNT) + e1i, 1u);
            RS[r] = rstd;
        }
        __syncthreads();
        for (int rr = 0; rr < 8; ++rr) {
            const int r = wave * 8 + rr; const float rstd = RS[r];
            const GAS f32x4* xp = (const GAS f32x4*)(F.out + (size_t)(row0 + r) * DM) + lane;
            GAS unsigned long long* o8 = (GAS unsigned long long*)(XN2 + (size_t)(row0 + r) * DM) + lane;
#pragma unroll
            for (int j = 0; j < 8; ++j) { const f32x4 t = xp[64 * j] * rstd * gn[j]; o8[64 * j] = (unsigned long long)pk2(t.x, t.y) | ((unsigned long long)pk2(t.z, t.w) << 32); }
        }
        __syncthreads();
    }
}
__device__ __forceinline__ void build_tables(Frame& F, LAS int* PS, LAS int* TE) {
    if (F.tid == 0) {
        int acc = 0, t = 0;
        for (int e = 0; e < NE; ++e) { PS[e] = acc; const int c = (int)__hip_atomic_load(F.ctl + CW_CNT + e, RLX_AGENT); const int nt = (c + 255) >> 8; for (int k = 0; k < nt; ++k) TE[t++] = e; acc += nt << 8; }
        PS[NE] = acc; TE[160] = t;
    }
    __syncthreads();
}
__device__ __forceinline__ void p8_scatter(Frame& F) {
    LAS int* PS = (LAS int*)(F.lds); LAS int* TE = (LAS int*)(F.lds + TILE_E_OFF);
    build_tables(F, PS, TE);
    const int gw = F.vcu * NWAVES + F.wave, NGW = F.G * NWAVES, lane = F.lane;
    const int* EIDX = (const int*)(F.ws + WS_ROUTE); int* SLOTS = (int*)(F.ws + WS_ROUTE + 262144);
    const bf16* XN2 = (const bf16*)(F.ws + WS_XN); bf16* XS = (bf16*)(F.ws + WS_XS);
    for (int p = gw; p < TK; p += NGW) {
        const int e = EIDX[p]; int pos = 0;
        if (lane == 0) pos = (int)atomicAdd((unsigned*)(F.ctl + CW_FILL) + e, 1u);
        pos = __builtin_amdgcn_readfirstlane(pos);
        const int slot = PS[e] + pos;
        const GAS v4u* src = (const GAS v4u*)(XN2 + (size_t)(p >> 1) * DM) + lane; GAS v4u* dst = (GAS v4u*)(XS + (size_t)slot * DM) + lane;
#pragma unroll
        for (int j = 0; j < 4; ++j) dst[64 * j] = src[64 * j];
        if (lane == 0) SLOTS[p] = slot;
    }
}
__device__ __forceinline__ void p11_combine(Frame& F) {
    const int gw = F.vcu * NWAVES + F.wave, NGW = F.G * NWAVES, lane = F.lane;
    const float* EW = (const float*)(F.ws + WS_ROUTE + 131072); const int* SLOTS = (const int*)(F.ws + WS_ROUTE + 262144);
    const bf16* Y = (const bf16*)(F.ws + WS_XS);
    for (int m = gw; m < M; m += NGW) {
        const int s0 = SLOTS[2 * m], s1 = SLOTS[2 * m + 1]; const float w0 = EW[2 * m], w1 = EW[2 * m + 1];
        GAS f32x4* op = (GAS f32x4*)(F.out + (size_t)m * DM) + lane;
        const GAS unsigned long long* y0 = (const GAS unsigned long long*)(Y + (size_t)s0 * DM) + lane; const GAS unsigned long long* y1 = (const GAS unsigned long long*)(Y + (size_t)s1 * DM) + lane;
#pragma unroll
        for (int j = 0; j < 8; ++j) { f32x4 v = op[64 * j]; const unsigned long long a = y0[64 * j], b = y1[64 * j];
            v.x += w0 * __uint_as_float((unsigned)a << 16) + w1 * __uint_as_float((unsigned)b << 16);
            v.y += w0 * __uint_as_float((unsigned)a & 0xffff0000u) + w1 * __uint_as_float((unsigned)b & 0xffff0000u);
            v.z += w0 * __uint_as_float((unsigned)(a >> 32) << 16) + w1 * __uint_as_float((unsigned)(b >> 32) << 16);
            v.w += w0 * __uint_as_float((unsigned)(a >> 32) & 0xffff0000u) + w1 * __uint_as_float((unsigned)(b >> 32) & 0xffff0000u);
            op[64 * j] = v; }
    }
}

struct Args { const float* in[18]; float* out; unsigned char* ws; int ph_lo, ph_hi, li, pad; };
__global__ void __launch_bounds__(NWAVES * 64, 2) mk_fwd(Args args) {
    extern __shared__ __attribute__((aligned(16))) unsigned char lds[];
    Frame F;
    F.lds = (LAS unsigned char*)lds;
    F.MISC = (volatile LAS unsigned*)(F.lds + MISC_OFF);
    F.tid = threadIdx.x; F.lane = F.tid & 63; F.wave = __builtin_amdgcn_readfirstlane(F.tid >> 6);
    F.G = gridDim.x; { const int bx = blockIdx.x; F.vcu = (F.G % 8 == 0) ? (bx % 8) * (F.G / 8) + bx / 8 : bx; }
    F.ws = args.ws; F.ctl = (gu32*)(args.ws + WS_CTL); F.out = args.out;
    F.x = args.in[0]; F.norm_mix = args.in[1]; F.w_in = args.in[2]; F.da_qn = args.in[3]; F.da_kn = args.in[4]; F.da_lq = args.in[5]; F.da_lk = args.in[6]; F.da_sn = args.in[7];
    F.dl_qn = args.in[8]; F.dl_kn = args.in[9]; F.w_a = args.in[10]; F.w_b = args.in[11]; F.w_out = args.in[12]; F.norm_ffn = args.in[13]; F.w_gr = args.in[14]; F.w_er = args.in[15]; F.w_gu = args.in[16]; F.w_dn = args.in[17];
    for (int u = F.tid; u < (LDS_BYTES - LDSCTL_OFF) / 4; u += NWAVES * 64) ((LAS unsigned*)(F.lds + LDSCTL_OFF))[u] = 0u;
    __syncthreads();
    XcdBarrier bar; bar.bar = (unsigned*)(F.ctl + CW_BAR); bar.x = 0; bar.st = nullptr;
    if (MK_N_LAUNCHES == 1) bar = xcd_barrier_post((unsigned*)(F.ctl + CW_BAR), F.MISC + 8);
    const int lo = args.ph_lo, hi = args.ph_hi;
#define IN(k) (lo <= (k) && (k) < hi)
#define SEAM(k) do { if (IN(k) && IN((k) + 1)) xcd_barrier(bar); } while (0)
    bf16* XN = (bf16*)(F.ws + WS_XN); bf16* PROJ = (bf16*)(F.ws + WS_PROJ); bf16* MIX = (bf16*)(F.ws + WS_MIX);

    if (IN(0)) { p0_prologue(F); } SEAM(0);
    if (IN(1)) {
        pg8::Gemm g{XN, (const bf16*)(F.ws + WS_WIN), M, NIN, DM, 0}; pg8::StaticOrder S; S.init(M, NIN, F.G, (int)blockIdx.x);
        pg8::EpiProj E{PROJ, NIN, (const float*)(F.ws + WS_GAIN), (LAS float*)(F.lds + XCH_OFF), 0.125f * LOG2E, 0.08838834764831845f * LOG2E, EPS};
        pg8::gemm_phase<pg8::EpiProj, pg8::StaticOrder, true, true>(F.lds + RING_OFF, g, S, E);
    } SEAM(1);
    if (IN(2)) { p2_attention(F); } SEAM(2);
    if (IN(3)) { p3_merge(F); } SEAM(3);
    if (IN(4)) {
        pg8::Gemm g{(const bf16*)(F.ws + WS_OA), (const bf16*)(F.ws + WS_WA), M, DM, 1024, 0}; pg8::StaticOrder S; S.init(M, DM, F.G, (int)blockIdx.x);
        pg8::EpiGate<0> E{MIX, DM, PROJ + C_GA, NIN};
        pg8::gemm_phase<pg8::EpiGate<0>, pg8::StaticOrder, true, true>(F.lds + RING_OFF, g, S, E);
    }
    if (IN(5)) {
        pg8::Gemm g{(const bf16*)(F.ws + WS_OB), (const bf16*)(F.ws + WS_WB), M, DM, 512, 0}; pg8::StaticOrder S; S.init(M, DM, F.G, (int)blockIdx.x);
        pg8::EpiGate<1> E{MIX, DM, PROJ + C_GB, NIN};
        pg8::gemm_phase<pg8::EpiGate<1>, pg8::StaticOrder, true, true>(F.lds + RING_OFF, g, S, E);
    } SEAM(5);
    if (IN(6)) {
        pg8::Gemm g{MIX, (const bf16*)(F.ws + WS_WO), M, DM, DM, 0}; pg8::StaticOrder S; S.init(M, DM, F.G, (int)blockIdx.x);
        pg8::EpiRes E{F.x, F.out, DM};
        pg8::gemm_phase<pg8::EpiRes, pg8::StaticOrder, true, true>(F.lds + RING_OFF, g, S, E);
    } SEAM(6);
    if (IN(7)) { p7_router(F); } SEAM(7);
    if (IN(8)) { p8_scatter(F); } SEAM(8);
    if (IN(9)) {
        LAS int* TE = (LAS int*)(F.lds + TILE_E_OFF); LAS int* PS = (LAS int*)(F.lds + TILE_E_OFF + 192 * 4);
        if (!IN(8)) build_tables(F, PS, TE);
        pg8::Gemm g{(const bf16*)(F.ws + WS_XS), (const bf16*)(F.ws + WS_WGU), XS_ROWS, 2048, DM, (size_t)2048 * DM * 2};
        pg8::GroupOrder S{TE[160], F.G, (int)blockIdx.x, TE};
        pg8::EpiSwiglu E{(bf16*)(F.ws + WS_HB), DFF};
        pg8::gemm_phase<pg8::EpiSwiglu, pg8::GroupOrder, true, true>(F.lds + RING_OFF, g, S, E);
    } SEAM(9);
    if (IN(10)) {
        LAS int* TE = (LAS int*)(F.lds + TILE_E_OFF); LAS int* PS = (LAS int*)(F.lds + TILE_E_OFF + 192 * 4);
        if (!IN(8)) build_tables(F, PS, TE);
        pg8::Gemm g{(const bf16*)(F.ws + WS_HB), (const bf16*)(F.ws + WS_WD), XS_ROWS, DM, DFF, (size_t)DM * DFF * 2};
        pg8::GroupOrder S{TE[160], F.G, (int)blockIdx.x, TE};
        pg8::EpiPlain E{(bf16*)(F.ws + WS_XS), DM};
        pg8::gemm_phase<pg8::EpiPlain, pg8::GroupOrder, true, true>(F.lds + RING_OFF, g, S, E);
    } SEAM(10);
    if (IN(11)) { p11_combine(F); }
#undef IN
#undef SEAM
}

extern "C" void kernel_launch(void* const* d_in, const int* in_sizes, int n_in, void* d_out, int out_size, void* d_ws, size_t ws_size, hipStream_t stream) {
    static int grid = 0;
    if (grid == 0) {
        if (n_in != 18 || out_size != M * DM || ws_size < WS_END) { fprintf(stderr, "kernel_launch: unexpected problem shape or workspace (%d inputs, out %d, ws %zu < %zu)\n", n_in, out_size, ws_size, (size_t)WS_END); grid = -1; return; }
        int dev = 0, cus = 0, per_cu = 0;
        if (hipGetDevice(&dev) != hipSuccess || hipDeviceGetAttribute(&cus, hipDeviceAttributeMultiprocessorCount, dev) != hipSuccess) { grid = -1; return; }
        if (hipFuncSetAttribute((const void*)mk_fwd, hipFuncAttributeMaxDynamicSharedMemorySize, LDS_BYTES) != hipSuccess) { fprintf(stderr, "kernel_launch: hipFuncSetAttribute failed\n"); grid = -1; return; }
        if (hipOccupancyMaxActiveBlocksPerMultiprocessor(&per_cu, (const void*)mk_fwd, NWAVES * 64, LDS_BYTES) != hipSuccess || per_cu < 1) { fprintf(stderr, "kernel_launch: occupancy query says %d blocks per CU\n", per_cu); (void)hipGetLastError(); grid = -1; return; }
        grid = cus;
        if (grid != 256) fprintf(stderr, "kernel_launch: %d CUs (tuned for 256)\n", grid);
    }
    if (grid < 0) return;
    (void)hipMemsetAsync((char*)d_ws + WS_CTL, 0, CTL_ZERO_BYTES, stream);
    Args a{};
    for (int i = 0; i < 18; ++i) a.in[i] = (const float*)d_in[i];
    a.out = (float*)d_out; a.ws = (unsigned char*)d_ws;
    if (MK_N_LAUNCHES == 1) {
        a.ph_lo = 0; a.ph_hi = N_PHASES; a.li = 0;
        hipLaunchKernelGGL(mk_fwd, dim3(grid), dim3(NWAVES * 64), LDS_BYTES, stream, a);
    } else {
        for (int p = 0; p < N_PHASES; ++p) {
            if (p == 5) continue;
            a.ph_lo = p; a.ph_hi = (p == 4) ? 6 : p + 1; a.li = p;
            hipLaunchKernelGGL(mk_fwd, dim3(grid), dim3(NWAVES * 64), LDS_BYTES, stream, a);
        }
    }
}
```

```cpp
#include <hip/hip_runtime.h>
#include <cstdio>
#include <cstdint>
#ifndef MK_EPI2
#define MK_EPI2 0
#endif
#ifndef MK_DBG
#define MK_DBG 0
#endif
#ifndef MK_DBG_GEMM
#define MK_DBG_GEMM 0
#endif
__device__ __forceinline__ int mk_lane() { int l; asm volatile("v_mbcnt_lo_u32_b32 %0, -1, 0\n\tv_mbcnt_hi_u32_b32 %0, -1, %0" : "=v"(l)); return l; }
namespace pg8 {
#define PG8_LAS __attribute__((address_space(3)))
typedef unsigned short bf16_t;
typedef short bf16x8 __attribute__((ext_vector_type(8)));
typedef float f32x4 __attribute__((ext_vector_type(4)));
typedef unsigned u32x4 __attribute__((ext_vector_type(4)));
typedef int i32x8 __attribute__((ext_vector_type(8)));
constexpr int BM = 256, BK = 64, HALF = 128, HTB = HALF * BK * 2  , STAGE_BYTES = 8 * HTB, NXCD = 8, WGM = 8;

__host__ __device__ __forceinline__ int lds_byte(int r, int c) { const int st = (r >> 4) * 2 + (c >> 5), rr = r & 15, cc = c & 31, ob = rr * 64 + cc * 2; return st * 1024 + (ob ^ (((ob >> 9) & 1) << 5)); }
__host__ __device__ __forceinline__ void stage_rc(int b, int& R, int& C) { const int st = b / 1024, sb = b % 1024, swz = sb ^ (((sb >> 9) & 1) << 5); R = (st >> 1) * 16 + swz / 64; C = (st & 1) * 32 + (swz % 64) / 2; }
__host__ __device__ __forceinline__ int perm32(int rho) { const int n = rho >> 4, i = rho & 15; return 8 * (i >> 2) + 4 * n + (i & 3); }

struct Unit { int pm, pn, e, nt, kofs, keep; };
struct Gemm { const bf16_t* A; const bf16_t* Bt; int M, N, K; size_t estride; };

struct StaticOrder {
    int nM, nN, nwg, G, c;
    __host__ __device__ void init(int M, int N, int G_, int c_) { nM = M / BM; nN = N / BM; nwg = nM * nN; G = G_; c = c_; }
    __host__ __device__ bool next(int i, Unit& u) const {
        const long L = (long)i * G + c; if (L >= nwg) return false;
        int wgid = (int)L; { const int q = nwg / NXCD, r = nwg % NXCD, xcd = wgid % NXCD, off = wgid / NXCD; wgid = (xcd < r ? xcd * (q + 1) : r * (q + 1) + (xcd - r) * q) + off; }
        const int nig = WGM * nN, gid = wgid / nig, fm = gid * WGM, gsz = (nM - fm) < WGM ? (nM - fm) : WGM;
        u.pm = fm + ((wgid % nig) % gsz); u.pn = (wgid % nig) / gsz; u.e = 0; u.nt = 0; u.kofs = 0; u.keep = 0; return true;
    }
    __device__ __forceinline__ int arow(const Unit&, int R) const { return R; }
    __device__ __forceinline__ void a_ready(const Unit&) const {}
    __device__ __forceinline__ void done(const Unit&) const {}
};

typedef float f32x2_c __attribute__((ext_vector_type(2))); typedef __bf16 bf16x2_c __attribute__((ext_vector_type(2)));
__device__ __forceinline__ unsigned cvt_pk_bf16(float lo, float hi) { f32x2_c v = {lo, hi}; bf16x2_c b = __builtin_convertvector(v, bf16x2_c); return __builtin_bit_cast(unsigned, b); }
__device__ __forceinline__ float bf2f(unsigned short b) { return __uint_as_float((unsigned)b << 16); }
__device__ __forceinline__ void unpack8(const u32x4 w, float (&f)[8]) {
    f[0] = __uint_as_float(w.x << 16); f[1] = __uint_as_float(w.x & 0xffff0000u); f[2] = __uint_as_float(w.y << 16); f[3] = __uint_as_float(w.y & 0xffff0000u);
    f[4] = __uint_as_float(w.z << 16); f[5] = __uint_as_float(w.z & 0xffff0000u); f[6] = __uint_as_float(w.w << 16); f[7] = __uint_as_float(w.w & 0xffff0000u);
}
__device__ __forceinline__ u32x4 pack8(const f32x4 v0, const f32x4 v1) { u32x4 w; w.x = cvt_pk_bf16(v0[0], v0[1]); w.y = cvt_pk_bf16(v0[2], v0[3]); w.z = cvt_pk_bf16(v1[0], v1[1]); w.w = cvt_pk_bf16(v1[2], v1[3]); return w; }

constexpr size_t PJ_QA = 0, PJ_KA = (size_t)16384 * 1024, PJ_VA = (size_t)16384 * 2048, PJ_QL = (size_t)16384 * 3072, PJ_KL = (size_t)16384 * 4608, PJ_VL = (size_t)16384 * 6144, PJ_G = (size_t)16384 * 7680;
struct EpiProj {
    static constexpr bool PERM = true, AFTER_DRAIN = false, IDEM = true; static constexpr int MIDT = 0;
    bf16_t* O;
    const float* gains;
    PG8_LAS float* xch;
    float c2_da, c2_dl, eps;
    __device__ __forceinline__ void operator()(const f32x4 (&acc)[2][2][4][2], const Unit& u, int wr, int wc, int fr, int fq) const {
        constexpr int S = 8192;
        const int pn = u.pn;
        const int kind = (pn < 8) ? 1 : (pn < 12) ? 0 : (pn < 24) ? 2 : (pn < 30) ? 0 : 3;
        const int rowl0 = wr * 64 + fr;
        const int b = u.pm >> 5, t0 = (u.pm & 31) * BM + rowl0;
        size_t hb0; int hstep, pitch, dil = 1;
        if (pn < 8) {
            const int pq = pn & 3; pitch = 64; hstep = 2 * S * 64;
            hb0 = (pn < 4 ? PJ_QA : PJ_KA) + ((size_t)((b * 8 + 2 * pq) * 2 + (wc >> 1)) * S) * 64 + (wc & 1) * 32 + 8 * fq;
        } else if (pn < 12) {
            const int pq = pn - 8; pitch = 128; hstep = S * 128;
            hb0 = PJ_VA + ((size_t)(b * 8 + 2 * pq) * S) * 128 + wc * 32 + 8 * fq;
        } else if (pn < 30) {
            const int sec = (pn - 12) / 6, pq = (pn - 12) % 6; pitch = 128; hstep = S * 128; dil = (pq < 2) ? 1 : (pq < 4) ? 4 : 16;
            hb0 = (sec == 0 ? PJ_QL : sec == 1 ? PJ_KL : PJ_VL) + ((size_t)(b * 12 + 2 * pq) * S) * 128 + wc * 32 + 8 * fq;
        } else {
            pitch = 4096; hstep = HALF;
            hb0 = PJ_G + ((size_t)b * S) * 4096 + (pn - 30) * BM + wc * 32 + 8 * fq;
        }
        bf16_t* const hb = O + hb0;
        const int lsh = (dil == 1) ? 0 : (dil == 4) ? 2 : 4;
        if (kind == 1 || kind == 2) {
#pragma unroll
            for (int ai = 0; ai < 2; ++ai)
#pragma unroll
                for (int m = 0; m < 4; ++m)
#pragma unroll
                    for (int bj = 0; bj < 2; ++bj) {
                        const f32x4 a = acc[ai][bj][m][0], bq = acc[ai][bj][m][1];
                        float s = (a[0] * a[0] + a[1] * a[1]) + (a[2] * a[2] + a[3] * a[3]) + (bq[0] * bq[0] + bq[1] * bq[1]) + (bq[2] * bq[2] + bq[3] * bq[3]);
                        s += __shfl_xor(s, 16); s += __shfl_xor(s, 32);
                        if (fq == 0) xch[(ai * HALF + rowl0 + m * 16) * 8 + bj * 4 + wc] = s;
                    }
            asm volatile("s_waitcnt lgkmcnt(0)" ::: "memory"); __builtin_amdgcn_s_barrier(); asm volatile("" ::: "memory");
            const bool isq = (pn < 4) || (pn >= 12 && pn < 18);
            const int goff = (kind == 1) ? ((isq ? 0 : 64) + (wc & 1) * 32 + 8 * fq) : ((isq ? 128 : 256) + wc * 32 + 8 * fq);
            const float* gp = gains + goff;
            const f32x4 g0 = *(const f32x4*)gp, g1 = *(const f32x4*)(gp + 4);
            const float sc = isq ? (kind == 1 ? c2_da : c2_dl) : 1.0f;
            const float inv = (kind == 1) ? (1.0f / 64.0f) : (1.0f / 128.0f);
#pragma unroll
            for (int ai = 0; ai < 2; ++ai)
#pragma unroll
                for (int m = 0; m < 4; ++m) {
                    const PG8_LAS f32x4* xr = (const PG8_LAS f32x4*)(xch + (ai * HALF + rowl0 + m * 16) * 8);
                    const int t = t0 + ai * HALF + m * 16; const size_t ro = (size_t)(((t & (dil - 1)) * (S >> lsh)) + (t >> lsh)) * pitch;
#pragma unroll
                    for (int bj = 0; bj < 2; ++bj) {
                        const f32x4 tt = xr[bj];
                        const float tot = (kind == 1) ? ((wc < 2) ? (tt[0] + tt[1]) : (tt[2] + tt[3])) : ((tt[0] + tt[1]) + (tt[2] + tt[3]));
                        const float rs = __builtin_amdgcn_rsqf(tot * inv + eps) * sc;
                        const f32x4 v0 = acc[ai][bj][m][0] * rs * g0, v1 = acc[ai][bj][m][1] * rs * g1;
                        *(u32x4*)(hb + ro + (size_t)bj * hstep) = pack8(v0, v1);
                    }
                }
        } else {
#pragma unroll
            for (int ai = 0; ai < 2; ++ai)
#pragma unroll
                for (int m = 0; m < 4; ++m) {
                    const int t = t0 + ai * HALF + m * 16; const size_t ro = (size_t)(((t & (dil - 1)) * (S >> lsh)) + (t >> lsh)) * pitch;
#pragma unroll
                    for (int bj = 0; bj < 2; ++bj) {
                        f32x4 v0 = acc[ai][bj][m][0], v1 = acc[ai][bj][m][1];
                        if (kind == 3) {
#pragma unroll
                            for (int j = 0; j < 4; ++j) { v0[j] = __builtin_amdgcn_rcpf(1.0f + __builtin_amdgcn_exp2f(-1.4426950408889634f * v0[j])); v1[j] = __builtin_amdgcn_rcpf(1.0f + __builtin_amdgcn_exp2f(-1.4426950408889634f * v1[j])); }
                        }
                        *(u32x4*)(hb + ro + (size_t)bj * hstep) = pack8(v0, v1);
                    }
                }
        }
    }
};

struct EpiGateSig {
    static constexpr bool PERM = true, AFTER_DRAIN = false, IDEM = true; static constexpr int MIDT = 0;
    bf16_t* G; float ascale; bf16_t* O;
    __device__ __forceinline__ void operator()(const f32x4 (&acc)[2][2][4][2], const Unit& u, int wr, int wc, int fr, int fq) const {
        constexpr int S = 8192;
        const bool gate = u.pn < 16;
        const int pv = u.pn - 16, b = u.pm >> 5, t0 = (u.pm & 31) * BM + wr * 64 + fr;
        const bool da = pv < 4; const int pq = da ? pv : pv - 4, dil = (gate || da || pq < 2) ? 1 : (pq < 4) ? 4 : 16, lsh = (dil == 1) ? 0 : (dil == 4) ? 2 : 4;
        const size_t ubase = gate ? (size_t)(u.pm * BM) * 4096 + u.pn * BM : (da ? PJ_VA + ((size_t)(b * 8 + 2 * pq) * S) * 128 : PJ_VL + ((size_t)(b * 12 + 2 * pq) * S) * 128);
        bf16_t* const base = (gate ? G : O) + ubase + (gate ? (unsigned)(wr * 64 + fr) * 4096u : 0u) + wc * 32 + 8 * fq;
        const unsigned pitch = gate ? 4096u : 128u, bjs = gate ? (unsigned)HALF : (unsigned)(S * 128);
        const float ns = gate ? -1.4426950408889634f * ascale : ascale;
#pragma unroll
        for (int ai = 0; ai < 2; ++ai)
#pragma unroll
            for (int m = 0; m < 4; ++m) {
                const int t = gate ? ai * HALF + m * 16 : t0 + ai * HALF + m * 16; const unsigned ro = (unsigned)(((t & (dil - 1)) * (S >> lsh)) + (t >> lsh)) * pitch;
#pragma unroll
                for (int bj = 0; bj < 2; ++bj) {
                    f32x4 v0 = acc[ai][bj][m][0] * ns, v1 = acc[ai][bj][m][1] * ns;
                    if (gate) {
#pragma unroll
                        for (int j = 0; j < 4; ++j) { v0[j] = __builtin_amdgcn_rcpf(1.0f + __builtin_amdgcn_exp2f(v0[j])); v1[j] = __builtin_amdgcn_rcpf(1.0f + __builtin_amdgcn_exp2f(v1[j])); }
                    }
                    *(u32x4*)(base + ro + bj * bjs) = pack8(v0, v1);
                }
            }
    }
};

struct EpiMix {
    static constexpr bool PERM = true, AFTER_DRAIN = false, IDEM = false; static constexpr int MIDT = 0;
    bf16_t* MIX; int ldm; const bf16_t* G; int ldg;
    __device__ __forceinline__ void operator()(f32x4 (&acc)[2][2][4][2], const Unit& u, int wr, int wc, int fr, int fq) const {
        const int row0 = u.pm * BM + wr * 64 + fr, col0 = u.pn * BM + wc * 32 + 8 * fq;
        if (!u.keep) {
#pragma unroll
            for (int ai = 0; ai < 2; ++ai)
#pragma unroll
                for (int m = 0; m < 4; ++m) {
                    const size_t r = (size_t)(row0 + ai * HALF + m * 16);
#pragma unroll
                    for (int bj = 0; bj < 2; ++bj) {
                        float ga[8], gb[8]; unpack8(*(const u32x4*)(G + r * ldg + col0 + bj * HALF), ga); unpack8(*(const u32x4*)(G + r * ldg + 2048 + col0 + bj * HALF), gb);
#pragma unroll
                        for (int j = 0; j < 4; ++j) { acc[ai][bj][m][0][j] *= ga[j] * __builtin_amdgcn_rcpf(gb[j]); acc[ai][bj][m][1][j] *= ga[4 + j] * __builtin_amdgcn_rcpf(gb[4 + j]); }
                    }
                    if (m & 1) asm volatile("" ::: "memory");
                }
        } else {
#pragma unroll
            for (int ai = 0; ai < 2; ++ai)
#pragma unroll
                for (int m = 0; m < 4; ++m) {
                    const size_t r = (size_t)(row0 + ai * HALF + m * 16);
#pragma unroll
                    for (int bj = 0; bj < 2; ++bj) {
                        float g[8]; unpack8(*(const u32x4*)(G + r * ldg + 2048 + col0 + bj * HALF), g);
                        f32x4 v0 = acc[ai][bj][m][0], v1 = acc[ai][bj][m][1];
                        v0[0] *= g[0]; v0[1] *= g[1]; v0[2] *= g[2]; v0[3] *= g[3]; v1[0] *= g[4]; v1[1] *= g[5]; v1[2] *= g[6]; v1[3] *= g[7];
                        *(u32x4*)(MIX + r * ldm + col0 + bj * HALF) = pack8(v0, v1);
                    }
                }
        }
    }
};
struct MixOrder {
    StaticOrder base;
    __device__ __forceinline__ bool next(int i, Unit& u) const { if (!base.next(i >> 1, u)) return false; const int part = i & 1; u.nt = part ? 8 : 16; u.kofs = part ? 2048 : 0; u.keep = part; return true; }
    __device__ __forceinline__ int arow(const Unit&, int R) const { return R; }
    __device__ __forceinline__ void a_ready(const Unit&) const {}
    __device__ __forceinline__ void done(const Unit&) const {}
};

struct EpiRes {
    static constexpr bool PERM = false, AFTER_DRAIN = false, IDEM = true; static constexpr int MIDT = 0;
    const float* X; float* Out; int ldc;
    __device__ __forceinline__ void operator()(const f32x4 (&acc)[2][2][4][2], const Unit& u, int wr, int wc, int fr, int fq) const {
        const int row0 = u.pm * BM + wr * 64 + fr, col0 = u.pn * BM + wc * 32 + 4 * fq;
#pragma unroll
        for (int ai = 0; ai < 2; ++ai)
#pragma unroll
            for (int m = 0; m < 4; ++m) {
                const size_t off = (size_t)(row0 + ai * HALF + m * 16) * ldc + col0;
#pragma unroll
                for (int bj = 0; bj < 2; ++bj)
#pragma unroll
                    for (int n = 0; n < 2; ++n) { const f32x4 xv = *(const f32x4*)(X + off + bj * HALF + n * 16); *(f32x4*)(Out + off + bj * HALF + n * 16) = xv + acc[ai][bj][m][n]; }
            }
    }
};

constexpr float HSCALE = 4.0f, WSCALE = 64.0f, XSCALE = 8.0f;
__device__ __forceinline__ unsigned pk_fp8x4(float a, float b, float c, float d) {
    a = fminf(fmaxf(a, -448.f), 448.f); b = fminf(fmaxf(b, -448.f), 448.f); c = fminf(fmaxf(c, -448.f), 448.f); d = fminf(fmaxf(d, -448.f), 448.f);
    int p = __builtin_amdgcn_cvt_pk_fp8_f32(a, b, 0, false); p = __builtin_amdgcn_cvt_pk_fp8_f32(c, d, p, true); return (unsigned)p; }
__device__ __forceinline__ unsigned pk_fp8x4_nc(float a, float b, float c, float d) { int p = __builtin_amdgcn_cvt_pk_fp8_f32(a, b, 0, false); p = __builtin_amdgcn_cvt_pk_fp8_f32(c, d, p, true); return (unsigned)p; }
struct EpiSwiglu {
    static constexpr bool PERM = true, AFTER_DRAIN = false, IDEM = true; static constexpr int MIDT = 0;
    unsigned char* H; int ldh; float ascale;
    const float* rsl; const PG8_LAS int* ps; int lcap;
    __device__ __forceinline__ void operator()(const f32x4 (&acc)[2][2][4][2], const Unit& u, int wr, int wc, int fr, int fq) const {
        const int row0 = u.pm * BM + wr * 64 + fr, col0 = u.pn * HALF + wc * 32 + 8 * fq;
        const float* rb = rsl + (size_t)u.e * lcap + (row0 - ps[u.e]);
#pragma unroll
        for (int ai = 0; ai < 2; ++ai)
#pragma unroll
            for (int m = 0; m < 4; ++m) {
                float v[8]; const float rs = rb[ai * HALF + m * 16] * ascale;
#pragma unroll
                for (int n = 0; n < 2; ++n)
#pragma unroll
                    for (int j = 0; j < 4; ++j) { const float gt = acc[ai][0][m][n][j] * rs, up = acc[ai][1][m][n][j] * rs; v[4 * n + j] = gt * __builtin_amdgcn_rcpf(1.0f + __builtin_amdgcn_exp2f(-1.4426950408889634f * gt)) * up * HSCALE; }
                typedef unsigned u32x2 __attribute__((ext_vector_type(2)));
                *(u32x2*)(H + (size_t)(row0 + ai * HALF + m * 16) * ldh + col0) = (u32x2){pk_fp8x4_nc(v[0], v[1], v[2], v[3]), pk_fp8x4_nc(v[4], v[5], v[6], v[7])};
            }
    }
};

constexpr float YSCALE = 16.0f;
struct EpiFp8 {
    static constexpr bool PERM = true, AFTER_DRAIN = false, IDEM = true; static constexpr int MIDT = 0;
    unsigned char* O; int ldc; float scale;
    __device__ __forceinline__ void operator()(const f32x4 (&acc)[2][2][4][2], const Unit& u, int wr, int wc, int fr, int fq) const {
        const int row0 = u.pm * BM + wr * 64 + fr, col0 = u.pn * BM + wc * 32 + 8 * fq;
        typedef unsigned u32x2 __attribute__((ext_vector_type(2)));
#pragma unroll
        for (int ai = 0; ai < 2; ++ai)
#pragma unroll
            for (int m = 0; m < 4; ++m)
#pragma unroll
                for (int bj = 0; bj < 2; ++bj) { const f32x4 a = acc[ai][bj][m][0] * scale, b = acc[ai][bj][m][1] * scale;
                    *(u32x2*)(O + (size_t)(row0 + ai * HALF + m * 16) * ldc + col0 + bj * HALF) = (u32x2){pk_fp8x4_nc(a[0], a[1], a[2], a[3]), pk_fp8x4_nc(b[0], b[1], b[2], b[3])}; }
    }
};
struct EpiPlain {
    static constexpr bool PERM = true, AFTER_DRAIN = false, IDEM = true; static constexpr int MIDT = 0;
    bf16_t* O; int ldc; float scale;
    __device__ __forceinline__ void operator()(const f32x4 (&acc)[2][2][4][2], const Unit& u, int wr, int wc, int fr, int fq) const {
        const int row0 = u.pm * BM + wr * 64 + fr, col0 = u.pn * BM + wc * 32 + 8 * fq;
#pragma unroll
        for (int ai = 0; ai < 2; ++ai)
#pragma unroll
            for (int m = 0; m < 4; ++m)
#pragma unroll
                for (int bj = 0; bj < 2; ++bj) *(u32x4*)(O + (size_t)(row0 + ai * HALF + m * 16) * ldc + col0 + bj * HALF) = pack8(acc[ai][bj][m][0] * scale, acc[ai][bj][m][1] * scale);
    }
};

struct TicketOrder {
    unsigned* q; int xcd, per; volatile PG8_LAS int* tick; int wave; int skipv;
    __device__ __forceinline__ bool next(int i, Unit& u) const {
        const bool t0 = (wave == 0) && (mk_lane() == 0);
        if (i == 0) { if (t0) { tick[0] = (int)atomicAdd(q, 1u); tick[1] = (int)atomicAdd(q, 1u); } __syncthreads(); }
        else if (t0) tick[(i + 1) & 1] = (int)atomicAdd(q, 1u);
        const int tk = __builtin_amdgcn_readfirstlane(tick[i & 1]);
        if (tk >= per) return false;
        u.pm = 8 * xcd + (tk & 7); u.pn = tk >> 3; if (skipv && u.pn >= 8) u.pn += 4; u.e = 0; u.nt = 0; u.kofs = 0; u.keep = 0; return true;
    }
    __device__ __forceinline__ int arow(const Unit&, int R) const { return R; }
    __device__ __forceinline__ void a_ready(const Unit&) const {}
    __device__ __forceinline__ void done(const Unit&) const {}
};

struct SkipOrder { StaticOrder base;
    __device__ __forceinline__ bool next(int i, Unit& u) const { if (!base.next(i, u)) return false; if (u.pn >= 8) u.pn += 4; return true; }
    __device__ __forceinline__ int arow(const Unit&, int R) const { return R; }
    __device__ __forceinline__ void a_ready(const Unit&) const {}
    __device__ __forceinline__ void done(const Unit&) const {}
};
struct OffOrder { StaticOrder base; int off;
    __device__ __forceinline__ bool next(int i, Unit& u) const { if (!base.next(i, u)) return false; u.pn += off; return true; }
    __device__ __forceinline__ int arow(const Unit&, int R) const { return R; }
    __device__ __forceinline__ void a_ready(const Unit&) const {}
    __device__ __forceinline__ void done(const Unit&) const {}
};
struct GroupOrder {
    int nT, G, c; const PG8_LAS int* tile_e; const PG8_LAS int* ps; const PG8_LAS int* cn; const int* list; int lcap;
    __device__ __forceinline__ bool next(int i, Unit& u) const {
        const int L = i * G + c; if (L >= nT * 8) return false;
        const int wgid = (L & 7) * nT + (L >> 3);
        u.pm = wgid >> 3; u.pn = wgid & 7; u.e = __builtin_amdgcn_readfirstlane(tile_e[u.pm]); u.nt = 0; u.kofs = 0; u.keep = 0; return true;
    }
    __device__ __forceinline__ int arow(const Unit& u, int R) const { const int lr = u.pm * BM - ps[u.e] + R; return (lr < cn[u.e]) ? list[(size_t)u.e * lcap + lr] : 0; }
    __device__ __forceinline__ void a_ready(const Unit&) const {}
    __device__ __forceinline__ void done(const Unit&) const {}
};
template <class Epi, class Sched, bool ALIGN_EPI = false, bool SP2 = false, bool GATHER = false, bool MX = false>
__device__ __forceinline__ void gemm_phase(const int wv  , PG8_LAS unsigned char* lds, const Gemm g, const Sched& S, const Epi& E, unsigned* dbg_out = nullptr) {
    const int lane = mk_lane(), wid = wv, tid = wid * 64 + lane, wr = wid >> 2, wc = wid & 3, fr = lane & 15, fq = lane >> 4;
    const int K = g.K, nt_all = K / BK;
    unsigned voffA[2], voffB[2];
#pragma unroll
    for (int i = 0; i < 2; ++i) { int R, C; stage_rc(tid * 16 + i * 8192, R, C); const int Rb = Epi::PERM ? ((R & ~31) + perm32(R & 31)) : R;
        voffA[i] = (unsigned)(R * K + C) * 2u; voffB[i] = (unsigned)(Rb * K + C) * 2u; }
    static_assert(!GATHER || SP2, "GATHER needs the SP2 loop");
    unsigned vc0[2], vc1[2];
#define PG8_V(arr) (GATHER ? (arr) : voffA)
#define PG8_GOFF(dst0, dst1, uu) do { _Pragma("unroll") for (int i_ = 0; i_ < 2; ++i_) { int R_, C_; stage_rc(tid * 16 + i_ * 8192, R_, C_); \
        dst0[i_] = (unsigned)(S.arow(uu, R_) * K + C_) * 2u; dst1[i_] = (unsigned)(S.arow(uu, R_ + HALF) * K + C_) * 2u; } } while (0)
    const size_t kstep = (size_t)(BK * 2);
    const size_t hstep = (size_t)HALF * K * 2;
    const size_t tstep = 2 * hstep;
    const size_t hstepA = GATHER ? (size_t)0 : hstep;
    const unsigned ldsw = (unsigned)wid * 1024u; const unsigned lds0 = (unsigned)(uintptr_t)lds;
    const int aoff = lds_byte(wr * 64 + fr, fq * 8), boff = lds_byte(wc * 32 + fr, fq * 8);
#define PG8_SA(b, h) (((b) * 2 + (h)) * HTB)
#define PG8_SB(b, h) ((4 + (b) * 2 + (h)) * HTB)
#define PG8_STAGE(bufoff, gbase, voff) do { const char* sb_ = (const char*)(gbase);       \
        _Pragma("unroll") for (int _i = 0; _i < 2; ++_i) { unsigned keep_; const unsigned ld_ = lds0 + (unsigned)(bufoff) + ldsw + (unsigned)_i * 8192u; \
            asm volatile("s_mov_b32 %0, m0\n\ts_mov_b32 m0, %3\n\ts_nop 2\n\tglobal_load_lds_dwordx4 %1, %2\n\ts_mov_b32 m0, %0" : "=&s"(keep_) : "v"((voff)[_i]), "s"(sb_), "s"(ld_) : "memory"); } } while (0)
#define PG8_LDA(dst, b, h) do { unsigned ab_ = (unsigned)(PG8_SA(b, h) + aoff); asm volatile("" : "+v"(ab_));   \
        _Pragma("unroll") for (int m = 0; m < 4; ++m) _Pragma("unroll") for (int k = 0; k < 2; ++k) dst[m][k] = *(const PG8_LAS bf16x8*)(lds + ab_ + m * 2048 + k * 1024); } while (0)
#define PG8_LDB(dst, b, h) do { unsigned bb_ = (unsigned)(PG8_SB(b, h) + boff); asm volatile("" : "+v"(bb_)); \
        _Pragma("unroll") for (int n = 0; n < 2; ++n) _Pragma("unroll") for (int k = 0; k < 2; ++k) dst[n][k] = *(const PG8_LAS bf16x8*)(lds + bb_ + n * 2048 + k * 1024); } while (0)
#define PG8_CAT8(x, y) __builtin_bit_cast(i32x8, __builtin_shufflevector(x, y, 0, 1, 2, 3, 4, 5, 6, 7, 8, 9, 10, 11, 12, 13, 14, 15))
#define PG8_MMA(ai, bj, At, Bt) do { __builtin_amdgcn_s_setprio(1); _Pragma("unroll") for (int m = 0; m < 4; ++m) _Pragma("unroll") for (int n = 0; n < 2; ++n) { \
        if constexpr (MX) acc[ai][bj][m][n] = __builtin_amdgcn_mfma_scale_f32_16x16x128_f8f6f4(PG8_CAT8(Bt[n][0], Bt[n][1]), PG8_CAT8(At[m][0], At[m][1]), acc[ai][bj][m][n], 0, 0, 0, 0x7f7f7f7f, 0, 0x7f7f7f7f); \
        else { _Pragma("unroll") for (int k = 0; k < 2; ++k) acc[ai][bj][m][n] = __builtin_amdgcn_mfma_f32_16x16x32_bf16(Bt[n][k], At[m][k], acc[ai][bj][m][n], 0, 0, 0); } } __builtin_amdgcn_s_setprio(0); } while (0)
#define PG8_WAIT_V(n) asm volatile("s_waitcnt vmcnt(" #n ")" ::: "memory")
#define PG8_WAIT_L(n) asm volatile("s_waitcnt lgkmcnt(" #n ")" ::: "memory")
#define PG8_BAR __builtin_amdgcn_s_barrier()
#define PG8_SCHED __builtin_amdgcn_sched_barrier(0)
    Unit cur, nxt; int ui = 0;
    if (!S.next(0, cur)) return;
    f32x4 acc[2][2][4][2];
#pragma unroll
    for (int a = 0; a < 2; ++a)
#pragma unroll
        for (int b = 0; b < 2; ++b)
#pragma unroll
            for (int m = 0; m < 4; ++m)
#pragma unroll
                for (int n = 0; n < 2; ++n) acc[a][b][m][n] = (f32x4){0.f, 0.f, 0.f, 0.f};
    bf16x8 At[4][2], B0[2][2], B1[2][2];
    const char* cA = (const char*)g.A + (GATHER ? (size_t)0 : (size_t)cur.pm * tstep) + cur.kofs; const char* cB = (const char*)g.Bt + (size_t)cur.pn * tstep + (size_t)cur.e * g.estride + cur.kofs;
    S.a_ready(cur);
    if constexpr (GATHER) { PG8_GOFF(vc0, vc1, cur); } else {
#pragma unroll
        for (int i = 0; i < 2; ++i) { vc0[i] = voffA[i]; vc1[i] = voffA[i]; } }
    if constexpr (SP2) {
        PG8_STAGE(PG8_SB(0, 0), cB, voffB); PG8_STAGE(PG8_SB(0, 1), cB + hstep, voffB); PG8_STAGE(PG8_SA(0, 0), cA, PG8_V(vc0)); PG8_STAGE(PG8_SA(0, 1), cA + hstepA, PG8_V(vc1));
        if (wr == 1) PG8_BAR;
        PG8_WAIT_V(2); PG8_BAR;
        PG8_STAGE(PG8_SB(1, 0), cB + kstep, voffB); PG8_STAGE(PG8_SA(1, 0), cA + kstep, PG8_V(vc0)); PG8_STAGE(PG8_SB(1, 1), cB + hstep + kstep, voffB);
        PG8_WAIT_V(6); PG8_BAR;
    } else {
        PG8_STAGE(PG8_SB(0, 0), cB, voffB); PG8_STAGE(PG8_SA(0, 0), cA, voffA); PG8_STAGE(PG8_SB(0, 1), cB + hstep, voffB); PG8_STAGE(PG8_SA(0, 1), cA + hstep, voffA);
        if (wr == 1) PG8_BAR;
        PG8_WAIT_V(4); PG8_BAR;
        PG8_STAGE(PG8_SB(1, 0), cB + kstep, voffB); PG8_STAGE(PG8_SA(1, 0), cA + kstep, voffA); PG8_STAGE(PG8_SB(1, 1), cB + hstep + kstep, voffB);
        PG8_WAIT_V(6); PG8_BAR;
    }
    for (;;) {
        const bool has_next = S.next(ui + 1, nxt);
        const char* nA = (has_next && !GATHER) ? (const char*)g.A + (size_t)nxt.pm * tstep + nxt.kofs : (GATHER ? (const char*)g.A : cA);
        const char* nB = has_next ? (const char*)g.Bt + (size_t)nxt.pn * tstep + (size_t)nxt.e * g.estride + nxt.kofs : cB;
        const int nt = cur.nt > 0 ? cur.nt : nt_all;
#if MK_DBG
        const unsigned long long dbg_k0 = __builtin_amdgcn_s_memtime();
#endif
        for (int t = 0; t < nt; t += 2) {
            const bool last = (t == nt - 2);
            const char* a1 = cA + (size_t)(t + 1) * kstep;
            const char* a2 = last ? nA : cA + (size_t)(t + 2) * kstep; const char* b2 = last ? nB : cB + (size_t)(t + 2) * kstep;
            const char* a3 = a2 + kstep; const char* b3 = b2 + kstep;
            if (last && has_next) S.a_ready(nxt);
            if constexpr (SP2) {
            PG8_LDB(B0, 0, 0); PG8_LDB(B1, 0, 1); PG8_SCHED; PG8_LDA(At, 0, 0); PG8_STAGE(PG8_SA(1, 1), a1 + hstepA, PG8_V(vc1));
            if constexpr (GATHER) { if (last && has_next) { PG8_GOFF(vc0, vc1, nxt); } }
            PG8_WAIT_V(8); PG8_WAIT_L(0); PG8_BAR; PG8_MMA(0, 0, At, B0); PG8_MMA(0, 1, At, B1); PG8_BAR; PG8_SCHED;
            PG8_LDA(At, 0, 1); PG8_STAGE(PG8_SB(0, 0), b2, voffB); PG8_STAGE(PG8_SB(0, 1), b2 + hstep, voffB); PG8_STAGE(PG8_SA(0, 0), a2, PG8_V(vc0));
            PG8_WAIT_V(8); PG8_WAIT_L(0); PG8_BAR; PG8_MMA(1, 0, At, B0); PG8_MMA(1, 1, At, B1); PG8_BAR; PG8_SCHED;
            PG8_LDB(B0, 1, 0); PG8_LDB(B1, 1, 1); PG8_SCHED; PG8_LDA(At, 1, 0); PG8_STAGE(PG8_SA(0, 1), a2 + hstepA, PG8_V(vc1));
            PG8_WAIT_V(8); PG8_WAIT_L(0); PG8_BAR; PG8_MMA(0, 0, At, B0); PG8_MMA(0, 1, At, B1); PG8_BAR; PG8_SCHED;
            PG8_LDA(At, 1, 1); PG8_STAGE(PG8_SB(1, 0), b3, voffB); PG8_STAGE(PG8_SB(1, 1), b3 + hstep, voffB); PG8_STAGE(PG8_SA(1, 0), a3, PG8_V(vc0));
            PG8_WAIT_V(8); PG8_WAIT_L(0); PG8_BAR; PG8_MMA(1, 0, At, B0); PG8_MMA(1, 1, At, B1); PG8_BAR; PG8_SCHED;
            } else {
            PG8_LDB(B0, 0, 0); PG8_SCHED; PG8_LDA(At, 0, 0); PG8_STAGE(PG8_SA(1, 1), a1 + hstep, voffA);
            PG8_WAIT_L(8); PG8_BAR; PG8_WAIT_L(0); PG8_MMA(0, 0, At, B0); PG8_BAR; PG8_SCHED;
            PG8_LDB(B1, 0, 1); PG8_STAGE(PG8_SB(0, 0), b2, voffB);
            PG8_BAR; PG8_WAIT_L(0); PG8_MMA(0, 1, At, B1); PG8_BAR;
            PG8_LDA(At, 0, 1); PG8_STAGE(PG8_SA(0, 0), a2, voffA);
            PG8_BAR; PG8_WAIT_L(0); PG8_MMA(1, 0, At, B0); PG8_BAR; PG8_SCHED;
            PG8_STAGE(PG8_SB(0, 1), b2 + hstep, voffB);
            PG8_WAIT_V(6); PG8_BAR; PG8_MMA(1, 1, At, B1); PG8_BAR;
            PG8_LDB(B0, 1, 0); PG8_SCHED; PG8_LDA(At, 1, 0); PG8_STAGE(PG8_SA(0, 1), a2 + hstep, voffA);
            PG8_WAIT_L(8); PG8_BAR; PG8_WAIT_L(0); PG8_MMA(0, 0, At, B0); PG8_BAR; PG8_SCHED;
            PG8_LDB(B1, 1, 1); PG8_STAGE(PG8_SB(1, 0), b3, voffB);
            PG8_BAR; PG8_WAIT_L(0); PG8_MMA(0, 1, At, B1); PG8_BAR;
            PG8_LDA(At, 1, 1); PG8_STAGE(PG8_SA(1, 0), a3, voffA);
            PG8_BAR; PG8_WAIT_L(0); PG8_MMA(1, 0, At, B0); PG8_BAR; PG8_SCHED;
            PG8_STAGE(PG8_SB(1, 1), b3 + hstep, voffB);
            PG8_WAIT_V(6); PG8_BAR; PG8_MMA(1, 1, At, B1); PG8_BAR;
            }
        }
#if MK_DBG
        if (MK_DBG_GEMM && dbg_out != nullptr && ui == 2 && blockIdx.x == 0 && tid == 0) { const unsigned long long d = __builtin_amdgcn_s_memtime() - dbg_k0; dbg_out[7] = (unsigned)(d / (unsigned long long)nt); }
#endif
        if constexpr (ALIGN_EPI) { if (wr == 0) PG8_BAR; }
        int lane_e = mk_lane(); asm volatile("" : "+v"(lane_e));
        const int fr_e = lane_e & 15, fq_e = lane_e >> 4;
        if constexpr (!Epi::AFTER_DRAIN) { E(acc, cur, wr, wc, fr_e, fq_e); if (MK_EPI2 && Epi::IDEM) { asm volatile("" ::: "memory"); E(acc, cur, wr, wc, fr_e, fq_e); } S.done(cur); }
        if (!has_next) break;
        if (!nxt.keep) {
#pragma unroll
        for (int a = 0; a < 2; ++a)
#pragma unroll
            for (int b = 0; b < 2; ++b)
#pragma unroll
                for (int m = 0; m < 4; ++m)
#pragma unroll
                    for (int n = 0; n < 2; ++n) acc[a][b][m][n] = (f32x4){0.f, 0.f, 0.f, 0.f};
        }
        cur = nxt; cA = nA; cB = nB; ++ui;
        if constexpr (ALIGN_EPI) { if (wr == 1) PG8_BAR; }
    }
    PG8_WAIT_V(0);
    if constexpr (!ALIGN_EPI) { if (wr == 0) PG8_BAR; }
    PG8_BAR;
    if constexpr (Epi::AFTER_DRAIN) { E.fused(acc, cur, wr, wc, fr, fq, lds, wid, lane); S.done(cur); }
#undef PG8_SA
#undef PG8_SB
#undef PG8_STAGE
#undef PG8_LDA
#undef PG8_LDB
#undef PG8_MMA
#undef PG8_WAIT_V
#undef PG8_WAIT_L
#undef PG8_BAR
#undef PG8_SCHED
#undef PG8_GOFF
#undef PG8_V
}
}
#include <cmath>
#ifndef ATT_KDUP
#define ATT_KDUP 1
#endif
#ifndef ATT_HALF
#define ATT_HALF(w) ((w) >> 2)
#endif
#ifndef MK_DBG
#define MK_DBG 0
#endif
#ifndef MK_DBG_SEL
#define MK_DBG_SEL 0
#endif
#ifndef ATT_PRIO
#define ATT_PRIO 0
#endif
#ifndef ATT_SIMPLE
#define ATT_SIMPLE 1
#endif
namespace att {
typedef unsigned short bf16_t;
typedef short bf16x8 __attribute__((ext_vector_type(8)));
typedef short s16x4 __attribute__((ext_vector_type(4)));
typedef short v4i16_t __attribute__((ext_vector_type(4)));
typedef float f32x16 __attribute__((ext_vector_type(16)));
typedef unsigned u32x4 __attribute__((ext_vector_type(4)));
#define ATT_LAS __attribute__((address_space(3)))
constexpr int SLOT = 16384, RSLOT = 2 * SLOT  , ATT_LDS_BYTES = 4 * RSLOT;
__device__ __forceinline__ int crow(int r, int hi) { return (r & 3) + 8 * (r >> 2) + 4 * hi; }
__device__ __forceinline__ void glds16(const void* gsrc, unsigned lds_dst) { unsigned keep;
    asm volatile("s_mov_b32 %0, m0\n\ts_mov_b32 m0, %2\n\ts_nop 0\n\tglobal_load_lds_dwordx4 %1, off\n\ts_mov_b32 m0, %0" : "=&s"(keep) : "v"(gsrc), "s"(lds_dst) : "memory"); }
__device__ __forceinline__ const void* uniform_ptr(const void* p) { const unsigned long long v = (unsigned long long)p;
    return (const void*)(((unsigned long long)(unsigned)__builtin_amdgcn_readfirstlane((unsigned)(v >> 32)) << 32) | (unsigned long long)(unsigned)__builtin_amdgcn_readfirstlane((unsigned)v)); }
__device__ __forceinline__ void glds16s(const void* sbase, unsigned voff, unsigned lds_dst) { unsigned keep;
    asm volatile("s_mov_b32 %0, m0\n\ts_mov_b32 m0, %3\n\ts_nop 4\n\tglobal_load_lds_dwordx4 %1, %2\n\ts_mov_b32 m0, %0" : "=&s"(keep) : "v"(voff), "s"(sbase), "s"(lds_dst) : "memory"); }
typedef float f32x2_t __attribute__((ext_vector_type(2))); typedef __bf16 bf16x2_t __attribute__((ext_vector_type(2)));
__device__ __forceinline__ unsigned cvtpk(float lo, float hi) { f32x2_t v = {lo, hi}; bf16x2_t b = __builtin_convertvector(v, bf16x2_t); return __builtin_bit_cast(unsigned, b); }
__device__ __forceinline__ s16x4 vtr(ATT_LAS const char* p) { return __builtin_bit_cast(s16x4, __builtin_amdgcn_ds_read_tr16_b64_v4i16((ATT_LAS v4i16_t*)p)); }
__device__ __forceinline__ float swapsum(float m) { auto rr = __builtin_amdgcn_permlane32_swap(__float_as_uint(m), __float_as_uint(m), false, false); return __uint_as_float(rr[0]) + __uint_as_float(rr[1]); }

template <int DK>
__device__ __forceinline__ void attn_unit(const bf16_t* Qp, const bf16_t* Kp, const bf16_t* Vp, int i0, int t_lo, int t_hi, int win, int wskip, float slope2, float cref,
                                          bf16_t* Op, long ostride, float* lsep, long lstride, ATT_LAS unsigned char* lds, ATT_LAS float* wsbase, const int wv, unsigned* dbgp = nullptr) {
    constexpr int NKS = DK / 16;
    constexpr int NKW = DK / 64;
    const int lane = mk_lane(), r32 = lane & 31, hi = lane >> 5; const int wid = wv; const int tid = wid * 64 + lane;
    i0 = __builtin_amdgcn_readfirstlane(i0); t_lo = __builtin_amdgcn_readfirstlane(t_lo); t_hi = __builtin_amdgcn_readfirstlane(t_hi); win = __builtin_amdgcn_readfirstlane(win); wskip = __builtin_amdgcn_readfirstlane(wskip);
    const int half = ATT_HALF(wid);
    const int qrow = i0 + 32 * wid + r32, qmin_w = i0 + 32 * wid, qmax_w = qmin_w + 31;
    const unsigned lds0 = (unsigned)(uintptr_t)lds;
    ATT_LAS float* wsf = wsbase + wid * 64;
    const int NT = t_hi - t_lo;
    unsigned koff[NKW], voff[2];
#pragma unroll
    for (int i = 0; i < NKW; ++i) { const int p = wid + 8 * i;
        if (DK == 64) { const int r = 8 * p + (lane >> 3), pc = lane & 7; koff[i] = (unsigned)(r * 128 + ((pc ^ ((r >> 1) & 7)) << 4)); }
        else          { const int r = 4 * p + (lane >> 4), pc = lane & 15; koff[i] = (unsigned)(r * 256 + ((pc ^ (r & 15)) << 4)); } }
#pragma unroll
    for (int i = 0; i < 2; ++i) { const int p = wid + 8 * i, r = 4 * p + (lane >> 4), pc = lane & 15; voff[i] = (unsigned)(r * 256 + ((pc ^ (((r & 3) << 2) | ((r >> 2) & 3))) << 4)); }
    constexpr long ktile = 64L * DK, vtile = 64L * 128;
#define ATT_DMA(t, slot) do { \
        _Pragma("unroll") for (int d_ = 0; d_ < ATT_KDUP; ++d_) _Pragma("unroll") for (int i_ = 0; i_ < NKW; ++i_) glds16s(uniform_ptr(Kp + (long)(t) * ktile), koff[i_], (unsigned)__builtin_amdgcn_readfirstlane(lds0 + (slot) * RSLOT + (wid + 8 * i_) * 1024)); \
        _Pragma("unroll") for (int i_ = 0; i_ < 2; ++i_)   glds16s(uniform_ptr(Vp + (long)(t) * vtile), voff[i_], (unsigned)__builtin_amdgcn_readfirstlane(lds0 + (slot) * RSLOT + SLOT + (wid + 8 * i_) * 1024)); } while (0)
#define ATT_NEED(t) (!(64 * (t) > qmax_w || 64 * (t) + 63 < qmin_w - wskip))
    ATT_DMA(t_lo, 0);
    if (NT > 1) ATT_DMA(t_lo + 1, 1);
    bf16x8 qr[NKS];
#pragma unroll
    for (int d0 = 0; d0 < NKS; ++d0) qr[d0] = *reinterpret_cast<const bf16x8*>(Qp + (long)qrow * DK + d0 * 16 + hi * 8);
    float l_run = 0.f;
    f32x16 o[4];
#pragma unroll
    for (int d = 0; d < 4; ++d)
#pragma unroll
        for (int r = 0; r < 16; ++r) o[d][r] = 0.f;
    f32x16 p0, p1; bf16x8 pa[4];
#pragma unroll
    for (int r = 0; r < 16; ++r) { p0[r] = 0.f; p1[r] = 0.f; }
#pragma unroll
    for (int i = 0; i < 4; ++i) pa[i] = (bf16x8){0, 0, 0, 0, 0, 0, 0, 0};
    const int ksw = (DK == 64) ? ((r32 >> 1) & 7) : (r32 & 15);
    const unsigned kbx = (unsigned)(r32 * (DK * 2) + ((hi ^ (ksw & 1)) << 4) + ((ksw >> 1) << 5));
    const int vq = (lane & 15) >> 2, vpp = lane & 3, vblk = (lane >> 4) & 1;
    const unsigned vbx = (unsigned)(SLOT + 1024 * hi + 256 * vq + 8 * (vpp & 1) + 64 * vq + 16 * ((2 * vblk + (vpp >> 1)) ^ hi));
    ATT_LAS const char* const ldsc = (ATT_LAS const char*)lds;
    if (NT > 1) { if (NKW * ATT_KDUP == 1) asm volatile("s_waitcnt vmcnt(3)" ::: "memory"); else if (NKW * ATT_KDUP == 2) asm volatile("s_waitcnt vmcnt(4)" ::: "memory"); else asm volatile("s_waitcnt vmcnt(6)" ::: "memory"); } else asm volatile("s_waitcnt vmcnt(0)" ::: "memory");
    asm volatile("s_waitcnt lgkmcnt(0)\n\ts_barrier" ::: "memory");
#pragma unroll
    for (int d0 = 0; d0 < NKS; ++d0) asm volatile("" : "+v"(qr[d0]));
#if ATT_SIMPLE
#define ATT_QK(tr_) do { const int t_ = t_lo + (tr_); \
        const float tb = slope2 * (float)(64 * t_ + 4 * hi - qrow) - cref; \
        _Pragma("unroll") for (int r = 0; r < 16; ++r) { p0[r] = __builtin_fmaf(slope2, (float)((r & 3) + 8 * (r >> 2)), tb); p1[r] = __builtin_fmaf(slope2, (float)(32 + (r & 3) + 8 * (r >> 2)), tb); } \
        unsigned kb_ = kbx + ((tr_) & 3) * RSLOT; asm volatile("" : "+v"(kb_)); \
        _Pragma("unroll") for (int blk = 0; blk < NKS / 4; ++blk) { \
            unsigned ka[4]; \
            _Pragma("unroll") for (int j = 0; j < 4; ++j) ka[j] = kb_ ^ (unsigned)(32 * (4 * blk + j)); \
            bf16x8 kb0[4], kb1[4]; \
            _Pragma("unroll") for (int j = 0; j < 4; ++j) { ATT_LAS const char* kp = ldsc + ka[j]; kb0[j] = *(ATT_LAS const bf16x8*)kp; kb1[j] = *(ATT_LAS const bf16x8*)(kp + 32 * DK * 2); } \
            __builtin_amdgcn_sched_barrier(0); if (ATT_PRIO) __builtin_amdgcn_s_setprio(1); \
            _Pragma("unroll") for (int j = 0; j < 4; ++j) { p0 = __builtin_amdgcn_mfma_f32_32x32x16_bf16(kb0[j], qr[4 * blk + j], p0, 0, 0, 0); p1 = __builtin_amdgcn_mfma_f32_32x32x16_bf16(kb1[j], qr[4 * blk + j], p1, 0, 0, 0); } \
            if (ATT_PRIO) __builtin_amdgcn_s_setprio(0); __builtin_amdgcn_sched_barrier(0); } } while (0)
#define ATT_SM(tr_) do { const int t_ = t_lo + (tr_); \
        if (64 * t_ + 63 > qmin_w || 64 * t_ < qmax_w - win) {        \
            const int dq = qrow - 64 * t_ - 4 * hi; const unsigned uw = (unsigned)win; \
            _Pragma("unroll") for (int r = 0; r < 16; ++r) { const int c = (r & 3) + 8 * (r >> 2); \
                if ((unsigned)(dq - c) > uw) p0[r] = -INFINITY; if ((unsigned)(dq - c - 32) > uw) p1[r] = -INFINITY; } } \
        float sa = 0.f, sb = 0.f, sc = 0.f, sd = 0.f; \
        _Pragma("unroll") for (int r = 0; r < 16; r += 2) { p0[r] = __builtin_amdgcn_exp2f(p0[r]); p0[r + 1] = __builtin_amdgcn_exp2f(p0[r + 1]); p1[r] = __builtin_amdgcn_exp2f(p1[r]); p1[r + 1] = __builtin_amdgcn_exp2f(p1[r + 1]); \
            sa += p0[r]; sb += p0[r + 1]; sc += p1[r]; sd += p1[r + 1]; } \
        l_run += (sa + sb) + (sc + sd); \
        u32x4 w; \
        w.x = cvtpk(p0[0], p0[1]); w.y = cvtpk(p0[2], p0[3]); w.z = cvtpk(p0[4], p0[5]); w.w = cvtpk(p0[6], p0[7]); pa[0] = __builtin_bit_cast(bf16x8, w); \
        w.x = cvtpk(p0[8], p0[9]); w.y = cvtpk(p0[10], p0[11]); w.z = cvtpk(p0[12], p0[13]); w.w = cvtpk(p0[14], p0[15]); pa[1] = __builtin_bit_cast(bf16x8, w); \
        w.x = cvtpk(p1[0], p1[1]); w.y = cvtpk(p1[2], p1[3]); w.z = cvtpk(p1[4], p1[5]); w.w = cvtpk(p1[6], p1[7]); pa[2] = __builtin_bit_cast(bf16x8, w); \
        w.x = cvtpk(p1[8], p1[9]); w.y = cvtpk(p1[10], p1[11]); w.z = cvtpk(p1[12], p1[13]); w.w = cvtpk(p1[14], p1[15]); pa[3] = __builtin_bit_cast(bf16x8, w); } while (0)
#define ATT_PV(tr_) do { unsigned vb_ = vbx + ((tr_) & 3) * RSLOT; asm volatile("" : "+v"(vb_)); if (ATT_PRIO) __builtin_amdgcn_s_setprio(1); \
        s16x4 vl[16], vh[16]; \
        _Pragma("unroll") for (int i = 0; i < 16; ++i) { vl[i] = vtr(ldsc + (vb_ ^ (unsigned)(64 * (i >> 2))) + (i & 3) * 4096); vh[i] = vtr(ldsc + (vb_ ^ (unsigned)(64 * (i >> 2) + 32)) + (i & 3) * 4096 + 2048); } \
        _Pragma("unroll") for (int i = 0; i < 16; ++i) { \
            const bf16x8 vf = (bf16x8){vl[i][0], vl[i][1], vl[i][2], vl[i][3], vh[i][0], vh[i][1], vh[i][2], vh[i][3]}; \
            o[i >> 2] = __builtin_amdgcn_mfma_f32_32x32x16_bf16(pa[i & 3], vf, o[i >> 2], 0, 0, 0); } \
        __builtin_amdgcn_sched_group_barrier(0x100, 8, 0); \
        _Pragma("unroll") for (int i = 0; i < 12; ++i) { __builtin_amdgcn_sched_group_barrier(0x8, 1, 0); __builtin_amdgcn_sched_group_barrier(0x100, 2, 0); } \
        _Pragma("unroll") for (int i = 0; i < 4; ++i) __builtin_amdgcn_sched_group_barrier(0x8, 1, 0); if (ATT_PRIO) __builtin_amdgcn_s_setprio(0); } while (0)
#if ATT_SIMPLE == 3
    if (half) asm volatile("s_waitcnt lgkmcnt(0)\n\ts_barrier" ::: "memory");
    for (int tr = 0; tr <= NT; ++tr) {
        if (tr + 2 < NT) ATT_DMA(t_lo + tr + 2, (tr + 2) & 3);
        if (tr > 0 && ATT_NEED(t_lo + tr - 1)) { ATT_PV(tr - 1); }
        if (tr < NT && ATT_NEED(t_lo + tr)) { ATT_QK(tr); }
        if (tr + 2 < NT) { if (NKW == 1) asm volatile("s_waitcnt vmcnt(3)" ::: "memory"); else asm volatile("s_waitcnt vmcnt(4)" ::: "memory"); } else asm volatile("s_waitcnt vmcnt(0)" ::: "memory");
        asm volatile("s_waitcnt lgkmcnt(0)\n\ts_barrier" ::: "memory");
        if (tr == NT) break;
        if (ATT_NEED(t_lo + tr)) { ATT_SM(tr); }
        asm volatile("s_waitcnt lgkmcnt(0)\n\ts_barrier" ::: "memory");
    }
    if (!half) asm volatile("s_waitcnt lgkmcnt(0)\n\ts_barrier" ::: "memory");
#elif ATT_SIMPLE == 2
    for (int tr = 0; tr < NT; ++tr) {
        if (tr + 1 < NT) { if (NKW == 1) asm volatile("s_waitcnt vmcnt(3)" ::: "memory"); else asm volatile("s_waitcnt vmcnt(4)" ::: "memory"); } else asm volatile("s_waitcnt vmcnt(0)" ::: "memory");
        asm volatile("s_waitcnt lgkmcnt(0)\n\ts_barrier" ::: "memory");
        if (tr + 2 < NT) ATT_DMA(t_lo + tr + 2, (tr + 2) & 3);
        if (half == 0) {
            if (ATT_NEED(t_lo + tr)) { ATT_QK(tr); ATT_SM(tr); ATT_PV(tr); }
        } else {
            if (tr > 0 && ATT_NEED(t_lo + tr - 1)) { ATT_SM(tr - 1); ATT_PV(tr - 1); }
            if (ATT_NEED(t_lo + tr)) { ATT_QK(tr); }
        }
    }
    if (half != 0 && ATT_NEED(t_lo + NT - 1)) { ATT_SM(NT - 1); ATT_PV(NT - 1); }
#else
    for (int tp = 0; tp < NT; tp += 2) {
        asm volatile("s_waitcnt vmcnt(0)" ::: "memory");
        asm volatile("s_waitcnt lgkmcnt(0)\n\ts_barrier" ::: "memory");
        if (tp + 2 < NT) ATT_DMA(t_lo + tp + 2, (tp + 2) & 3);
        if (tp + 3 < NT) ATT_DMA(t_lo + tp + 3, (tp + 3) & 3);
#pragma unroll 1
        for (int sub = 0; sub < 2; ++sub) { const int tr = tp + sub; if (tr >= NT || !ATT_NEED(t_lo + tr)) continue; ATT_QK(tr); ATT_SM(tr); ATT_PV(tr); }
    }
#endif
#undef ATT_QK
#undef ATT_SM
#undef ATT_PV
    asm volatile("s_waitcnt vmcnt(0) lgkmcnt(0)\n\ts_barrier" ::: "memory");
#else
    const int nslots = 2 * NT + 2;
#if MK_DBG
    unsigned long long dbg_t0 = __builtin_amdgcn_s_memtime(), dbg_w = 0, dbg_a = 0, dbg_b = 0;
#endif
    for (int s = 0; s < nslots; ++s) {
        if ((s & 1) == 0) { const int tt = s >> 1; if (tt + 2 < NT) ATT_DMA(t_lo + tt + 2, (tt + 2) & 3); }
        const int k = s - half;
#if MK_DBG
        const unsigned long long dbg_pp = __builtin_amdgcn_s_memtime();
#endif
        if (k >= 0 && k <= 2 * NT) {
            const int tr = k >> 1, t = t_lo + tr;
            if ((k & 1) == 0) {
                const bool doqk = (tr < NT) && ATT_NEED(t), dopv = (tr >= 1) && ATT_NEED(t - 1);
                if (dopv) {
                    unsigned vb_ = vbx + ((tr - 1) & 3) * RSLOT; asm volatile("" : "+v"(vb_));
                    s16x4 vl[16], vh[16];
#pragma unroll
                    for (int i = 0; i < 16; ++i) { vl[i] = vtr(ldsc + (vb_ ^ (unsigned)(64 * (i >> 2))) + (i & 3) * 4096); vh[i] = vtr(ldsc + (vb_ ^ (unsigned)(64 * (i >> 2) + 32)) + (i & 3) * 4096 + 2048); }
#pragma unroll
                    for (int i = 0; i < 16; ++i) {
                        const bf16x8 vf = (bf16x8){vl[i][0], vl[i][1], vl[i][2], vl[i][3], vh[i][0], vh[i][1], vh[i][2], vh[i][3]};
                        o[i >> 2] = __builtin_amdgcn_mfma_f32_32x32x16_bf16(pa[i & 3], vf, o[i >> 2], 0, 0, 0); }
                    __builtin_amdgcn_sched_group_barrier(0x100, 8, 0);
#pragma unroll
                    for (int i = 0; i < 12; ++i) { __builtin_amdgcn_sched_group_barrier(0x8, 1, 0); __builtin_amdgcn_sched_group_barrier(0x100, 2, 0); }
#pragma unroll
                    for (int i = 0; i < 4; ++i) __builtin_amdgcn_sched_group_barrier(0x8, 1, 0);
                }
                __builtin_amdgcn_sched_barrier(0);
                if (doqk) {
                    const float tb = slope2 * (float)(64 * t + 4 * hi - qrow) - cref;
#pragma unroll
                    for (int r = 0; r < 16; ++r) { p0[r] = __builtin_fmaf(slope2, (float)((r & 3) + 8 * (r >> 2)), tb); p1[r] = __builtin_fmaf(slope2, (float)(32 + (r & 3) + 8 * (r >> 2)), tb); }
                    unsigned kb_ = kbx + (tr & 3) * RSLOT; asm volatile("" : "+v"(kb_));
#pragma unroll
                    for (int blk = 0; blk < NKS / 4; ++blk) {
                        unsigned ka[4];
#pragma unroll
                        for (int j = 0; j < 4; ++j) ka[j] = kb_ ^ (unsigned)(32 * (4 * blk + j));
                        bf16x8 kb0[4], kb1[4];
#pragma unroll
                        for (int j = 0; j < 4; ++j) { ATT_LAS const char* kp = ldsc + ka[j]; kb0[j] = *(ATT_LAS const bf16x8*)kp; kb1[j] = *(ATT_LAS const bf16x8*)(kp + 32 * DK * 2); }
                        __builtin_amdgcn_sched_barrier(0);
#pragma unroll
                        for (int j = 0; j < 4; ++j) { p0 = __builtin_amdgcn_mfma_f32_32x32x16_bf16(kb0[j], qr[4 * blk + j], p0, 0, 0, 0); p1 = __builtin_amdgcn_mfma_f32_32x32x16_bf16(kb1[j], qr[4 * blk + j], p1, 0, 0, 0); }
                        __builtin_amdgcn_sched_barrier(0);
                    }
                }
            } else if (tr < NT && ATT_NEED(t)) {
                if (64 * t + 63 > qmin_w || 64 * t < qmax_w - win) {
                    const int kb = 64 * t + 4 * hi, lo = qrow - win;
#pragma unroll
                    for (int r = 0; r < 16; ++r) { const int kv = kb + (r & 3) + 8 * (r >> 2);
                        if (kv > qrow || kv < lo) p0[r] = -INFINITY; if (kv + 32 > qrow || kv + 32 < lo) p1[r] = -INFINITY; }
                }
                float sa = 0.f, sb = 0.f, sc = 0.f, sd = 0.f;
#pragma unroll
                for (int r = 0; r < 16; r += 2) { p0[r] = __builtin_amdgcn_exp2f(p0[r]); p0[r + 1] = __builtin_amdgcn_exp2f(p0[r + 1]); p1[r] = __builtin_amdgcn_exp2f(p1[r]); p1[r + 1] = __builtin_amdgcn_exp2f(p1[r + 1]);
                    sa += p0[r]; sb += p0[r + 1]; sc += p1[r]; sd += p1[r + 1]; }
                l_run += (sa + sb) + (sc + sd);
                { u32x4 w;
                  w.x = cvtpk(p0[0], p0[1]); w.y = cvtpk(p0[2], p0[3]); w.z = cvtpk(p0[4], p0[5]); w.w = cvtpk(p0[6], p0[7]); pa[0] = __builtin_bit_cast(bf16x8, w);
                  w.x = cvtpk(p0[8], p0[9]); w.y = cvtpk(p0[10], p0[11]); w.z = cvtpk(p0[12], p0[13]); w.w = cvtpk(p0[14], p0[15]); pa[1] = __builtin_bit_cast(bf16x8, w);
                  w.x = cvtpk(p1[0], p1[1]); w.y = cvtpk(p1[2], p1[3]); w.z = cvtpk(p1[4], p1[5]); w.w = cvtpk(p1[6], p1[7]); pa[2] = __builtin_bit_cast(bf16x8, w);
                  w.x = cvtpk(p1[8], p1[9]); w.y = cvtpk(p1[10], p1[11]); w.z = cvtpk(p1[12], p1[13]); w.w = cvtpk(p1[14], p1[15]); pa[3] = __builtin_bit_cast(bf16x8, w); }
            }
        }
#if MK_DBG
        const unsigned long long dbg_t1 = __builtin_amdgcn_s_memtime();
        if (k >= 0 && k <= 2 * NT) { if ((k & 1) == 0) dbg_a += dbg_t1 - dbg_pp; else dbg_b += dbg_t1 - dbg_pp; }
#endif
        if (s & 1) { if ((s >> 1) + 2 < NT) { if (NKW * ATT_KDUP == 1) asm volatile("s_waitcnt vmcnt(3)" ::: "memory"); else if (NKW * ATT_KDUP == 2) asm volatile("s_waitcnt vmcnt(4)" ::: "memory"); else asm volatile("s_waitcnt vmcnt(6)" ::: "memory"); } else asm volatile("s_waitcnt vmcnt(0)" ::: "memory"); }
        asm volatile("s_waitcnt lgkmcnt(0)\n\ts_barrier" ::: "memory");
#if MK_DBG
        dbg_w += __builtin_amdgcn_s_memtime() - dbg_t1;
#endif
    }
#if MK_DBG
    if (dbgp != nullptr && tid == 0) { const unsigned long long tt = __builtin_amdgcn_s_memtime() - dbg_t0; dbgp[0] = (unsigned)(tt / (unsigned long long)nslots); dbgp[1] = (unsigned)(dbg_w / (unsigned long long)nslots); dbgp[2] = (unsigned)nslots; dbgp[3] = (unsigned)(dbg_a / (unsigned long long)(NT + 1)); dbgp[4] = (unsigned)(dbg_b / (unsigned long long)NT); }
#endif
#endif
#undef ATT_DMA
#undef ATT_NEED
    int lane_e = lane; asm volatile("" : "+v"(lane_e));
    const int r32e = lane_e & 31, hie = lane_e >> 5;
    const float l_tot = swapsum(l_run);
    if (hie == 0) wsf[32 + r32e] = l_tot;
    if (lsep != nullptr && hie == 0) lsep[(long)(i0 + 32 * wid + r32e) * lstride] = __builtin_amdgcn_logf(l_tot) + cref;
    {
        ATT_LAS unsigned short* stg = (ATT_LAS unsigned short*)(lds + wid * 8192);
#pragma unroll
        for (int r = 0; r < 16; ++r) { const int orow = crow(r, hie); const float rl = __builtin_amdgcn_rcpf(wsf[32 + orow]);
#pragma unroll
            for (int d0 = 0; d0 < 4; ++d0) stg[orow * 128 + d0 * 32 + r32e] = (unsigned short)(cvtpk(o[d0][r] * rl, 0.f) & 0xffffu); }
        asm volatile("s_waitcnt lgkmcnt(0)" ::: "memory");
        bf16_t* Ow = Op + (long)(i0 + 32 * wid) * ostride;
#pragma unroll
        for (int i = 0; i < 8; ++i) { const int row = i * 4 + (lane_e >> 4), ch = lane_e & 15; const u32x4 v = *(ATT_LAS const u32x4*)(stg + row * 128 + ch * 8); *(u32x4*)(Ow + (long)row * ostride + ch * 8) = v; }
    }
    asm volatile("s_waitcnt lgkmcnt(0)\n\ts_barrier" ::: "memory");
}
}
constexpr int NWAVES = 8;
constexpr int BATCH = 2, SEQ = 8192, DM = 2048, M = BATCH * SEQ;
constexpr int NIN = 11776;
#ifndef MK_NINP
#define MK_NINP 11776
#endif
constexpr int NINP = MK_NINP;
constexpr int C_DAQ = 0, C_DAK = 1024, C_DAV = 2048, C_DLQ = 3072, C_DLK = 4608, C_DLV = 6144, C_GA = 7680, C_GB = 9728;
constexpr int NE = 32, DFF = 1024, TK = 2 * M;
constexpr int XS_ROWS = TK + NE * 256;
constexpr float EPS = 1e-6f, LOG2E = 1.4426950408889634f;
constexpr float LAM_INIT = 0.2f;

#ifndef MK_N_LAUNCHES
#define MK_N_LAUNCHES 1
#endif
constexpr int N_PHASES = 12;
#ifndef MK_DBG_Q
#define MK_DBG_Q 250u
#endif
#ifndef MK_DBG_THR
#define MK_DBG_THR 0u
#endif
#ifndef MK_DBG_UNIT
#define MK_DBG_UNIT 0
#endif
#ifndef MK_SPLIT_AT
#define MK_SPLIT_AT (-1)
#endif
#ifndef MK_REPEAT_SUB
#define MK_REPEAT_SUB 3
#endif

constexpr size_t MiB = 1u << 20;
constexpr size_t WS_CTL = 0, CTL_ZERO_BYTES = 256 * 1024;
constexpr size_t WS_WR   = 1 * MiB;
constexpr size_t WS_GAIN = 1 * MiB + 512 * 1024;
constexpr size_t WS_ROUTE = 2 * MiB;
constexpr size_t WS_LSE  = 3 * MiB;
constexpr size_t WS_WIN  = 4 * MiB;
constexpr size_t WS_WIN8 = 36 * MiB;
constexpr size_t WS_XN8  = 672 * MiB;
constexpr size_t WS_WA   = 50 * MiB;
constexpr size_t WS_WB   = 54 * MiB;
constexpr size_t WS_WO   = 56 * MiB;
constexpr size_t WS_WGU  = 64 * MiB;
constexpr size_t WS_WD   = 320 * MiB;
constexpr size_t WS_XN   = 448 * MiB;
constexpr size_t WS_ODA  = 512 * MiB;
constexpr size_t WS_ODL  = 576 * MiB;
constexpr size_t WS_OA   = 624 * MiB;
constexpr size_t WS_OB   = 656 * MiB;
constexpr size_t WS_MIX  = 672 * MiB;
constexpr size_t WS_PROJ = 736 * MiB;
constexpr size_t WS_XS   = WS_PROJ;
constexpr size_t WS_Y8   = WS_PROJ + 240 * MiB;
constexpr size_t WS_HB   = WS_PROJ + 160 * MiB;
constexpr size_t WS_LIST = WS_PROJ + 376 * MiB;
constexpr size_t WS_RSL  = WS_LIST + 2 * MiB;
constexpr size_t WS_END  = WS_RSL + 2 * MiB;
static_assert((size_t)XS_ROWS * 2048 * 2 <= 160 * MiB && (size_t)XS_ROWS * 1024 * 2 <= 80 * MiB && (size_t)M * NINP * 2 <= 376 * MiB, "ws map");
constexpr int CW_TMO = 0, CW_CODE = 1;
constexpr int CW_BAR = 4096;
constexpr int CW_CNT = 16384, CW_FILL = 16384 + 64;
static_assert(true, "");
constexpr int CW_TQ = 24576;
constexpr int CW_DBG = 20480;
constexpr int CW_QUEUE = 20544;

constexpr int RING_OFF = 0, RING_BYTES = 131072;
constexpr int LDSCTL_OFF = RING_BYTES, MISC_OFF = LDSCTL_OFF + 320;
constexpr int TILE_E_OFF = LDSCTL_OFF + 1024;
constexpr int XCH_OFF = LDSCTL_OFF + 2048;
constexpr int LDS_BYTES = 147456;
static_assert(XCH_OFF + 8192 <= LDS_BYTES && att::ATT_LDS_BYTES <= RING_BYTES, "LDS map");

#define GAS __attribute__((address_space(1)))
#define LAS __attribute__((address_space(3)))
typedef unsigned short bf16;
typedef unsigned v4u __attribute__((ext_vector_type(4)));
typedef float f32x4 __attribute__((ext_vector_type(4)));
typedef short bf16x8 __attribute__((ext_vector_type(8)));
typedef GAS unsigned gu32;
typedef GAS unsigned long long gu64;
#define RLX_AGENT __ATOMIC_RELAXED, __HIP_MEMORY_SCOPE_AGENT
#define LDS_WAIT() asm volatile("s_waitcnt lgkmcnt(0)" ::: "memory")
#define VM_WAIT() asm volatile("s_waitcnt vmcnt(0)" ::: "memory")
__device__ __forceinline__ unsigned long long rt() { return __builtin_amdgcn_s_memrealtime(); }
__device__ __forceinline__ unsigned f2bf(float f) { unsigned u = __builtin_bit_cast(unsigned, f); return (u + 0x7fffu + ((u >> 16) & 1u)) >> 16; }
__device__ __forceinline__ unsigned pk2(float lo, float hi) { return f2bf(lo) | (f2bf(hi) << 16); }

#define XB_TMO      128
#define XB_XCNT(j)  (256  + 64 * (j))
#define XB_XSUB(j)  (1280 + 64 * (j))
#define XB_XGEN(j)  (2304 + 64 * (j))
#define XB_TOP      3328
#define XB_TOPGEN   3392
#define XCD_BAR_WORDS 3456
#define XB_SPIN_CAP (1u << 18)

__device__ __forceinline__ unsigned xb_ld(unsigned* p)              { return __hip_atomic_load(p, __ATOMIC_RELAXED, __HIP_MEMORY_SCOPE_AGENT); }
__device__ __forceinline__ unsigned xb_add(unsigned* p, unsigned v) { return __hip_atomic_fetch_add(p, v, __ATOMIC_RELAXED, __HIP_MEMORY_SCOPE_AGENT); }
__device__ __forceinline__ unsigned xb_xcc_id() { return (unsigned)__builtin_amdgcn_s_getreg((3 << 11) | 20) & 0xFu; }
#define XB_SPIN(cond, bar) do { unsigned _sp = 0; while (cond) { __builtin_amdgcn_s_sleep(1); \
    if ((++_sp & 255u) == 0u) { if (xb_ld(&(bar)[XB_TMO])) break; if (_sp > XB_SPIN_CAP) { atomicAdd(&(bar)[XB_TMO], 1u); break; } } } } while (0)

struct XcdBarrier {
    unsigned* bar; unsigned x; unsigned w0;
    volatile LAS unsigned* st;
};

__device__ __forceinline__ XcdBarrier xcd_barrier_post(unsigned* bar, volatile LAS unsigned* st, unsigned w0) {
    XcdBarrier b; b.bar = bar; b.x = xb_xcc_id(); b.st = st; b.w0 = w0;
    if (w0 && mk_lane() == 0) (void)xb_add(&bar[XB_XCNT(b.x)], 1u);
    return b;
}
__device__ __forceinline__ void xcd_barrier_complete(unsigned* bar, unsigned x, unsigned& nloc, unsigned& nx) {
    const unsigned G = gridDim.x * gridDim.y * gridDim.z;
    unsigned sum, cnt, mine, sp = 0u;
    for (;;) {
        sum = 0u; cnt = 0u; mine = 0u;
#pragma unroll
        for (unsigned j = 0; j < 16; ++j) { const unsigned c = xb_ld(&bar[XB_XCNT(j)]); sum += c; cnt += (c > 0u) ? 1u : 0u; mine = (j == x) ? c : mine; }
        if (sum == G) break;
        __builtin_amdgcn_s_sleep(1);
        if ((++sp & 255u) == 0u) { if (xb_ld(&bar[XB_TMO])) break; if (sp > XB_SPIN_CAP) { atomicAdd(&bar[XB_TMO], 1u); break; } }
    }
    nloc = mine > 0u ? mine : 1u; nx = cnt > 0u ? cnt : 1u;
}

__device__ __forceinline__ void xcd_barrier(const XcdBarrier& b) {
    asm volatile("s_waitcnt vmcnt(0)" ::: "memory");
    __syncthreads();
    if (b.w0 && mk_lane() == 0) {
        unsigned* bar = b.bar;
        __builtin_amdgcn_s_waitcnt(0);
        unsigned nloc = b.st[0], nx = b.st[1];
        if (nloc == 0u) { xcd_barrier_complete(bar, b.x, nloc, nx); b.st[0] = nloc; b.st[1] = nx; }
        const unsigned old = xb_add(&bar[XB_XSUB(b.x)], 1u);
        const unsigned gen = old / nloc;
        if (old + 1u == (gen + 1u) * nloc) {
            __builtin_amdgcn_fence(__ATOMIC_RELEASE, "agent");
            asm volatile("s_waitcnt vmcnt(0)" ::: "memory");
            const unsigned og = xb_add(&bar[XB_TOP], 1u);
            const unsigned tg = og / nx;
            if (og + 1u == (tg + 1u) * nx) xb_add(&bar[XB_TOPGEN], 1u);
            else XB_SPIN(xb_ld(&bar[XB_TOPGEN]) == tg, bar);
            __builtin_amdgcn_fence(__ATOMIC_ACQUIRE, "agent");
            xb_add(&bar[XB_XGEN(b.x)], 1u);
            asm volatile("s_waitcnt vmcnt(0)" ::: "memory");
        } else {
            XB_SPIN(xb_ld(&bar[XB_XGEN(b.x)]) == gen, bar);
            __builtin_amdgcn_fence(__ATOMIC_ACQUIRE, "agent");
            asm volatile("s_waitcnt vmcnt(0)" ::: "memory");
        }
    }
    __syncthreads();
}
struct Args { const float* in[18]; float* out; unsigned char* ws; int ph_lo, ph_hi, li, sub; };
struct Frame {
    const Args* ka;
    LAS unsigned char* lds;
    volatile LAS unsigned* MISC;
    gu32* ctl;
    int wave;
    int vcu, G, li;
    unsigned char* ws;
    float* out;
};
__device__ __forceinline__ float wave_sum(float v) {
#pragma unroll
    for (int o = 1; o < 64; o <<= 1) v += __shfl_xor(v, o);
    return v;
}
__device__ __forceinline__ void p0_transpose_item(const float* W, int K, int N, bf16* WT, int k0, int n0, int dst_row0, LAS unsigned char* scr, int lane, int kdst = -1) {
    if (kdst < 0) kdst = k0;
    const int q = lane >> 4, m = lane & 15;
    const GAS f32x4* src = (const GAS f32x4*)(W + (size_t)(k0 + 2 * q) * N + n0) + m;
    f32x4 v[16];
#pragma unroll
    for (int i = 0; i < 16; ++i) v[i] = src[((size_t)(8 * (i >> 1) + (i & 1)) * N) >> 2];
#pragma unroll
    for (int j = 0; j < 8; ++j) {
#pragma unroll
        for (int c = 0; c < 4; ++c) {
            const int n = 4 * m + c, col = (4 * j + q) ^ ((m & 7) << 2);
            *(LAS unsigned*)(scr + n * 128 + col * 4) = pg8::cvt_pk_bf16(v[2 * j][c], v[2 * j + 1][c]);
        }
    }
    LDS_WAIT(); asm volatile("" ::: "memory");
    const int ch = lane & 7;
#pragma unroll
    for (int i = 0; i < 8; ++i) { const int n = 8 * i + (lane >> 3);
        const v4u o = *(const LAS v4u*)(scr + n * 128 + ((ch ^ ((n >> 2) & 7)) << 4));
        *(GAS v4u*)(WT + (size_t)(dst_row0 + n) * K + kdst + 8 * ch) = o; }
    LDS_WAIT(); asm volatile("" ::: "memory");
}
__device__ __forceinline__ void p0_item_load(const float* W, int N, int k0, int n0, int lane, f32x4 (&v)[16]) {
    const int q = lane >> 4, m = lane & 15;
    const GAS f32x4* src = (const GAS f32x4*)(W + (size_t)(k0 + 2 * q) * N + n0) + m;
#pragma unroll
    for (int i = 0; i < 16; ++i) v[i] = src[((size_t)(8 * (i >> 1) + (i & 1)) * N) >> 2];
}
__device__ __forceinline__ void p0_item_store(const f32x4 (&v)[16], int K, bf16* WT, int k0, int dst_row0, LAS unsigned char* scr, int lane) {
    const int q = lane >> 4, m = lane & 15;
#pragma unroll
    for (int j = 0; j < 8; ++j) {
#pragma unroll
        for (int c = 0; c < 4; ++c) {
            const int n = 4 * m + c, col = (4 * j + q) ^ ((m & 7) << 2);
            *(LAS unsigned*)(scr + n * 128 + col * 4) = pg8::cvt_pk_bf16(v[2 * j][c], v[2 * j + 1][c]);
        }
    }
    LDS_WAIT(); asm volatile("" ::: "memory");
    const int ch = lane & 7;
#pragma unroll
    for (int i = 0; i < 8; ++i) { const int n = 8 * i + (lane >> 3);
        const v4u o = *(const LAS v4u*)(scr + n * 128 + ((ch ^ ((n >> 2) & 7)) << 4));
        *(GAS v4u*)(WT + (size_t)(dst_row0 + n) * K + k0 + 8 * ch) = o; }
    LDS_WAIT(); asm volatile("" ::: "memory");
}
__device__ __forceinline__ void p0_item_store_fp8(const f32x4 (&v)[16], int K, unsigned char* WT, int k0, int dst_row0, LAS unsigned char* scr, int lane) {
    const int q = lane >> 4, m = lane & 15;
#pragma unroll
    for (int j = 0; j < 8; ++j) {
#pragma unroll
        for (int c = 0; c < 4; ++c) {
            const int n = 4 * m + c, kb = 8 * j + 2 * q;
            const int p = __builtin_amdgcn_cvt_pk_fp8_f32(v[2 * j][c] * pg8::WSCALE, v[2 * j + 1][c] * pg8::WSCALE, 0, false);
            *(LAS unsigned short*)(scr + n * 64 + ((((kb >> 4) ^ (m & 3)) << 4) | (kb & 15))) = (unsigned short)p;
        }
    }
    LDS_WAIT(); asm volatile("" ::: "memory");
    const int ch = lane & 3;
#pragma unroll
    for (int i = 0; i < 4; ++i) { const int n = 16 * i + (lane >> 2);
        const v4u o = *(const LAS v4u*)(scr + n * 64 + ((ch ^ ((n >> 2) & 3)) << 4));
        *(GAS v4u*)(WT + (size_t)(dst_row0 + n) * K + k0 + 16 * ch) = o; }
    LDS_WAIT(); asm volatile("" ::: "memory");
}
struct MoeItem { const float* W; bf16* WT; int K, N, k0, n0, drow, f8; };
__device__ __forceinline__ MoeItem moe_item(Frame& F, int r) {
    constexpr int I_GU1 = (DM / 64) * (2048 / 64), I_GU = NE * I_GU1, I_D1 = (DFF / 64) * (DM / 64);
    MoeItem it;
    if (r < I_GU) { const int e = r / I_GU1, q = r % I_GU1, nblk = 2048 / 64, kb = q / nblk, nb = q % nblk, n0 = 64 * nb, j = n0 & 1023, up = n0 >> 10;
        it.W = F.ka->in[16] + (size_t)e * DM * 2048; it.WT = (bf16*)(F.ws + WS_WGU + (size_t)e * 2048 * DM); it.K = DM; it.N = 2048; it.k0 = 64 * kb; it.n0 = n0; it.drow = 256 * (j >> 7) + 128 * up + (j & 127); it.f8 = 1; }
    else { r -= I_GU; const int e = r / I_D1, q = r % I_D1, nblk = DM / 64, kb = q / nblk, nb = q % nblk;
        it.W = F.ka->in[17] + (size_t)e * DFF * DM; it.WT = (bf16*)(F.ws + WS_WD + (size_t)e * DM * DFF); it.K = DFF; it.N = DM; it.k0 = 64 * kb; it.n0 = 64 * nb; it.drow = 64 * nb; it.f8 = 1; }
    return it;
}
__device__ __forceinline__ void p0_moe_weights(Frame& F, int gw, int NGW) {
    constexpr int NIT = NE * ((DM / 64) * (2048 / 64) + (DFF / 64) * (DM / 64));
    LAS unsigned char* scr = F.lds + RING_OFF + F.wave * 8192;
    f32x4 va[16], vb[16];
    int r = gw;
    if (r < NIT) { const MoeItem a = moe_item(F, r); p0_item_load(a.W, a.N, a.k0, a.n0, mk_lane(), va); }
    for (; r < NIT; r += 2 * NGW) {
        const MoeItem a = moe_item(F, r);
        const bool hb = r + NGW < NIT; MoeItem b = a;
        if (hb) { b = moe_item(F, r + NGW); p0_item_load(b.W, b.N, b.k0, b.n0, mk_lane(), vb); }
        if (a.f8) p0_item_store_fp8(va, a.K, (unsigned char*)a.WT, a.k0, a.drow, scr, mk_lane()); else p0_item_store(va, a.K, a.WT, a.k0, a.drow, scr, mk_lane());
        if (r + 2 * NGW < NIT) { const MoeItem c = moe_item(F, r + 2 * NGW); p0_item_load(c.W, c.N, c.k0, c.n0, mk_lane(), va); }
        if (hb) { if (b.f8) p0_item_store_fp8(vb, b.K, (unsigned char*)b.WT, b.k0, b.drow, scr, mk_lane()); else p0_item_store(vb, b.K, b.WT, b.k0, b.drow, scr, mk_lane()); }
    }
}
__device__ __forceinline__ void p0_prologue(Frame& F, int which, int gw, int NGW) {
    LAS unsigned char* scr = F.lds + RING_OFF + F.wave * 8192;
    constexpr int I_IN = (DM / 64) * (NIN / 64), I_A = (1024 / 64) * (DM / 64), I_B = (512 / 64) * (DM / 64), I_O = (DM / 64) * (DM / 64);
    constexpr int I_GU1 = (DM / 64) * (2048 / 64), I_GU = NE * I_GU1, I_D1 = (DFF / 64) * (DM / 64), I_D = NE * I_D1;
    constexpr int NITEMS = I_IN + I_A + I_B + I_O + I_GU + I_D;
    bf16* WIN = (bf16*)(F.ws + WS_WIN); bf16* WA = (bf16*)(F.ws + WS_WA); bf16* WB = (bf16*)(F.ws + WS_WB); bf16* WO = (bf16*)(F.ws + WS_WO); bf16* WGU = (bf16*)(F.ws + WS_WGU); bf16* WD = (bf16*)(F.ws + WS_WD);
    for (int it = gw; it < NITEMS; it += NGW) {
        int r = it;
        if (!(which & 1) && r < I_IN + I_A + I_B + I_O) continue;
        if (!(which & 2) && r >= I_IN + I_A + I_B + I_O) break;
        if (r < I_IN) { const int nblk = NIN / 64, kb = r / nblk, nb = r % nblk;
            const int n0 = 64 * nb, r8 = (n0 >= C_GA) ? n0 - C_GA : (n0 >= C_DAV && n0 < C_DLQ) ? 4096 + (n0 - C_DAV) : (n0 >= C_DLV) ? 5120 + (n0 - C_DLV) : -1;
            if (r8 < 0) p0_transpose_item(F.ka->in[2], DM, NIN, WIN, 64 * kb, n0, n0, scr, mk_lane());
            else { f32x4 v[16]; p0_item_load(F.ka->in[2], NIN, 64 * kb, n0, mk_lane(), v); p0_item_store_fp8(v, DM, (unsigned char*)(F.ws + WS_WIN8), 64 * kb, r8, scr, mk_lane()); }
            continue; } r -= I_IN;
        if (r < I_A)  { const int nblk = DM / 64, kb = r / nblk, nb = r % nblk; p0_transpose_item(F.ka->in[10], 1536, DM, WA, 64 * kb, 64 * nb, 64 * nb, scr, mk_lane()); continue; } r -= I_A;
        if (r < I_B)  { const int nblk = DM / 64, kb = r / nblk, nb = r % nblk; p0_transpose_item(F.ka->in[11], 1536, DM, WA, 64 * kb, 64 * nb, 64 * nb, scr, mk_lane(), 1024 + 64 * kb); continue; } r -= I_B;
        if (r < I_O)  { const int nblk = DM / 64, kb = r / nblk, nb = r % nblk; p0_transpose_item(F.ka->in[12], DM, DM, WO, 64 * kb, 64 * nb, 64 * nb, scr, mk_lane()); continue; } r -= I_O;
        if (r < I_GU) { const int e = r / I_GU1, q = r % I_GU1, nblk = 2048 / 64, kb = q / nblk, nb = q % nblk, n0 = 64 * nb, j = n0 & 1023, up = n0 >> 10;
                        p0_transpose_item(F.ka->in[16] + (size_t)e * DM * 2048, DM, 2048, WGU + (size_t)e * 2048 * DM, 64 * kb, n0, 256 * (j >> 7) + 128 * up + (j & 127), scr, mk_lane()); continue; } r -= I_GU;
        { const int e = r / I_D1, q = r % I_D1, nblk = DM / 64, kb = q / nblk, nb = q % nblk;
          p0_transpose_item(F.ka->in[17] + (size_t)e * DFF * DM, DFF, DM, WD + (size_t)e * DM * DFF, 64 * kb, 64 * nb, 64 * nb, scr, mk_lane()); }
    }
    bf16* XN = (bf16*)(F.ws + WS_XN);
    if (which & 4) {
        f32x4 g[8];
#pragma unroll
        for (int j = 0; j < 8; ++j) g[j] = *((const GAS f32x4*)F.ka->in[1] + mk_lane() + 64 * j);
        for (int m = gw; m < M; m += 2 * NGW) {
            const int m2 = (m + NGW < M) ? m + NGW : m;
            const GAS f32x4* xr = (const GAS f32x4*)(F.ka->in[0] + (size_t)m * DM) + mk_lane(); const GAS f32x4* xr2 = (const GAS f32x4*)(F.ka->in[0] + (size_t)m2 * DM) + mk_lane();
            f32x4 v[8], w[8]; float s = 0.f, s2 = 0.f;
#pragma unroll
            for (int j = 0; j < 8; ++j) { v[j] = xr[64 * j]; w[j] = xr2[64 * j]; }
#pragma unroll
            for (int j = 0; j < 8; ++j) { s += (v[j].x * v[j].x + v[j].y * v[j].y) + (v[j].z * v[j].z + v[j].w * v[j].w); s2 += (w[j].x * w[j].x + w[j].y * w[j].y) + (w[j].z * w[j].z + w[j].w * w[j].w); }
            const float rstd = 1.0f / sqrtf(wave_sum(s) * (1.f / DM) + EPS), rstd2 = 1.0f / sqrtf(wave_sum(s2) * (1.f / DM) + EPS);
            GAS unsigned long long* o8 = (GAS unsigned long long*)(XN + (size_t)m * DM) + mk_lane(); GAS unsigned long long* o82 = (GAS unsigned long long*)(XN + (size_t)m2 * DM) + mk_lane();
            GAS unsigned* q8 = (GAS unsigned*)((unsigned char*)(F.ws + WS_XN8) + (size_t)m * DM) + mk_lane(); GAS unsigned* q82 = (GAS unsigned*)((unsigned char*)(F.ws + WS_XN8) + (size_t)m2 * DM) + mk_lane();
#pragma unroll
            for (int j = 0; j < 8; ++j) { const f32x4 t = v[j] * rstd * g[j]; o8[64 * j] = (unsigned long long)pk2(t.x, t.y) | ((unsigned long long)pk2(t.z, t.w) << 32); q8[64 * j] = pg8::pk_fp8x4(t.x * pg8::XSCALE, t.y * pg8::XSCALE, t.z * pg8::XSCALE, t.w * pg8::XSCALE);
                                          const f32x4 t2 = w[j] * rstd2 * g[j]; o82[64 * j] = (unsigned long long)pk2(t2.x, t2.y) | ((unsigned long long)pk2(t2.z, t2.w) << 32); q82[64 * j] = pg8::pk_fp8x4(t2.x * pg8::XSCALE, t2.y * pg8::XSCALE, t2.z * pg8::XSCALE, t2.w * pg8::XSCALE); }
        }
    }
    if ((which & 4) && F.vcu == 0 && (F.wave * 64 + mk_lane()) < 384) { float* GN = (float*)(F.ws + WS_GAIN); const int t = (F.wave * 64 + mk_lane()); GN[t] = (t < 64) ? F.ka->in[3][t] : (t < 128) ? F.ka->in[4][t - 64] : (t < 256) ? F.ka->in[8][t - 128] : F.ka->in[9][t - 256]; }
    if (which & 4) { float* WR = (float*)(F.ws + WS_WR);
      for (int i = (F.vcu * NWAVES * 64) + (F.wave * 64 + mk_lane()); i < DM * 48; i += F.G * NWAVES * 64) { const int k = i / 48, c = i % 48; const float gn = F.ka->in[13][k];
          WR[i] = (c < 32) ? F.ka->in[15][k * 32 + c] * gn : (c < 36) ? F.ka->in[14][k * 4 + (c - 32)] * gn : 0.f; } }
}
__device__ __forceinline__ void p2_attention(Frame& F, int which) {
    const bf16* PROJ = (const bf16*)(F.ws + WS_PROJ);
    bf16* ODA = (bf16*)(F.ws + WS_ODA); bf16* ODL = (bf16*)(F.ws + WS_ODL); float* LSE = (float*)(F.ws + WS_LSE);
    float gq = fabsf(F.ka->in[3][mk_lane()]), gk = fabsf(F.ka->in[4][mk_lane()]);
#pragma unroll
    for (int o = 1; o < 64; o <<= 1) { gq = fmaxf(gq, __shfl_xor(gq, o)); gk = fmaxf(gk, __shfl_xor(gk, o)); }
    const float Bq = 8.0f * gq * gk * 1.02f;
    float g1 = fmaxf(fabsf(F.ka->in[8][mk_lane()]), fabsf(F.ka->in[8][64 + mk_lane()])), g2 = fmaxf(fabsf(F.ka->in[9][mk_lane()]), fabsf(F.ka->in[9][64 + mk_lane()]));
#pragma unroll
    for (int o = 1; o < 64; o <<= 1) { g1 = fmaxf(g1, __shfl_xor(g1, o)); g2 = fmaxf(g2, __shfl_xor(g2, o)); }
    const float Bl = 11.313708f * g1 * g2 * 1.02f;
    volatile LAS int* QW = (volatile LAS int*)(F.MISC + 16);
    for (;;) {
        if ((F.wave * 64 + mk_lane()) == 0) QW[0] = (int)atomicAdd((unsigned*)(F.ctl + CW_QUEUE) + 64 * F.li, 1u);
        __syncthreads();
        const int u = __builtin_amdgcn_readfirstlane(QW[0]);
        if (u >= 1024 + 768) break;
        if (u < 1024) {
            const int h = 7 - (u >> 7), rem = u & 127, b = rem >> 6, mp = (rem >> 5) & 1, qb = 31 - (rem & 31);
            const float slope = exp2f(-(float)(h + 1));
            const float Df = (2.0f * Bq + logf(1.0f / slope) + 30.0f) / slope;
            const int Dk = (Df < 1.0e6f) ? (int)Df + 1 : (1 << 20);
            int t_lo = (256 * qb - Dk) >> 6; if (t_lo < 0) t_lo = 0;
            if (which & 1)
            att::attn_unit<64>(PROJ + pg8::PJ_QA + (size_t)((b * 8 + h) * 2 + mp) * SEQ * 64, PROJ + pg8::PJ_KA + (size_t)((b * 8 + h) * 2 + mp) * SEQ * 64, PROJ + pg8::PJ_VA + (size_t)(b * 8 + h) * SEQ * 128,
                               256 * qb, t_lo, 4 * (qb + 1), 1 << 30, Dk, slope * LOG2E, Bq * LOG2E - 20.0f,
                               ODA + (size_t)mp * M * 1024 + (size_t)b * SEQ * 1024 + h * 128, 1024L, nullptr, 0L, F.lds + RING_OFF, (LAS float*)(F.lds + XCH_OFF), F.wave, (u == MK_DBG_UNIT) ? (unsigned*)(F.ctl + CW_DBG) : nullptr);
        } else {
            const int v = u - 1024, b = v / 384, rem = v % 384, g = rem / 128, rem2 = rem % 128, h = rem2 / 32, j = rem2 % 32;
            const int d = (g == 0) ? 1 : (g == 1) ? 4 : 16, nblk = 32 / d, r = j / nblk, iblk = j % nblk, hh = g * 4 + h;
            const size_t hoff = ((size_t)(b * 12 + hh) * SEQ + (size_t)r * (SEQ / d)) * 128;
            const float slope2 = exp2f(-8.0f * (float)(hh + 1) / 12.0f) * (float)d * LOG2E;
            if (which & 2)
            att::attn_unit<128>(PROJ + pg8::PJ_QL + hoff, PROJ + pg8::PJ_KL + hoff, PROJ + pg8::PJ_VL + hoff, 256 * iblk, (4 * iblk - 2 < 0) ? 0 : 4 * iblk - 2, 4 * iblk + 4, 128, 128, slope2, Bl * LOG2E - 20.0f,
                                ODL + (size_t)g * M * 512 + ((size_t)b * SEQ + r) * 512 + h * 128, 512L * d, LSE + (size_t)g * M * 4 + ((size_t)b * SEQ + r) * 4 + h, 4L * d, F.lds + RING_OFF, (LAS float*)(F.lds + XCH_OFF), F.wave);
        }
        __syncthreads();
    }
}
__device__ __forceinline__ void p3_merge(Frame& F) {
    const int gw = F.vcu * NWAVES + F.wave, NGW = F.G * NWAVES, lane = mk_lane();
    const bf16* ODA = (const bf16*)(F.ws + WS_ODA); const bf16* ODL = (const bf16*)(F.ws + WS_ODL); const float* LSE = (const float*)(F.ws + WS_LSE);
    bf16* OA = (bf16*)(F.ws + WS_OA); bf16* OB = (bf16*)(F.ws + WS_OB);
    const float s0 = wave_sum(F.ka->in[5][lane] * F.ka->in[6][lane]), s1 = wave_sum(F.ka->in[5][64 + lane] * F.ka->in[6][64 + lane]);
    const float lam = expf(s0) - expf(s1) + LAM_INIT;
    float sg[16];
#pragma unroll
    for (int j = 0; j < 16; ++j) sg[j] = F.ka->in[7][(lane & 7) * 16 + j] * (1.0f - LAM_INIT);
    for (int m = gw; m < M; m += NGW) {
        {
            const v4u* p0 = (const v4u*)(ODA + (size_t)m * 1024 + lane * 16); const v4u* p1 = (const v4u*)(ODA + (size_t)M * 1024 + (size_t)m * 1024 + lane * 16);
            float a[16], b[16]; pg8::unpack8(p0[0], *(float(*)[8])&a[0]); pg8::unpack8(p0[1], *(float(*)[8])&a[8]); pg8::unpack8(p1[0], *(float(*)[8])&b[0]); pg8::unpack8(p1[1], *(float(*)[8])&b[8]);
            float ss = 0.f;
#pragma unroll
            for (int j = 0; j < 16; ++j) { a[j] = a[j] - lam * b[j]; ss += a[j] * a[j]; }
            ss += __shfl_xor(ss, 1); ss += __shfl_xor(ss, 2); ss += __shfl_xor(ss, 4);
            const float rstd = 1.0f / sqrtf(ss * (1.f / 128.f) + EPS);
            v4u o0, o1;
            o0.x = pk2(a[0] * rstd * sg[0], a[1] * rstd * sg[1]); o0.y = pk2(a[2] * rstd * sg[2], a[3] * rstd * sg[3]); o0.z = pk2(a[4] * rstd * sg[4], a[5] * rstd * sg[5]); o0.w = pk2(a[6] * rstd * sg[6], a[7] * rstd * sg[7]);
            o1.x = pk2(a[8] * rstd * sg[8], a[9] * rstd * sg[9]); o1.y = pk2(a[10] * rstd * sg[10], a[11] * rstd * sg[11]); o1.z = pk2(a[12] * rstd * sg[12], a[13] * rstd * sg[13]); o1.w = pk2(a[14] * rstd * sg[14], a[15] * rstd * sg[15]);
            v4u* q = (v4u*)(OA + (size_t)m * 1536 + lane * 16); q[0] = o0; q[1] = o1;
        }
        {
            const int h = lane >> 4;
            const float l0 = LSE[(size_t)m * 4 + h], l1 = LSE[(size_t)M * 4 + (size_t)m * 4 + h], l2 = LSE[(size_t)2 * M * 4 + (size_t)m * 4 + h];
            const float mx = fmaxf(l0, fmaxf(l1, l2)); float w0 = exp2f(l0 - mx), w1 = exp2f(l1 - mx), w2 = exp2f(l2 - mx); const float inv = 1.0f / (w0 + w1 + w2); w0 *= inv; w1 *= inv; w2 *= inv;
            float a[8], b[8], c[8];
            pg8::unpack8(*(const v4u*)(ODL + (size_t)m * 512 + lane * 8), a); pg8::unpack8(*(const v4u*)(ODL + (size_t)M * 512 + (size_t)m * 512 + lane * 8), b); pg8::unpack8(*(const v4u*)(ODL + (size_t)2 * M * 512 + (size_t)m * 512 + lane * 8), c);
            v4u o;
            o.x = pk2(w0 * a[0] + w1 * b[0] + w2 * c[0], w0 * a[1] + w1 * b[1] + w2 * c[1]); o.y = pk2(w0 * a[2] + w1 * b[2] + w2 * c[2], w0 * a[3] + w1 * b[3] + w2 * c[3]);
            o.z = pk2(w0 * a[4] + w1 * b[4] + w2 * c[4], w0 * a[5] + w1 * b[5] + w2 * c[5]); o.w = pk2(w0 * a[6] + w1 * b[6] + w2 * c[6], w0 * a[7] + w1 * b[7] + w2 * c[7]);
            *(v4u*)(OA + (size_t)m * 1536 + 1024 + lane * 8) = o;
        }
    }
}
__device__ __forceinline__ f32x4 bf4_to_f32(unsigned long long a) {
    f32x4 r; r.x = __uint_as_float((unsigned)a << 16); r.y = __uint_as_float((unsigned)a & 0xffff0000u); r.z = __uint_as_float((unsigned)(a >> 32) << 16); r.w = __uint_as_float((unsigned)(a >> 32) & 0xffff0000u); return r; }
__device__ __forceinline__ void p7_router(Frame& F) {
    typedef float f32x4v __attribute__((ext_vector_type(4)));
    LAS float* LG = (LAS float*)(F.lds);
    LAS float* SS = (LAS float*)(F.lds + 24576);
    LAS float* RS = (LAS float*)(F.lds + 25088);
    const float* WR = (const float*)(F.ws + WS_WR);
    int* EIDX = (int*)(F.ws + WS_ROUTE); float* EW = (float*)(F.ws + WS_ROUTE + 131072); int* POS = (int*)(F.ws + WS_ROUTE + 262144); int* LIST = (int*)(F.ws + WS_LIST); float* RSL = (float*)(F.ws + WS_RSL);
    bf16* X1 = (bf16*)(F.ws + WS_XN);
    unsigned char* XQ = (unsigned char*)(F.ws + WS_XS);
    bf16* XN2 = (bf16*)(F.ws + WS_XN); const bf16* DELTA = (const bf16*)(F.ws + WS_ODA);
    const int lane = mk_lane(), wave = F.wave, rg = wave & 3, kh = wave >> 2, i = lane & 15, kq = lane >> 4;
    for (int it = F.vcu; it < M / 64; it += F.G) {
        const int row0 = 64 * it;
        const size_t eo = (size_t)(row0 + 16 * rg + i) * DM + 1024 * kh + 16 * kq;
        const float* xr = F.ka->in[0] + eo;
        const bf16* dr = DELTA + eo;
        const float* gp = F.ka->in[13] + 1024 * kh + 16 * kq;
        unsigned char* xq = XQ + eo;
        bf16* x1p = X1 + eo;
        const float* wr = WR + (size_t)(1024 * kh + 16 * kq) * 48 + i;
        f32x4v a0 = {0.f, 0.f, 0.f, 0.f}, a1 = a0, a2 = a0; float ssq = 0.f;
        for (int T = 0; T < 16; ++T) {
            v4u q, xb0, xb1;
#pragma unroll
            for (int tt = 0; tt < 4; ++tt) {
                const f32x4 xv = *(const f32x4*)(xr + 64 * T + 4 * tt) + bf4_to_f32(*(const unsigned long long*)(dr + 64 * T + 4 * tt));
                const f32x4 gv = *(const f32x4*)(gp + 64 * T + 4 * tt) * pg8::XSCALE;
                ssq += (xv.x * xv.x + xv.y * xv.y) + (xv.z * xv.z + xv.w * xv.w);
                q[tt] = pg8::pk_fp8x4(xv.x * gv.x, xv.y * gv.y, xv.z * gv.z, xv.w * gv.w);
                if (tt < 2) { xb0[2 * tt] = pk2(xv.x, xv.y); xb0[2 * tt + 1] = pk2(xv.z, xv.w); } else { xb1[2 * tt - 4] = pk2(xv.x, xv.y); xb1[2 * tt - 3] = pk2(xv.z, xv.w); }
#pragma unroll
                for (int c = 0; c < 4; ++c) { const float* w = wr + (size_t)(64 * T + 4 * tt + c) * 48; const float xa = xv[c];
                    a0 = __builtin_amdgcn_mfma_f32_16x16x4f32(xa, w[0], a0, 0, 0, 0); a1 = __builtin_amdgcn_mfma_f32_16x16x4f32(xa, w[16], a1, 0, 0, 0); a2 = __builtin_amdgcn_mfma_f32_16x16x4f32(xa, w[32], a2, 0, 0, 0); }
            }
            *(v4u*)(xq + 64 * T) = q; *(v4u*)(x1p + 64 * T) = xb0; *(v4u*)(x1p + 64 * T + 8) = xb1;
        }
        ssq += __shfl_xor(ssq, 16); ssq += __shfl_xor(ssq, 32);
#pragma unroll
        for (int reg = 0; reg < 4; ++reg) { LAS float* p = LG + (kh * 64 + 16 * rg + 4 * kq + reg) * 48 + i; p[0] = a0[reg]; p[16] = a1[reg]; p[32] = a2[reg]; }
        if (kq == 0) SS[kh * 64 + 16 * rg + i] = ssq;
        __syncthreads();
        if ((F.wave * 64 + mk_lane()) < 64) {
            const int r = (F.wave * 64 + mk_lane()); const float rstd = 1.0f / sqrtf((SS[r] + SS[64 + r]) * (1.f / DM) + EPS);
            const LAS float* l0 = LG + r * 48; const LAS float* l1 = LG + (64 + r) * 48;
            float gl[4];
#pragma unroll
            for (int j = 0; j < 4; ++j) gl[j] = (l0[32 + j] + l1[32 + j]) * rstd;
            int g = 0; float gmax = gl[0];
#pragma unroll
            for (int j = 1; j < 4; ++j) if (gl[j] > gmax) { gmax = gl[j]; g = j; }
            float gs = 0.f;
#pragma unroll
            for (int j = 0; j < 4; ++j) gs += expf(gl[j] - gmax);
            const float gw = 1.0f / gs;
            float t0 = -INFINITY, t1 = -INFINITY; int i0 = 0, i1 = 0;
#pragma unroll
            for (int j = 0; j < 8; ++j) { const float v = (l0[8 * g + j] + l1[8 * g + j]) * rstd;
                if (v > t0) { t1 = t0; i1 = i0; t0 = v; i0 = j; } else if (v > t1) { t1 = v; i1 = j; } }
            const float e1 = expf(t1 - t0), w0 = gw / (1.0f + e1), w1 = gw * e1 / (1.0f + e1);
            const int e0i = 8 * g + i0, e1i = 8 * g + i1, row = row0 + r;
            EIDX[2 * row] = e0i; EIDX[2 * row + 1] = e1i; EW[2 * row] = w0; EW[2 * row + 1] = w1;
            if (!(MK_SPLIT_AT == 7 && F.li == 1)) {
                const int p0 = (int)atomicAdd((unsigned*)(F.ctl + CW_CNT) + e0i, 1u), p1 = (int)atomicAdd((unsigned*)(F.ctl + CW_CNT) + e1i, 1u);
                LIST[(size_t)e0i * M + p0] = row; LIST[(size_t)e1i * M + p1] = row; POS[2 * row] = p0; POS[2 * row + 1] = p1;
                RSL[(size_t)e0i * M + p0] = rstd; RSL[(size_t)e1i * M + p1] = rstd;
            }
        }
        __syncthreads();
        __syncthreads();
    }
}
__device__ __forceinline__ void build_tables(Frame& F, LAS int* PS, LAS int* CN, LAS int* TE) {
    if ((F.wave * 64 + mk_lane()) == 0) {
        int acc = 0, t = 0;
        for (int e = 0; e < NE; ++e) { PS[e] = acc; const int c = (int)__hip_atomic_load(F.ctl + CW_CNT + e, RLX_AGENT); CN[e] = c; const int nt = (c + 255) >> 8; for (int k = 0; k < nt; ++k) TE[t++] = e; acc += nt << 8; }
        PS[NE] = acc; TE[160] = t;
    }
    __syncthreads();
}
__device__ __forceinline__ void p11_combine(Frame& F) {
    const int gw = F.vcu * NWAVES + F.wave, NGW = F.G * NWAVES, lane = mk_lane();
    const float* EW = (const float*)(F.ws + WS_ROUTE + 131072); const int* POS = (const int*)(F.ws + WS_ROUTE + 262144); const int* EIDX = (const int*)(F.ws + WS_ROUTE);
    const LAS int* PS = (const LAS int*)(F.lds + XCH_OFF);
    const unsigned char* Y = (const unsigned char*)(F.ws + WS_Y8); const bf16* X1 = (const bf16*)(F.ws + WS_XN);
    typedef float f32x2c __attribute__((ext_vector_type(2)));
    for (int m = gw; m < M; m += NGW) {
        const int s0 = PS[EIDX[2 * m]] + POS[2 * m], s1 = PS[EIDX[2 * m + 1]] + POS[2 * m + 1]; const float w0 = EW[2 * m] * (1.0f / pg8::YSCALE), w1 = EW[2 * m + 1] * (1.0f / pg8::YSCALE);
        GAS f32x4* op = (GAS f32x4*)(F.out + (size_t)m * DM) + lane; const GAS unsigned long long* dp = (const GAS unsigned long long*)(X1 + (size_t)m * DM) + lane;
        const GAS unsigned* y0 = (const GAS unsigned*)(Y + (size_t)s0 * DM) + lane; const GAS unsigned* y1 = (const GAS unsigned*)(Y + (size_t)s1 * DM) + lane;
#pragma unroll
        for (int j = 0; j < 8; ++j) { f32x4 v = bf4_to_f32(dp[64 * j]); const unsigned a = y0[64 * j], b = y1[64 * j];
            const f32x2c a0 = __builtin_amdgcn_cvt_pk_f32_fp8((int)a, false), a1 = __builtin_amdgcn_cvt_pk_f32_fp8((int)a, true), b0 = __builtin_amdgcn_cvt_pk_f32_fp8((int)b, false), b1 = __builtin_amdgcn_cvt_pk_f32_fp8((int)b, true);
            v.x += w0 * a0.x + w1 * b0.x; v.y += w0 * a0.y + w1 * b0.y; v.z += w0 * a1.x + w1 * b1.x; v.w += w0 * a1.y + w1 * b1.y;
            op[64 * j] = v; }
    }
}

__global__ void __launch_bounds__(NWAVES * 64, 2) mk_fwd(Args args) {
    extern __shared__ __attribute__((aligned(16))) unsigned char lds[];
    Frame F;
    F.lds = (LAS unsigned char*)lds;
    F.MISC = (volatile LAS unsigned*)(F.lds + MISC_OFF);
    F.wave = __builtin_amdgcn_readfirstlane((int)threadIdx.x >> 6);
    F.G = gridDim.x; { const int bx = blockIdx.x; F.vcu = (F.G % 8 == 0) ? (bx % 8) * (F.G / 8) + bx / 8 : bx; }
    F.ws = args.ws; F.ctl = (gu32*)(args.ws + WS_CTL); F.out = args.out; F.li = args.li;
    F.ka = &args;
    for (int u = (F.wave * 64 + mk_lane()); u < (LDS_BYTES - LDSCTL_OFF) / 4; u += NWAVES * 64) ((LAS unsigned*)(F.lds + LDSCTL_OFF))[u] = 0u;
    __syncthreads();
    XcdBarrier bar; bar.bar = (unsigned*)(F.ctl + CW_BAR) + args.li * XCD_BAR_WORDS; bar.x = 0; bar.st = nullptr; bar.w0 = 0;
    if (MK_N_LAUNCHES == 1) bar = xcd_barrier_post((unsigned*)(F.ctl + CW_BAR) + args.li * XCD_BAR_WORDS, F.MISC + 8, F.wave == 0 ? 1u : 0u);
    const int lo = args.ph_lo, hi = args.ph_hi;
#define IN(k) (lo <= (k) && (k) < hi)
#define SEAM(k) do { if (IN(k) && IN((k) + 1)) xcd_barrier(bar); } while (0)
    bf16* XN = (bf16*)(F.ws + WS_XN); bf16* PROJ = (bf16*)(F.ws + WS_PROJ); bf16* MIX = (bf16*)(F.ws + WS_MIX);

    const bool conv_wg = (F.G == 256) && (((int)blockIdx.x >> 3) & 3) == 3; const int conv_idx = ((int)blockIdx.x & 7) * 8 + ((int)blockIdx.x >> 5);
    if (IN(0)) { p0_prologue(F, ((args.li == 1) ? args.sub : 7) & ((F.G == 256) ? 5 : 7), F.vcu * NWAVES + F.wave, F.G * NWAVES); } SEAM(0);
    if (IN(1)) {
        if (conv_wg && !(MK_SPLIT_AT == 1 && args.li == 1)) { p0_moe_weights(F, conv_idx * NWAVES + F.wave, 64 * NWAVES); __syncthreads(); }
        pg8::EpiProj E{PROJ, (const float*)(F.ws + WS_GAIN), (LAS float*)(F.lds + XCH_OFF), 0.125f * LOG2E, 0.08838834764831845f * LOG2E, EPS};
        if (F.G == 256) {
            { pg8::Gemm g{XN, (const bf16*)(F.ws + WS_WIN), M, C_GA, DM, 0};
              pg8::TicketOrder S{(unsigned*)(F.ctl + CW_TQ) + 64 * ((int)blockIdx.x & 7) + 1024 * F.li, (int)blockIdx.x & 7, 8 * 20, (volatile LAS int*)(F.MISC + 20), F.wave, 1};
              pg8::gemm_phase<pg8::EpiProj, pg8::TicketOrder, true, true>(F.wave, F.lds + RING_OFF, g, S, E); }
            { pg8::Gemm g{(const bf16*)(F.ws + WS_XN8), (const bf16*)(F.ws + WS_WIN8), M, 6656, DM / 2, 0};
              pg8::TicketOrder S{(unsigned*)(F.ctl + CW_TQ) + 512 + 64 * ((int)blockIdx.x & 7) + 1024 * F.li, (int)blockIdx.x & 7, 8 * 26, (volatile LAS int*)(F.MISC + 22), F.wave, 0};
              pg8::EpiGateSig EG{PROJ + pg8::PJ_G, 1.0f / (pg8::XSCALE * pg8::WSCALE), PROJ};
              pg8::gemm_phase<pg8::EpiGateSig, pg8::TicketOrder, true, true, false, true>(F.wave, F.lds + RING_OFF, g, S, EG); }
        } else {
            pg8::Gemm g{XN, (const bf16*)(F.ws + WS_WIN), M, C_GA, DM, 0}; pg8::SkipOrder S0; S0.base.init(M, 20 * 256, F.G, (int)blockIdx.x); pg8::gemm_phase<pg8::EpiProj, pg8::SkipOrder, true, true>(F.wave, F.lds + RING_OFF, g, S0, E);
            pg8::Gemm g2{(const bf16*)(F.ws + WS_XN8), (const bf16*)(F.ws + WS_WIN8), M, 6656, DM / 2, 0}; pg8::StaticOrder S1; S1.init(M, 6656, F.G, (int)blockIdx.x);
            pg8::EpiGateSig EG{PROJ + pg8::PJ_G, 1.0f / (pg8::XSCALE * pg8::WSCALE), PROJ}; pg8::gemm_phase<pg8::EpiGateSig, pg8::StaticOrder, true, true, false, true>(F.wave, F.lds + RING_OFF, g2, S1, EG);
        }
    } SEAM(1);
    if (IN(2)) { p2_attention(F, (args.li == 1 && lo == 2) ? args.sub : 3); } SEAM(2);
    if (IN(3)) { p3_merge(F); } SEAM(3);
    if (IN(4)) {
        pg8::Gemm g{(const bf16*)(F.ws + WS_OA), (const bf16*)(F.ws + WS_WA), M, DM, 1536, 0}; pg8::MixOrder S; S.base.init(M, DM, F.G, (int)blockIdx.x);
        pg8::EpiMix E{MIX, DM, PROJ + pg8::PJ_G, 4096};
        pg8::gemm_phase<pg8::EpiMix, pg8::MixOrder, true, true>(F.wave, F.lds + RING_OFF, g, S, E);
    }
    if (IN(4) && IN(6)) xcd_barrier(bar);
    if (IN(6)) {
        pg8::Gemm g{MIX, (const bf16*)(F.ws + WS_WO), M, DM, DM, 0}; pg8::StaticOrder S; S.init(M, DM, F.G, (int)blockIdx.x);
        pg8::EpiPlain E{(bf16*)(F.ws + WS_ODA), DM, 1.0f};
        pg8::gemm_phase<pg8::EpiPlain, pg8::StaticOrder, true, true>(F.wave, F.lds + RING_OFF, g, S, E);
    } SEAM(6);
    if (IN(7)) { p7_router(F); }
    if (IN(7) && (IN(8) || IN(9))) xcd_barrier(bar);
    LAS int* TE = (LAS int*)(F.lds + TILE_E_OFF); LAS int* PS = (LAS int*)(F.lds + XCH_OFF); LAS int* CN = (LAS int*)(F.lds + XCH_OFF + 256);
    if (hi > 8 && lo <= 11) build_tables(F, PS, CN, TE);
    if (IN(9)) {
        pg8::Gemm g{(const bf16*)(F.ws + WS_XS), (const bf16*)(F.ws + WS_WGU), M, 2048, DM / 2, (size_t)2048 * DM};
        pg8::GroupOrder S{TE[160], F.G, (int)blockIdx.x, TE, PS, CN, (const int*)(F.ws + WS_LIST), M};
        pg8::EpiSwiglu E{(unsigned char*)(F.ws + WS_HB), DFF, 1.0f / (pg8::XSCALE * pg8::WSCALE), (const float*)(F.ws + WS_RSL), PS, M};
        pg8::gemm_phase<pg8::EpiSwiglu, pg8::GroupOrder, true, true, true, true>(F.wave, F.lds + RING_OFF, g, S, E);
    } SEAM(9);
    if (IN(10)) {
        pg8::Gemm g{(const bf16*)(F.ws + WS_HB), (const bf16*)(F.ws + WS_WD), XS_ROWS, DM, DFF / 2, (size_t)DM * DFF};
        pg8::GroupOrder S{TE[160], F.G, (int)blockIdx.x, TE, PS, CN, (const int*)(F.ws + WS_LIST), M};
        pg8::EpiFp8 E{(unsigned char*)(F.ws + WS_Y8), DM, pg8::YSCALE / (pg8::HSCALE * pg8::WSCALE)};
        pg8::gemm_phase<pg8::EpiFp8, pg8::GroupOrder, true, true, false, true>(F.wave, F.lds + RING_OFF, g, S, E);
    } SEAM(10);
    if (IN(11)) { p11_combine(F); }
#undef IN
#undef SEAM
}

extern "C" void kernel_launch(void* const* d_in, const int* in_sizes, int n_in, void* d_out, int out_size, void* d_ws, size_t ws_size, hipStream_t stream) {
    static int grid = 0;
    if (grid == 0) {
        if (n_in != 18 || out_size != M * DM || ws_size < WS_END) { fprintf(stderr, "kernel_launch: unexpected problem shape or workspace (%d inputs, out %d, ws %zu < %zu)\n", n_in, out_size, ws_size, (size_t)WS_END); grid = -1; return; }
        int dev = 0, cus = 0, per_cu = 0;
        if (hipGetDevice(&dev) != hipSuccess || hipDeviceGetAttribute(&cus, hipDeviceAttributeMultiprocessorCount, dev) != hipSuccess) { grid = -1; return; }
        if (hipFuncSetAttribute((const void*)mk_fwd, hipFuncAttributeMaxDynamicSharedMemorySize, LDS_BYTES) != hipSuccess) { fprintf(stderr, "kernel_launch: hipFuncSetAttribute failed\n"); grid = -1; return; }
        if (hipOccupancyMaxActiveBlocksPerMultiprocessor(&per_cu, (const void*)mk_fwd, NWAVES * 64, LDS_BYTES) != hipSuccess || per_cu < 1) { fprintf(stderr, "kernel_launch: occupancy query says %d blocks per CU\n", per_cu); (void)hipGetLastError(); grid = -1; return; }
        grid = cus;
        if (grid != 256) fprintf(stderr, "kernel_launch: %d CUs (tuned for 256)\n", grid);
    }
    if (grid < 0) return;
    (void)hipMemsetAsync((char*)d_ws + WS_CTL, 0, CTL_ZERO_BYTES, stream);
    Args a{};
    for (int i = 0; i < 18; ++i) a.in[i] = (const float*)d_in[i];
    a.out = (float*)d_out; a.ws = (unsigned char*)d_ws;
    if (MK_N_LAUNCHES == 1) {
        if (MK_SPLIT_AT >= 0) {
            a.ph_lo = 0; a.ph_hi = MK_SPLIT_AT + 1 + (MK_SPLIT_AT == 4 ? 1 : 0); a.li = 0; a.sub = 3;
            hipLaunchKernelGGL(mk_fwd, dim3(grid), dim3(NWAVES * 64), LDS_BYTES, stream, a);
            a.ph_lo = MK_SPLIT_AT; a.ph_hi = N_PHASES; a.li = 1; a.sub = MK_REPEAT_SUB;
            hipLaunchKernelGGL(mk_fwd, dim3(grid), dim3(NWAVES * 64), LDS_BYTES, stream, a);
            return;
        }
        a.ph_lo = 0; a.ph_hi = N_PHASES; a.li = 0; a.sub = 3;
        hipLaunchKernelGGL(mk_fwd, dim3(grid), dim3(NWAVES * 64), LDS_BYTES, stream, a);
    } else {
        for (int p = 0; p < N_PHASES; ++p) {
            if (p == 5) continue;
            a.ph_lo = p; a.ph_hi = (p == 4) ? 6 : p + 1; a.li = 0; a.sub = 3;
            hipLaunchKernelGGL(mk_fwd, dim3(grid), dim3(NWAVES * 64), LDS_BYTES, stream, a);
        }
    }
}
```

```cpp
#include <hip/hip_runtime.h>
#include <cstdio>
#include <cstdint>
#ifndef MK_EPI2
#define MK_EPI2 0
#endif
#ifndef MK_DBG
#define MK_DBG 0
#endif
#ifndef MK_DBG_GEMM
#define MK_DBG_GEMM 0
#endif
__device__ __forceinline__ int mk_lane() { int l; asm volatile("v_mbcnt_lo_u32_b32 %0, -1, 0\n\tv_mbcnt_hi_u32_b32 %0, -1, %0" : "=v"(l)); return l; }
namespace pg8 {
#define PG8_LAS __attribute__((address_space(3)))
typedef unsigned short bf16_t;
typedef short bf16x8 __attribute__((ext_vector_type(8)));
typedef float f32x4 __attribute__((ext_vector_type(4)));
typedef unsigned u32x4 __attribute__((ext_vector_type(4)));
typedef int i32x8 __attribute__((ext_vector_type(8)));
constexpr int BM = 256, BK = 64, HALF = 128, HTB = HALF * BK * 2  , STAGE_BYTES = 8 * HTB, NXCD = 8, WGM = 8;

__host__ __device__ __forceinline__ int lds_byte(int r, int c) { const int st = (r >> 4) * 2 + (c >> 5), rr = r & 15, cc = c & 31, ob = rr * 64 + cc * 2; return st * 1024 + (ob ^ (((ob >> 9) & 1) << 5)); }
__host__ __device__ __forceinline__ void stage_rc(int b, int& R, int& C) { const int st = b / 1024, sb = b % 1024, swz = sb ^ (((sb >> 9) & 1) << 5); R = (st >> 1) * 16 + swz / 64; C = (st & 1) * 32 + (swz % 64) / 2; }
__host__ __device__ __forceinline__ int perm32(int rho) { const int n = rho >> 4, i = rho & 15; return 8 * (i >> 2) + 4 * n + (i & 3); }

struct Unit { int pm, pn, e, nt, kofs, keep; };
struct Gemm { const bf16_t* A; const bf16_t* Bt; int M, N, K; size_t estride; };

struct StaticOrder {
    int nM, nN, nwg, G, c;
    __host__ __device__ void init(int M, int N, int G_, int c_) { nM = M / BM; nN = N / BM; nwg = nM * nN; G = G_; c = c_; }
    __host__ __device__ bool next(int i, Unit& u) const {
        const long L = (long)i * G + c; if (L >= nwg) return false;
        int wgid = (int)L; { const int q = nwg / NXCD, r = nwg % NXCD, xcd = wgid % NXCD, off = wgid / NXCD; wgid = (xcd < r ? xcd * (q + 1) : r * (q + 1) + (xcd - r) * q) + off; }
        const int nig = WGM * nN, gid = wgid / nig, fm = gid * WGM, gsz = (nM - fm) < WGM ? (nM - fm) : WGM;
        u.pm = fm + ((wgid % nig) % gsz); u.pn = (wgid % nig) / gsz; u.e = 0; u.nt = 0; u.kofs = 0; u.keep = 0; return true;
    }
    __device__ __forceinline__ int arow(const Unit&, int R) const { return R; }
    __device__ __forceinline__ void a_ready(const Unit&) const {}
    __device__ __forceinline__ void done(const Unit&) const {}
};

typedef float f32x2_c __attribute__((ext_vector_type(2))); typedef __bf16 bf16x2_c __attribute__((ext_vector_type(2)));
__device__ __forceinline__ unsigned cvt_pk_bf16(float lo, float hi) { f32x2_c v = {lo, hi}; bf16x2_c b = __builtin_convertvector(v, bf16x2_c); return __builtin_bit_cast(unsigned, b); }
__device__ __forceinline__ float bf2f(unsigned short b) { return __uint_as_float((unsigned)b << 16); }
__device__ __forceinline__ void unpack8(const u32x4 w, float (&f)[8]) {
    f[0] = __uint_as_float(w.x << 16); f[1] = __uint_as_float(w.x & 0xffff0000u); f[2] = __uint_as_float(w.y << 16); f[3] = __uint_as_float(w.y & 0xffff0000u);
    f[4] = __uint_as_float(w.z << 16); f[5] = __uint_as_float(w.z & 0xffff0000u); f[6] = __uint_as_float(w.w << 16); f[7] = __uint_as_float(w.w & 0xffff0000u);
}
__device__ __forceinline__ u32x4 pack8(const f32x4 v0, const f32x4 v1) { u32x4 w; w.x = cvt_pk_bf16(v0[0], v0[1]); w.y = cvt_pk_bf16(v0[2], v0[3]); w.z = cvt_pk_bf16(v1[0], v1[1]); w.w = cvt_pk_bf16(v1[2], v1[3]); return w; }

constexpr size_t PJ_QA = 0, PJ_KA = (size_t)16384 * 1024, PJ_VA = (size_t)16384 * 2048, PJ_QL = (size_t)16384 * 3072, PJ_KL = (size_t)16384 * 4608, PJ_VL = (size_t)16384 * 6144, PJ_G = (size_t)16384 * 7680;
struct EpiProj {
    static constexpr bool PERM = true, AFTER_DRAIN = false, IDEM = true; static constexpr int MIDT = 0;
    bf16_t* O;
    const float* gains;
    PG8_LAS float* xch;
    float c2_da, c2_dl, eps;
    __device__ __forceinline__ void operator()(const f32x4 (&acc)[2][2][4][2], const Unit& u, int wr, int wc, int fr, int fq) const {
        constexpr int S = 8192;
        const int pn = u.pn;
        const int kind = (pn < 8) ? 1 : (pn < 12) ? 0 : (pn < 24) ? 2 : (pn < 30) ? 0 : 3;
        const int rowl0 = wr * 64 + fr;
        const int b = u.pm >> 5, t0 = (u.pm & 31) * BM + rowl0;
        size_t hb0; int hstep, pitch, dil = 1;
        if (pn < 8) {
            const int pq = pn & 3; pitch = 64; hstep = 2 * S * 64;
            hb0 = (pn < 4 ? PJ_QA : PJ_KA) + ((size_t)((b * 8 + 2 * pq) * 2 + (wc >> 1)) * S) * 64 + (wc & 1) * 32 + 8 * fq;
        } else if (pn < 12) {
            const int pq = pn - 8; pitch = 128; hstep = S * 128;
            hb0 = PJ_VA + ((size_t)(b * 8 + 2 * pq) * S) * 128 + wc * 32 + 8 * fq;
        } else if (pn < 30) {
            const int sec = (pn - 12) / 6, pq = (pn - 12) % 6; pitch = 128; hstep = S * 128; dil = (pq < 2) ? 1 : (pq < 4) ? 4 : 16;
            hb0 = (sec == 0 ? PJ_QL : sec == 1 ? PJ_KL : PJ_VL) + ((size_t)(b * 12 + 2 * pq) * S) * 128 + wc * 32 + 8 * fq;
        } else {
            pitch = 4096; hstep = HALF;
            hb0 = PJ_G + ((size_t)b * S) * 4096 + (pn - 30) * BM + wc * 32 + 8 * fq;
        }
        bf16_t* const hb = O + hb0;
        const int lsh = (dil == 1) ? 0 : (dil == 4) ? 2 : 4;
        if (kind == 1 || kind == 2) {
#pragma unroll
            for (int ai = 0; ai < 2; ++ai)
#pragma unroll
                for (int m = 0; m < 4; ++m)
#pragma unroll
                    for (int bj = 0; bj < 2; ++bj) {
                        const f32x4 a = acc[ai][bj][m][0], bq = acc[ai][bj][m][1];
                        float s = (a[0] * a[0] + a[1] * a[1]) + (a[2] * a[2] + a[3] * a[3]) + (bq[0] * bq[0] + bq[1] * bq[1]) + (bq[2] * bq[2] + bq[3] * bq[3]);
                        s += __shfl_xor(s, 16); s += __shfl_xor(s, 32);
                        if (fq == 0) xch[(ai * HALF + rowl0 + m * 16) * 8 + bj * 4 + wc] = s;
                    }
            asm volatile("s_waitcnt lgkmcnt(0)" ::: "memory"); __builtin_amdgcn_s_barrier(); asm volatile("" ::: "memory");
            const bool isq = (pn < 4) || (pn >= 12 && pn < 18);
            const int goff = (kind == 1) ? ((isq ? 0 : 64) + (wc & 1) * 32 + 8 * fq) : ((isq ? 128 : 256) + wc * 32 + 8 * fq);
            const float* gp = gains + goff;
            const f32x4 g0 = *(const f32x4*)gp, g1 = *(const f32x4*)(gp + 4);
            const float sc = isq ? (kind == 1 ? c2_da : c2_dl) : 1.0f;
            const float inv = (kind == 1) ? (1.0f / 64.0f) : (1.0f / 128.0f);
#pragma unroll
            for (int ai = 0; ai < 2; ++ai)
#pragma unroll
                for (int m = 0; m < 4; ++m) {
                    const PG8_LAS f32x4* xr = (const PG8_LAS f32x4*)(xch + (ai * HALF + rowl0 + m * 16) * 8);
                    const int t = t0 + ai * HALF + m * 16; const size_t ro = (size_t)(((t & (dil - 1)) * (S >> lsh)) + (t >> lsh)) * pitch;
#pragma unroll
                    for (int bj = 0; bj < 2; ++bj) {
                        const f32x4 tt = xr[bj];
                        const float tot = (kind == 1) ? ((wc < 2) ? (tt[0] + tt[1]) : (tt[2] + tt[3])) : ((tt[0] + tt[1]) + (tt[2] + tt[3]));
                        const float rs = __builtin_amdgcn_rsqf(tot * inv + eps) * sc;
                        const f32x4 v0 = acc[ai][bj][m][0] * rs * g0, v1 = acc[ai][bj][m][1] * rs * g1;
                        *(u32x4*)(hb + ro + (size_t)bj * hstep) = pack8(v0, v1);
                    }
                }
        } else {
#pragma unroll
            for (int ai = 0; ai < 2; ++ai)
#pragma unroll
                for (int m = 0; m < 4; ++m) {
                    const int t = t0 + ai * HALF + m * 16; const size_t ro = (size_t)(((t & (dil - 1)) * (S >> lsh)) + (t >> lsh)) * pitch;
#pragma unroll
                    for (int bj = 0; bj < 2; ++bj) {
                        f32x4 v0 = acc[ai][bj][m][0], v1 = acc[ai][bj][m][1];
                        if (kind == 3) {
#pragma unroll
                            for (int j = 0; j < 4; ++j) { v0[j] = __builtin_amdgcn_rcpf(1.0f + __builtin_amdgcn_exp2f(-1.4426950408889634f * v0[j])); v1[j] = __builtin_amdgcn_rcpf(1.0f + __builtin_amdgcn_exp2f(-1.4426950408889634f * v1[j])); }
                        }
                        *(u32x4*)(hb + ro + (size_t)bj * hstep) = pack8(v0, v1);
                    }
                }
        }
    }
};

struct EpiGateSig {
    static constexpr bool PERM = true, AFTER_DRAIN = false, IDEM = true; static constexpr int MIDT = 0;
    unsigned char* G; float ascale; bf16_t* O;
    __device__ __forceinline__ void operator()(const f32x4 (&acc)[2][2][4][2], const Unit& u, int wr, int wc, int fr, int fq) const {
        constexpr int S = 8192;
        const bool gate = u.pn < 16;
        const int pv = u.pn - 16, b = u.pm >> 5, t0 = (u.pm & 31) * BM + wr * 64 + fr;
        const bool da = pv < 4; const int pq = da ? pv : pv - 4, dil = (gate || da || pq < 2) ? 1 : (pq < 4) ? 4 : 16, lsh = (dil == 1) ? 0 : (dil == 4) ? 2 : 4;
        const size_t ubase = gate ? (size_t)(u.pm * BM) * 4096 + 2 * ((u.pn & 7) * BM) + ((u.pn >> 3) << 3) : 2 * (da ? PJ_VA + ((size_t)(b * 8 + 2 * pq) * S) * 128 : PJ_VL + ((size_t)(b * 12 + 2 * pq) * S) * 128);
        unsigned char* const base = (gate ? G : (unsigned char*)O) + ubase + (gate ? (unsigned)(wr * 64 + fr) * 4096u : 0u) + 2 * (wc * 32 + 8 * fq);
        const unsigned pitch = gate ? 4096u : 256u, bjs = gate ? (unsigned)(2 * HALF) : (unsigned)(S * 256);
        const float ns = gate ? -1.4426950408889634f * ascale : ascale;
        typedef unsigned u32x2 __attribute__((ext_vector_type(2)));
#pragma unroll
        for (int ai = 0; ai < 2; ++ai)
#pragma unroll
            for (int m = 0; m < 4; ++m) {
                const int t = gate ? ai * HALF + m * 16 : t0 + ai * HALF + m * 16; const unsigned ro = (unsigned)(((t & (dil - 1)) * (S >> lsh)) + (t >> lsh)) * pitch;
#pragma unroll
                for (int bj = 0; bj < 2; ++bj) {
                    f32x4 v0 = acc[ai][bj][m][0] * ns, v1 = acc[ai][bj][m][1] * ns;
                    if (gate) {
#pragma unroll
                        for (int j = 0; j < 4; ++j) { v0[j] = fmaxf(255.0f * __builtin_amdgcn_rcpf(1.0f + __builtin_amdgcn_exp2f(v0[j])), 1.0f); v1[j] = fmaxf(255.0f * __builtin_amdgcn_rcpf(1.0f + __builtin_amdgcn_exp2f(v1[j])), 1.0f); }
                        unsigned lo = 0, hi = 0;
                        lo = __builtin_amdgcn_cvt_pk_u8_f32(v0[0], 0, lo); lo = __builtin_amdgcn_cvt_pk_u8_f32(v0[1], 1, lo); lo = __builtin_amdgcn_cvt_pk_u8_f32(v0[2], 2, lo); lo = __builtin_amdgcn_cvt_pk_u8_f32(v0[3], 3, lo);
                        hi = __builtin_amdgcn_cvt_pk_u8_f32(v1[0], 0, hi); hi = __builtin_amdgcn_cvt_pk_u8_f32(v1[1], 1, hi); hi = __builtin_amdgcn_cvt_pk_u8_f32(v1[2], 2, hi); hi = __builtin_amdgcn_cvt_pk_u8_f32(v1[3], 3, hi);
                        *(u32x2*)(base + ro + bj * bjs) = (u32x2){lo, hi};
                    } else *(u32x4*)(base + ro + bj * bjs) = pack8(v0, v1);
                }
            }
    }
};

struct EpiMix {
    static constexpr bool PERM = true, AFTER_DRAIN = false, IDEM = false; static constexpr int MIDT = 0;
    bf16_t* MIX; int ldm; const unsigned char* G;
    __device__ __forceinline__ void operator()(f32x4 (&acc)[2][2][4][2], const Unit& u, int wr, int wc, int fr, int fq) const {
        const int row0 = u.pm * BM + wr * 64 + fr, col0 = u.pn * BM + wc * 32 + 8 * fq;
        const unsigned char* const gp = G + (size_t)row0 * 4096 + 2 * col0;
#define PG8_UB(w, k) ((float)(((w) >> (8 * (k))) & 0xffu))
        if (!u.keep) {
#pragma unroll
            for (int ai = 0; ai < 2; ++ai)
#pragma unroll
                for (int m = 0; m < 4; ++m) {
#pragma unroll
                    for (int bj = 0; bj < 2; ++bj) {
                        const u32x4 g = *(const u32x4*)(gp + (size_t)(ai * HALF + m * 16) * 4096 + 2 * bj * HALF);
#pragma unroll
                        for (int j = 0; j < 4; ++j) { acc[ai][bj][m][0][j] *= PG8_UB(g.x, j) * __builtin_amdgcn_rcpf(PG8_UB(g.z, j)); acc[ai][bj][m][1][j] *= PG8_UB(g.y, j) * __builtin_amdgcn_rcpf(PG8_UB(g.w, j)); }
                    }
                    if (m & 1) asm volatile("" ::: "memory");
                }
        } else {
#pragma unroll
            for (int ai = 0; ai < 2; ++ai)
#pragma unroll
                for (int m = 0; m < 4; ++m) {
                    const size_t r = (size_t)(row0 + ai * HALF + m * 16);
#pragma unroll
                    for (int bj = 0; bj < 2; ++bj) {
                        typedef unsigned u32x2 __attribute__((ext_vector_type(2)));
                        const u32x2 g = *(const u32x2*)(gp + (size_t)(ai * HALF + m * 16) * 4096 + 2 * bj * HALF + 8);
                        f32x4 v0 = acc[ai][bj][m][0], v1 = acc[ai][bj][m][1];
#pragma unroll
                        for (int j = 0; j < 4; ++j) { v0[j] *= PG8_UB(g.x, j) * (1.0f / 255.0f); v1[j] *= PG8_UB(g.y, j) * (1.0f / 255.0f); }
                        *(u32x4*)(MIX + r * ldm + col0 + bj * HALF) = pack8(v0, v1);
                    }
                }
        }
#undef PG8_UB
    }
};
struct MixOrder {
    StaticOrder base;
    __device__ __forceinline__ bool next(int i, Unit& u) const { if (!base.next(i >> 1, u)) return false; const int part = i & 1; u.nt = part ? 8 : 16; u.kofs = part ? 2048 : 0; u.keep = part; return true; }
    __device__ __forceinline__ int arow(const Unit&, int R) const { return R; }
    __device__ __forceinline__ void a_ready(const Unit&) const {}
    __device__ __forceinline__ void done(const Unit&) const {}
};

struct EpiRes {
    static constexpr bool PERM = false, AFTER_DRAIN = false, IDEM = true; static constexpr int MIDT = 0;
    const float* X; float* Out; int ldc;
    __device__ __forceinline__ void operator()(const f32x4 (&acc)[2][2][4][2], const Unit& u, int wr, int wc, int fr, int fq) const {
        const int row0 = u.pm * BM + wr * 64 + fr, col0 = u.pn * BM + wc * 32 + 4 * fq;
#pragma unroll
        for (int ai = 0; ai < 2; ++ai)
#pragma unroll
            for (int m = 0; m < 4; ++m) {
                const size_t off = (size_t)(row0 + ai * HALF + m * 16) * ldc + col0;
#pragma unroll
                for (int bj = 0; bj < 2; ++bj)
#pragma unroll
                    for (int n = 0; n < 2; ++n) { const f32x4 xv = *(const f32x4*)(X + off + bj * HALF + n * 16); *(f32x4*)(Out + off + bj * HALF + n * 16) = xv + acc[ai][bj][m][n]; }
            }
    }
};

constexpr float HSCALE = 4.0f, WSCALE = 64.0f, XSCALE = 8.0f;
__device__ __forceinline__ unsigned pk_fp8x4(float a, float b, float c, float d) {
    a = fminf(fmaxf(a, -448.f), 448.f); b = fminf(fmaxf(b, -448.f), 448.f); c = fminf(fmaxf(c, -448.f), 448.f); d = fminf(fmaxf(d, -448.f), 448.f);
    int p = __builtin_amdgcn_cvt_pk_fp8_f32(a, b, 0, false); p = __builtin_amdgcn_cvt_pk_fp8_f32(c, d, p, true); return (unsigned)p; }
__device__ __forceinline__ unsigned pk_fp8x4_nc(float a, float b, float c, float d) { int p = __builtin_amdgcn_cvt_pk_fp8_f32(a, b, 0, false); p = __builtin_amdgcn_cvt_pk_fp8_f32(c, d, p, true); return (unsigned)p; }
struct EpiSwiglu {
    static constexpr bool PERM = true, AFTER_DRAIN = false, IDEM = true; static constexpr int MIDT = 0;
    unsigned char* H; int ldh; float ascale;
    const float* rsl; const PG8_LAS int* ps; int lcap;
    __device__ __forceinline__ void operator()(const f32x4 (&acc)[2][2][4][2], const Unit& u, int wr, int wc, int fr, int fq) const {
        const int row0 = u.pm * BM + wr * 64 + fr, col0 = u.pn * HALF + wc * 32 + 8 * fq;
        const float* rb = rsl + (size_t)u.e * lcap + (row0 - ps[u.e]);
#pragma unroll
        for (int ai = 0; ai < 2; ++ai)
#pragma unroll
            for (int m = 0; m < 4; ++m) {
                float v[8]; const float rs = rb[ai * HALF + m * 16] * ascale;
#pragma unroll
                for (int n = 0; n < 2; ++n)
#pragma unroll
                    for (int j = 0; j < 4; ++j) { const float gt = acc[ai][0][m][n][j] * rs, up = acc[ai][1][m][n][j] * rs; v[4 * n + j] = gt * __builtin_amdgcn_rcpf(1.0f + __builtin_amdgcn_exp2f(-1.4426950408889634f * gt)) * up * HSCALE; }
                typedef unsigned u32x2 __attribute__((ext_vector_type(2)));
                *(u32x2*)(H + (size_t)(row0 + ai * HALF + m * 16) * ldh + col0) = (u32x2){pk_fp8x4_nc(v[0], v[1], v[2], v[3]), pk_fp8x4_nc(v[4], v[5], v[6], v[7])};
            }
    }
};

constexpr float YSCALE = 16.0f;
struct EpiFp8 {
    static constexpr bool PERM = true, AFTER_DRAIN = false, IDEM = true; static constexpr int MIDT = 0;
    unsigned char* O; int ldc; float scale;
    __device__ __forceinline__ void operator()(const f32x4 (&acc)[2][2][4][2], const Unit& u, int wr, int wc, int fr, int fq) const {
        const int row0 = u.pm * BM + wr * 64 + fr, col0 = u.pn * BM + wc * 32 + 8 * fq;
        typedef unsigned u32x2 __attribute__((ext_vector_type(2)));
#pragma unroll
        for (int ai = 0; ai < 2; ++ai)
#pragma unroll
            for (int m = 0; m < 4; ++m)
#pragma unroll
                for (int bj = 0; bj < 2; ++bj) { const f32x4 a = acc[ai][bj][m][0] * scale, b = acc[ai][bj][m][1] * scale;
                    *(u32x2*)(O + (size_t)(row0 + ai * HALF + m * 16) * ldc + col0 + bj * HALF) = (u32x2){pk_fp8x4_nc(a[0], a[1], a[2], a[3]), pk_fp8x4_nc(b[0], b[1], b[2], b[3])}; }
    }
};
struct EpiPlain {
    static constexpr bool PERM = true, AFTER_DRAIN = false, IDEM = true; static constexpr int MIDT = 0;
    bf16_t* O; int ldc; float scale;
    __device__ __forceinline__ void operator()(const f32x4 (&acc)[2][2][4][2], const Unit& u, int wr, int wc, int fr, int fq) const {
        const int row0 = u.pm * BM + wr * 64 + fr, col0 = u.pn * BM + wc * 32 + 8 * fq;
#pragma unroll
        for (int ai = 0; ai < 2; ++ai)
#pragma unroll
            for (int m = 0; m < 4; ++m)
#pragma unroll
                for (int bj = 0; bj < 2; ++bj) *(u32x4*)(O + (size_t)(row0 + ai * HALF + m * 16) * ldc + col0 + bj * HALF) = pack8(acc[ai][bj][m][0] * scale, acc[ai][bj][m][1] * scale);
    }
};

struct TicketOrder {
    unsigned* q; int xcd, per; volatile PG8_LAS int* tick; int wave; int skipv;
    __device__ __forceinline__ bool next(int i, Unit& u) const {
        const bool t0 = (wave == 0) && (mk_lane() == 0);
        if (i == 0) { if (t0) { tick[0] = (int)atomicAdd(q, 1u); tick[1] = (int)atomicAdd(q, 1u); } __syncthreads(); }
        else if (t0) tick[(i + 1) & 1] = (int)atomicAdd(q, 1u);
        const int tk = __builtin_amdgcn_readfirstlane(tick[i & 1]);
        if (tk >= per) return false;
        u.pm = 8 * xcd + (tk & 7); u.pn = tk >> 3; if (skipv && u.pn >= 8) u.pn += 4; u.e = 0; u.nt = 0; u.kofs = 0; u.keep = 0; return true;
    }
    __device__ __forceinline__ int arow(const Unit&, int R) const { return R; }
    __device__ __forceinline__ void a_ready(const Unit&) const {}
    __device__ __forceinline__ void done(const Unit&) const {}
};

struct SkipOrder { StaticOrder base;
    __device__ __forceinline__ bool next(int i, Unit& u) const { if (!base.next(i, u)) return false; if (u.pn >= 8) u.pn += 4; return true; }
    __device__ __forceinline__ int arow(const Unit&, int R) const { return R; }
    __device__ __forceinline__ void a_ready(const Unit&) const {}
    __device__ __forceinline__ void done(const Unit&) const {}
};
struct OffOrder { StaticOrder base; int off;
    __device__ __forceinline__ bool next(int i, Unit& u) const { if (!base.next(i, u)) return false; u.pn += off; return true; }
    __device__ __forceinline__ int arow(const Unit&, int R) const { return R; }
    __device__ __forceinline__ void a_ready(const Unit&) const {}
    __device__ __forceinline__ void done(const Unit&) const {}
};
struct GroupOrder {
    int nT, G, c; const PG8_LAS int* tile_e; const PG8_LAS int* ps; const PG8_LAS int* cn; const int* list; int lcap;
    __device__ __forceinline__ bool next(int i, Unit& u) const {
        const int L = i * G + c; if (L >= nT * 8) return false;
        const int wgid = (L & 7) * nT + (L >> 3);
        u.pm = wgid >> 3; u.pn = wgid & 7; u.e = __builtin_amdgcn_readfirstlane(tile_e[u.pm]); u.nt = 0; u.kofs = 0; u.keep = 0; return true;
    }
    __device__ __forceinline__ int arow(const Unit& u, int R) const { const int lr = u.pm * BM - ps[u.e] + R; return (lr < cn[u.e]) ? list[(size_t)u.e * lcap + lr] : 0; }
    __device__ __forceinline__ void a_ready(const Unit&) const {}
    __device__ __forceinline__ void done(const Unit&) const {}
};
template <class Epi, class Sched, bool ALIGN_EPI = false, bool SP2 = false, bool GATHER = false, bool MX = false>
__device__ __forceinline__ void gemm_phase(const int wv  , PG8_LAS unsigned char* lds, const Gemm g, const Sched& S, const Epi& E, unsigned* dbg_out = nullptr) {
    const int lane = mk_lane(), wid = wv, tid = wid * 64 + lane, wr = wid >> 2, wc = wid & 3, fr = lane & 15, fq = lane >> 4;
    const int K = g.K, nt_all = K / BK;
    unsigned voffA[2], voffB[2];
#pragma unroll
    for (int i = 0; i < 2; ++i) { int R, C; stage_rc(tid * 16 + i * 8192, R, C); const int Rb = Epi::PERM ? ((R & ~31) + perm32(R & 31)) : R;
        voffA[i] = (unsigned)(R * K + C) * 2u; voffB[i] = (unsigned)(Rb * K + C) * 2u; }
    static_assert(!GATHER || SP2, "GATHER needs the SP2 loop");
    unsigned vc0[2], vc1[2];
#define PG8_V(arr) (GATHER ? (arr) : voffA)
#define PG8_GOFF(dst0, dst1, uu) do { _Pragma("unroll") for (int i_ = 0; i_ < 2; ++i_) { int R_, C_; stage_rc(tid * 16 + i_ * 8192, R_, C_); \
        dst0[i_] = (unsigned)(S.arow(uu, R_) * K + C_) * 2u; dst1[i_] = (unsigned)(S.arow(uu, R_ + HALF) * K + C_) * 2u; } } while (0)
    const size_t kstep = (size_t)(BK * 2);
    const size_t hstep = (size_t)HALF * K * 2;
    const size_t tstep = 2 * hstep;
    const size_t hstepA = GATHER ? (size_t)0 : hstep;
    const unsigned ldsw = (unsigned)wid * 1024u; const unsigned lds0 = (unsigned)(uintptr_t)lds;
    const int aoff = lds_byte(wr * 64 + fr, fq * 8), boff = lds_byte(wc * 32 + fr, fq * 8);
#define PG8_SA(b, h) (((b) * 2 + (h)) * HTB)
#define PG8_SB(b, h) ((4 + (b) * 2 + (h)) * HTB)
#define PG8_STAGE(bufoff, gbase, voff) do { const char* sb_ = (const char*)(gbase);       \
        _Pragma("unroll") for (int _i = 0; _i < 2; ++_i) { unsigned keep_; const unsigned ld_ = lds0 + (unsigned)(bufoff) + ldsw + (unsigned)_i * 8192u; \
            asm volatile("s_mov_b32 %0, m0\n\ts_mov_b32 m0, %3\n\ts_nop 2\n\tglobal_load_lds_dwordx4 %1, %2\n\ts_mov_b32 m0, %0" : "=&s"(keep_) : "v"((voff)[_i]), "s"(sb_), "s"(ld_) : "memory"); } } while (0)
#define PG8_LDA(dst, b, h) do { unsigned ab_ = (unsigned)(PG8_SA(b, h) + aoff); asm volatile("" : "+v"(ab_));   \
        _Pragma("unroll") for (int m = 0; m < 4; ++m) _Pragma("unroll") for (int k = 0; k < 2; ++k) dst[m][k] = *(const PG8_LAS bf16x8*)(lds + ab_ + m * 2048 + k * 1024); } while (0)
#define PG8_LDB(dst, b, h) do { unsigned bb_ = (unsigned)(PG8_SB(b, h) + boff); asm volatile("" : "+v"(bb_)); \
        _Pragma("unroll") for (int n = 0; n < 2; ++n) _Pragma("unroll") for (int k = 0; k < 2; ++k) dst[n][k] = *(const PG8_LAS bf16x8*)(lds + bb_ + n * 2048 + k * 1024); } while (0)
#define PG8_CAT8(x, y) __builtin_bit_cast(i32x8, __builtin_shufflevector(x, y, 0, 1, 2, 3, 4, 5, 6, 7, 8, 9, 10, 11, 12, 13, 14, 15))
#define PG8_MMA(ai, bj, At, Bt) do { __builtin_amdgcn_s_setprio(1); _Pragma("unroll") for (int m = 0; m < 4; ++m) _Pragma("unroll") for (int n = 0; n < 2; ++n) { \
        if constexpr (MX) acc[ai][bj][m][n] = __builtin_amdgcn_mfma_scale_f32_16x16x128_f8f6f4(PG8_CAT8(Bt[n][0], Bt[n][1]), PG8_CAT8(At[m][0], At[m][1]), acc[ai][bj][m][n], 0, 0, 0, 0x7f7f7f7f, 0, 0x7f7f7f7f); \
        else { _Pragma("unroll") for (int k = 0; k < 2; ++k) acc[ai][bj][m][n] = __builtin_amdgcn_mfma_f32_16x16x32_bf16(Bt[n][k], At[m][k], acc[ai][bj][m][n], 0, 0, 0); } } __builtin_amdgcn_s_setprio(0); } while (0)
#define PG8_WAIT_V(n) asm volatile("s_waitcnt vmcnt(" #n ")" ::: "memory")
#define PG8_WAIT_L(n) asm volatile("s_waitcnt lgkmcnt(" #n ")" ::: "memory")
#define PG8_BAR __builtin_amdgcn_s_barrier()
#define PG8_SCHED __builtin_amdgcn_sched_barrier(0)
    Unit cur, nxt; int ui = 0;
    if (!S.next(0, cur)) return;
    f32x4 acc[2][2][4][2];
#pragma unroll
    for (int a = 0; a < 2; ++a)
#pragma unroll
        for (int b = 0; b < 2; ++b)
#pragma unroll
            for (int m = 0; m < 4; ++m)
#pragma unroll
                for (int n = 0; n < 2; ++n) acc[a][b][m][n] = (f32x4){0.f, 0.f, 0.f, 0.f};
    bf16x8 At[4][2], B0[2][2], B1[2][2];
    const char* cA = (const char*)g.A + (GATHER ? (size_t)0 : (size_t)cur.pm * tstep) + cur.kofs; const char* cB = (const char*)g.Bt + (size_t)cur.pn * tstep + (size_t)cur.e * g.estride + cur.kofs;
    S.a_ready(cur);
    if constexpr (GATHER) { PG8_GOFF(vc0, vc1, cur); } else {
#pragma unroll
        for (int i = 0; i < 2; ++i) { vc0[i] = voffA[i]; vc1[i] = voffA[i]; } }
    if constexpr (SP2) {
        PG8_STAGE(PG8_SB(0, 0), cB, voffB); PG8_STAGE(PG8_SB(0, 1), cB + hstep, voffB); PG8_STAGE(PG8_SA(0, 0), cA, PG8_V(vc0)); PG8_STAGE(PG8_SA(0, 1), cA + hstepA, PG8_V(vc1));
        if (wr == 1) PG8_BAR;
        PG8_WAIT_V(2); PG8_BAR;
        PG8_STAGE(PG8_SB(1, 0), cB + kstep, voffB); PG8_STAGE(PG8_SA(1, 0), cA + kstep, PG8_V(vc0)); PG8_STAGE(PG8_SB(1, 1), cB + hstep + kstep, voffB);
        PG8_WAIT_V(6); PG8_BAR;
    } else {
        PG8_STAGE(PG8_SB(0, 0), cB, voffB); PG8_STAGE(PG8_SA(0, 0), cA, voffA); PG8_STAGE(PG8_SB(0, 1), cB + hstep, voffB); PG8_STAGE(PG8_SA(0, 1), cA + hstep, voffA);
        if (wr == 1) PG8_BAR;
        PG8_WAIT_V(4); PG8_BAR;
        PG8_STAGE(PG8_SB(1, 0), cB + kstep, voffB); PG8_STAGE(PG8_SA(1, 0), cA + kstep, voffA); PG8_STAGE(PG8_SB(1, 1), cB + hstep + kstep, voffB);
        PG8_WAIT_V(6); PG8_BAR;
    }
    for (;;) {
        const bool has_next = S.next(ui + 1, nxt);
        const char* nA = (has_next && !GATHER) ? (const char*)g.A + (size_t)nxt.pm * tstep + nxt.kofs : (GATHER ? (const char*)g.A : cA);
        const char* nB = has_next ? (const char*)g.Bt + (size_t)nxt.pn * tstep + (size_t)nxt.e * g.estride + nxt.kofs : cB;
        const int nt = cur.nt > 0 ? cur.nt : nt_all;
#if MK_DBG
        const unsigned long long dbg_k0 = __builtin_amdgcn_s_memtime();
#endif
        for (int t = 0; t < nt; t += 2) {
            const bool last = (t == nt - 2);
            const char* a1 = cA + (size_t)(t + 1) * kstep;
            const char* a2 = last ? nA : cA + (size_t)(t + 2) * kstep; const char* b2 = last ? nB : cB + (size_t)(t + 2) * kstep;
            const char* a3 = a2 + kstep; const char* b3 = b2 + kstep;
            if (last && has_next) S.a_ready(nxt);
            if constexpr (SP2) {
            PG8_LDB(B0, 0, 0); PG8_LDB(B1, 0, 1); PG8_SCHED; PG8_LDA(At, 0, 0); PG8_STAGE(PG8_SA(1, 1), a1 + hstepA, PG8_V(vc1));
            if constexpr (GATHER) { if (last && has_next) { PG8_GOFF(vc0, vc1, nxt); } }
            PG8_WAIT_V(8); PG8_WAIT_L(0); PG8_BAR; PG8_MMA(0, 0, At, B0); PG8_MMA(0, 1, At, B1); PG8_BAR; PG8_SCHED;
            PG8_LDA(At, 0, 1); PG8_STAGE(PG8_SB(0, 0), b2, voffB); PG8_STAGE(PG8_SB(0, 1), b2 + hstep, voffB); PG8_STAGE(PG8_SA(0, 0), a2, PG8_V(vc0));
            PG8_WAIT_V(8); PG8_WAIT_L(0); PG8_BAR; PG8_MMA(1, 0, At, B0); PG8_MMA(1, 1, At, B1); PG8_BAR; PG8_SCHED;
            PG8_LDB(B0, 1, 0); PG8_LDB(B1, 1, 1); PG8_SCHED; PG8_LDA(At, 1, 0); PG8_STAGE(PG8_SA(0, 1), a2 + hstepA, PG8_V(vc1));
            PG8_WAIT_V(8); PG8_WAIT_L(0); PG8_BAR; PG8_MMA(0, 0, At, B0); PG8_MMA(0, 1, At, B1); PG8_BAR; PG8_SCHED;
            PG8_LDA(At, 1, 1); PG8_STAGE(PG8_SB(1, 0), b3, voffB); PG8_STAGE(PG8_SB(1, 1), b3 + hstep, voffB); PG8_STAGE(PG8_SA(1, 0), a3, PG8_V(vc0));
            PG8_WAIT_V(8); PG8_WAIT_L(0); PG8_BAR; PG8_MMA(1, 0, At, B0); PG8_MMA(1, 1, At, B1); PG8_BAR; PG8_SCHED;
            } else {
            PG8_LDB(B0, 0, 0); PG8_SCHED; PG8_LDA(At, 0, 0); PG8_STAGE(PG8_SA(1, 1), a1 + hstep, voffA);
            PG8_WAIT_L(8); PG8_BAR; PG8_WAIT_L(0); PG8_MMA(0, 0, At, B0); PG8_BAR; PG8_SCHED;
            PG8_LDB(B1, 0, 1); PG8_STAGE(PG8_SB(0, 0), b2, voffB);
            PG8_BAR; PG8_WAIT_L(0); PG8_MMA(0, 1, At, B1); PG8_BAR;
            PG8_LDA(At, 0, 1); PG8_STAGE(PG8_SA(0, 0), a2, voffA);
            PG8_BAR; PG8_WAIT_L(0); PG8_MMA(1, 0, At, B0); PG8_BAR; PG8_SCHED;
            PG8_STAGE(PG8_SB(0, 1), b2 + hstep, voffB);
            PG8_WAIT_V(6); PG8_BAR; PG8_MMA(1, 1, At, B1); PG8_BAR;
            PG8_LDB(B0, 1, 0); PG8_SCHED; PG8_LDA(At, 1, 0); PG8_STAGE(PG8_SA(0, 1), a2 + hstep, voffA);
            PG8_WAIT_L(8); PG8_BAR; PG8_WAIT_L(0); PG8_MMA(0, 0, At, B0); PG8_BAR; PG8_SCHED;
            PG8_LDB(B1, 1, 1); PG8_STAGE(PG8_SB(1, 0), b3, voffB);
            PG8_BAR; PG8_WAIT_L(0); PG8_MMA(0, 1, At, B1); PG8_BAR;
            PG8_LDA(At, 1, 1); PG8_STAGE(PG8_SA(1, 0), a3, voffA);
            PG8_BAR; PG8_WAIT_L(0); PG8_MMA(1, 0, At, B0); PG8_BAR; PG8_SCHED;
            PG8_STAGE(PG8_SB(1, 1), b3 + hstep, voffB);
            PG8_WAIT_V(6); PG8_BAR; PG8_MMA(1, 1, At, B1); PG8_BAR;
            }
        }
#if MK_DBG
        if (MK_DBG_GEMM && dbg_out != nullptr && ui == 2 && blockIdx.x == 0 && tid == 0) { const unsigned long long d = __builtin_amdgcn_s_memtime() - dbg_k0; dbg_out[7] = (unsigned)(d / (unsigned long long)nt); }
#endif
        if constexpr (ALIGN_EPI) { if (wr == 0) PG8_BAR; }
        int lane_e = mk_lane(); asm volatile("" : "+v"(lane_e));
        const int fr_e = lane_e & 15, fq_e = lane_e >> 4;
        if constexpr (!Epi::AFTER_DRAIN) { E(acc, cur, wr, wc, fr_e, fq_e); if (MK_EPI2 && Epi::IDEM) { asm volatile("" ::: "memory"); E(acc, cur, wr, wc, fr_e, fq_e); } S.done(cur); }
        if (!has_next) break;
        if (!nxt.keep) {
#pragma unroll
        for (int a = 0; a < 2; ++a)
#pragma unroll
            for (int b = 0; b < 2; ++b)
#pragma unroll
                for (int m = 0; m < 4; ++m)
#pragma unroll
                    for (int n = 0; n < 2; ++n) acc[a][b][m][n] = (f32x4){0.f, 0.f, 0.f, 0.f};
        }
        cur = nxt; cA = nA; cB = nB; ++ui;
        if constexpr (ALIGN_EPI) { if (wr == 1) PG8_BAR; }
    }
    PG8_WAIT_V(0);
    if constexpr (!ALIGN_EPI) { if (wr == 0) PG8_BAR; }
    PG8_BAR;
    if constexpr (Epi::AFTER_DRAIN) { E.fused(acc, cur, wr, wc, fr, fq, lds, wid, lane); S.done(cur); }
#undef PG8_SA
#undef PG8_SB
#undef PG8_STAGE
#undef PG8_LDA
#undef PG8_LDB
#undef PG8_MMA
#undef PG8_WAIT_V
#undef PG8_WAIT_L
#undef PG8_BAR
#undef PG8_SCHED
#undef PG8_GOFF
#undef PG8_V
}
}
#include <cmath>
#ifndef ATT_KDUP
#define ATT_KDUP 1
#endif
#ifndef ATT_HALF
#define ATT_HALF(w) ((w) >> 2)
#endif
#ifndef MK_DBG
#define MK_DBG 0
#endif
#ifndef MK_DBG_SEL
#define MK_DBG_SEL 0
#endif
#ifndef ATT_PRIO
#define ATT_PRIO 0
#endif
#ifndef ATT_SIMPLE
#define ATT_SIMPLE 1
#endif
namespace att {
typedef unsigned short bf16_t;
typedef short bf16x8 __attribute__((ext_vector_type(8)));
typedef short s16x4 __attribute__((ext_vector_type(4)));
typedef short v4i16_t __attribute__((ext_vector_type(4)));
typedef float f32x16 __attribute__((ext_vector_type(16)));
typedef unsigned u32x4 __attribute__((ext_vector_type(4)));
#define ATT_LAS __attribute__((address_space(3)))
constexpr int SLOT = 16384, RSLOT = 2 * SLOT  , ATT_LDS_BYTES = 4 * RSLOT;
__device__ __forceinline__ int crow(int r, int hi) { return (r & 3) + 8 * (r >> 2) + 4 * hi; }
__device__ __forceinline__ void glds16(const void* gsrc, unsigned lds_dst) { unsigned keep;
    asm volatile("s_mov_b32 %0, m0\n\ts_mov_b32 m0, %2\n\ts_nop 0\n\tglobal_load_lds_dwordx4 %1, off\n\ts_mov_b32 m0, %0" : "=&s"(keep) : "v"(gsrc), "s"(lds_dst) : "memory"); }
__device__ __forceinline__ const void* uniform_ptr(const void* p) { const unsigned long long v = (unsigned long long)p;
    return (const void*)(((unsigned long long)(unsigned)__builtin_amdgcn_readfirstlane((unsigned)(v >> 32)) << 32) | (unsigned long long)(unsigned)__builtin_amdgcn_readfirstlane((unsigned)v)); }
__device__ __forceinline__ void glds16s(const void* sbase, unsigned voff, unsigned lds_dst) { unsigned keep;
    asm volatile("s_mov_b32 %0, m0\n\ts_mov_b32 m0, %3\n\ts_nop 4\n\tglobal_load_lds_dwordx4 %1, %2\n\ts_mov_b32 m0, %0" : "=&s"(keep) : "v"(voff), "s"(sbase), "s"(lds_dst) : "memory"); }
typedef float f32x2_t __attribute__((ext_vector_type(2))); typedef __bf16 bf16x2_t __attribute__((ext_vector_type(2)));
__device__ __forceinline__ unsigned cvtpk(float lo, float hi) { f32x2_t v = {lo, hi}; bf16x2_t b = __builtin_convertvector(v, bf16x2_t); return __builtin_bit_cast(unsigned, b); }
__device__ __forceinline__ s16x4 vtr(ATT_LAS const char* p) { return __builtin_bit_cast(s16x4, __builtin_amdgcn_ds_read_tr16_b64_v4i16((ATT_LAS v4i16_t*)p)); }
__device__ __forceinline__ float swapsum(float m) { auto rr = __builtin_amdgcn_permlane32_swap(__float_as_uint(m), __float_as_uint(m), false, false); return __uint_as_float(rr[0]) + __uint_as_float(rr[1]); }

template <int DK>
__device__ __forceinline__ void attn_unit(const bf16_t* Qp, const bf16_t* Kp, const bf16_t* Vp, int i0, int t_lo, int t_hi, int win, int wskip, float slope2, float cref,
                                          bf16_t* Op, long ostride, float* lsep, long lstride, ATT_LAS unsigned char* lds, ATT_LAS float* wsbase, const int wv, unsigned* dbgp = nullptr) {
    constexpr int NKS = DK / 16;
    constexpr int NKW = DK / 64;
    const int lane = mk_lane(), r32 = lane & 31, hi = lane >> 5; const int wid = wv; const int tid = wid * 64 + lane;
    i0 = __builtin_amdgcn_readfirstlane(i0); t_lo = __builtin_amdgcn_readfirstlane(t_lo); t_hi = __builtin_amdgcn_readfirstlane(t_hi); win = __builtin_amdgcn_readfirstlane(win); wskip = __builtin_amdgcn_readfirstlane(wskip);
    const int half = ATT_HALF(wid);
    const int qrow = i0 + 32 * wid + r32, qmin_w = i0 + 32 * wid, qmax_w = qmin_w + 31;
    const unsigned lds0 = (unsigned)(uintptr_t)lds;
    ATT_LAS float* wsf = wsbase + wid * 64;
    const int NT = t_hi - t_lo;
    unsigned koff[NKW], voff[2];
#pragma unroll
    for (int i = 0; i < NKW; ++i) { const int p = wid + 8 * i;
        if (DK == 64) { const int r = 8 * p + (lane >> 3), pc = lane & 7; koff[i] = (unsigned)(r * 128 + ((pc ^ ((r >> 1) & 7)) << 4)); }
        else          { const int r = 4 * p + (lane >> 4), pc = lane & 15; koff[i] = (unsigned)(r * 256 + ((pc ^ (r & 15)) << 4)); } }
#pragma unroll
    for (int i = 0; i < 2; ++i) { const int p = wid + 8 * i, r = 4 * p + (lane >> 4), pc = lane & 15; voff[i] = (unsigned)(r * 256 + ((pc ^ (((r & 3) << 2) | ((r >> 2) & 3))) << 4)); }
    constexpr long ktile = 64L * DK, vtile = 64L * 128;
#define ATT_DMA(t, slot) do { \
        _Pragma("unroll") for (int d_ = 0; d_ < ATT_KDUP; ++d_) _Pragma("unroll") for (int i_ = 0; i_ < NKW; ++i_) glds16s(uniform_ptr(Kp + (long)(t) * ktile), koff[i_], (unsigned)__builtin_amdgcn_readfirstlane(lds0 + (slot) * RSLOT + (wid + 8 * i_) * 1024)); \
        _Pragma("unroll") for (int i_ = 0; i_ < 2; ++i_)   glds16s(uniform_ptr(Vp + (long)(t) * vtile), voff[i_], (unsigned)__builtin_amdgcn_readfirstlane(lds0 + (slot) * RSLOT + SLOT + (wid + 8 * i_) * 1024)); } while (0)
#define ATT_NEED(t) (!(64 * (t) > qmax_w || 64 * (t) + 63 < qmin_w - wskip))
    ATT_DMA(t_lo, 0);
    if (NT > 1) ATT_DMA(t_lo + 1, 1);
    bf16x8 qr[NKS];
#pragma unroll
    for (int d0 = 0; d0 < NKS; ++d0) qr[d0] = *reinterpret_cast<const bf16x8*>(Qp + (long)qrow * DK + d0 * 16 + hi * 8);
    float l_run = 0.f;
    f32x16 o[4];
#pragma unroll
    for (int d = 0; d < 4; ++d)
#pragma unroll
        for (int r = 0; r < 16; ++r) o[d][r] = 0.f;
    f32x16 p0, p1; bf16x8 pa[4];
#pragma unroll
    for (int r = 0; r < 16; ++r) { p0[r] = 0.f; p1[r] = 0.f; }
#pragma unroll
    for (int i = 0; i < 4; ++i) pa[i] = (bf16x8){0, 0, 0, 0, 0, 0, 0, 0};
    const int ksw = (DK == 64) ? ((r32 >> 1) & 7) : (r32 & 15);
    const unsigned kbx = (unsigned)(r32 * (DK * 2) + ((hi ^ (ksw & 1)) << 4) + ((ksw >> 1) << 5));
    const int vq = (lane & 15) >> 2, vpp = lane & 3, vblk = (lane >> 4) & 1;
    const unsigned vbx = (unsigned)(SLOT + 1024 * hi + 256 * vq + 8 * (vpp & 1) + 64 * vq + 16 * ((2 * vblk + (vpp >> 1)) ^ hi));
    ATT_LAS const char* const ldsc = (ATT_LAS const char*)lds;
    if (NT > 1) { if (NKW * ATT_KDUP == 1) asm volatile("s_waitcnt vmcnt(3)" ::: "memory"); else if (NKW * ATT_KDUP == 2) asm volatile("s_waitcnt vmcnt(4)" ::: "memory"); else asm volatile("s_waitcnt vmcnt(6)" ::: "memory"); } else asm volatile("s_waitcnt vmcnt(0)" ::: "memory");
    asm volatile("s_waitcnt lgkmcnt(0)\n\ts_barrier" ::: "memory");
#pragma unroll
    for (int d0 = 0; d0 < NKS; ++d0) asm volatile("" : "+v"(qr[d0]));
#if ATT_SIMPLE
#define ATT_QK(tr_) do { const int t_ = t_lo + (tr_); \
        const float tb = slope2 * (float)(64 * t_ + 4 * hi - qrow) - cref; \
        _Pragma("unroll") for (int r = 0; r < 16; ++r) { p0[r] = __builtin_fmaf(slope2, (float)((r & 3) + 8 * (r >> 2)), tb); p1[r] = __builtin_fmaf(slope2, (float)(32 + (r & 3) + 8 * (r >> 2)), tb); } \
        unsigned kb_ = kbx + ((tr_) & 3) * RSLOT; asm volatile("" : "+v"(kb_)); \
        _Pragma("unroll") for (int blk = 0; blk < NKS / 4; ++blk) { \
            unsigned ka[4]; \
            _Pragma("unroll") for (int j = 0; j < 4; ++j) ka[j] = kb_ ^ (unsigned)(32 * (4 * blk + j)); \
            bf16x8 kb0[4], kb1[4]; \
            _Pragma("unroll") for (int j = 0; j < 4; ++j) { ATT_LAS const char* kp = ldsc + ka[j]; kb0[j] = *(ATT_LAS const bf16x8*)kp; kb1[j] = *(ATT_LAS const bf16x8*)(kp + 32 * DK * 2); } \
            __builtin_amdgcn_sched_barrier(0); if (ATT_PRIO) __builtin_amdgcn_s_setprio(1); \
            _Pragma("unroll") for (int j = 0; j < 4; ++j) { p0 = __builtin_amdgcn_mfma_f32_32x32x16_bf16(kb0[j], qr[4 * blk + j], p0, 0, 0, 0); p1 = __builtin_amdgcn_mfma_f32_32x32x16_bf16(kb1[j], qr[4 * blk + j], p1, 0, 0, 0); } \
            if (ATT_PRIO) __builtin_amdgcn_s_setprio(0); __builtin_amdgcn_sched_barrier(0); } } while (0)
#define ATT_SM(tr_) do { const int t_ = t_lo + (tr_); \
        if (64 * t_ + 63 > qmin_w || 64 * t_ < qmax_w - win) {        \
            const int dq = qrow - 64 * t_ - 4 * hi; const unsigned uw = (unsigned)win; \
            _Pragma("unroll") for (int r = 0; r < 16; ++r) { const int c = (r & 3) + 8 * (r >> 2); \
                if ((unsigned)(dq - c) > uw) p0[r] = -INFINITY; if ((unsigned)(dq - c - 32) > uw) p1[r] = -INFINITY; } } \
        float sa = 0.f, sb = 0.f, sc = 0.f, sd = 0.f; \
        _Pragma("unroll") for (int r = 0; r < 16; r += 2) { p0[r] = __builtin_amdgcn_exp2f(p0[r]); p0[r + 1] = __builtin_amdgcn_exp2f(p0[r + 1]); p1[r] = __builtin_amdgcn_exp2f(p1[r]); p1[r + 1] = __builtin_amdgcn_exp2f(p1[r + 1]); \
            sa += p0[r]; sb += p0[r + 1]; sc += p1[r]; sd += p1[r + 1]; } \
        l_run += (sa + sb) + (sc + sd); \
        u32x4 w; \
        w.x = cvtpk(p0[0], p0[1]); w.y = cvtpk(p0[2], p0[3]); w.z = cvtpk(p0[4], p0[5]); w.w = cvtpk(p0[6], p0[7]); pa[0] = __builtin_bit_cast(bf16x8, w); \
        w.x = cvtpk(p0[8], p0[9]); w.y = cvtpk(p0[10], p0[11]); w.z = cvtpk(p0[12], p0[13]); w.w = cvtpk(p0[14], p0[15]); pa[1] = __builtin_bit_cast(bf16x8, w); \
        w.x = cvtpk(p1[0], p1[1]); w.y = cvtpk(p1[2], p1[3]); w.z = cvtpk(p1[4], p1[5]); w.w = cvtpk(p1[6], p1[7]); pa[2] = __builtin_bit_cast(bf16x8, w); \
        w.x = cvtpk(p1[8], p1[9]); w.y = cvtpk(p1[10], p1[11]); w.z = cvtpk(p1[12], p1[13]); w.w = cvtpk(p1[14], p1[15]); pa[3] = __builtin_bit_cast(bf16x8, w); } while (0)
#define ATT_PV(tr_) do { unsigned vb_ = vbx + ((tr_) & 3) * RSLOT; asm volatile("" : "+v"(vb_)); if (ATT_PRIO) __builtin_amdgcn_s_setprio(1); \
        s16x4 vl[16], vh[16]; \
        _Pragma("unroll") for (int i = 0; i < 16; ++i) { vl[i] = vtr(ldsc + (vb_ ^ (unsigned)(64 * (i >> 2))) + (i & 3) * 4096); vh[i] = vtr(ldsc + (vb_ ^ (unsigned)(64 * (i >> 2) + 32)) + (i & 3) * 4096 + 2048); } \
        _Pragma("unroll") for (int i = 0; i < 16; ++i) { \
            const bf16x8 vf = (bf16x8){vl[i][0], vl[i][1], vl[i][2], vl[i][3], vh[i][0], vh[i][1], vh[i][2], vh[i][3]}; \
            o[i >> 2] = __builtin_amdgcn_mfma_f32_32x32x16_bf16(pa[i & 3], vf, o[i >> 2], 0, 0, 0); } \
        __builtin_amdgcn_sched_group_barrier(0x100, 8, 0); \
        _Pragma("unroll") for (int i = 0; i < 12; ++i) { __builtin_amdgcn_sched_group_barrier(0x8, 1, 0); __builtin_amdgcn_sched_group_barrier(0x100, 2, 0); } \
        _Pragma("unroll") for (int i = 0; i < 4; ++i) __builtin_amdgcn_sched_group_barrier(0x8, 1, 0); if (ATT_PRIO) __builtin_amdgcn_s_setprio(0); } while (0)
#if ATT_SIMPLE == 3
    if (half) asm volatile("s_waitcnt lgkmcnt(0)\n\ts_barrier" ::: "memory");
    for (int tr = 0; tr <= NT; ++tr) {
        if (tr + 2 < NT) ATT_DMA(t_lo + tr + 2, (tr + 2) & 3);
        if (tr > 0 && ATT_NEED(t_lo + tr - 1)) { ATT_PV(tr - 1); }
        if (tr < NT && ATT_NEED(t_lo + tr)) { ATT_QK(tr); }
        if (tr + 2 < NT) { if (NKW == 1) asm volatile("s_waitcnt vmcnt(3)" ::: "memory"); else asm volatile("s_waitcnt vmcnt(4)" ::: "memory"); } else asm volatile("s_waitcnt vmcnt(0)" ::: "memory");
        asm volatile("s_waitcnt lgkmcnt(0)\n\ts_barrier" ::: "memory");
        if (tr == NT) break;
        if (ATT_NEED(t_lo + tr)) { ATT_SM(tr); }
        asm volatile("s_waitcnt lgkmcnt(0)\n\ts_barrier" ::: "memory");
    }
    if (!half) asm volatile("s_waitcnt lgkmcnt(0)\n\ts_barrier" ::: "memory");
#elif ATT_SIMPLE == 2
    for (int tr = 0; tr < NT; ++tr) {
        if (tr + 1 < NT) { if (NKW == 1) asm volatile("s_waitcnt vmcnt(3)" ::: "memory"); else asm volatile("s_waitcnt vmcnt(4)" ::: "memory"); } else asm volatile("s_waitcnt vmcnt(0)" ::: "memory");
        asm volatile("s_waitcnt lgkmcnt(0)\n\ts_barrier" ::: "memory");
        if (tr + 2 < NT) ATT_DMA(t_lo + tr + 2, (tr + 2) & 3);
        if (half == 0) {
            if (ATT_NEED(t_lo + tr)) { ATT_QK(tr); ATT_SM(tr); ATT_PV(tr); }
        } else {
            if (tr > 0 && ATT_NEED(t_lo + tr - 1)) { ATT_SM(tr - 1); ATT_PV(tr - 1); }
            if (ATT_NEED(t_lo + tr)) { ATT_QK(tr); }
        }
    }
    if (half != 0 && ATT_NEED(t_lo + NT - 1)) { ATT_SM(NT - 1); ATT_PV(NT - 1); }
#else
    for (int tp = 0; tp < NT; tp += 2) {
        asm volatile("s_waitcnt vmcnt(0)" ::: "memory");
        asm volatile("s_waitcnt lgkmcnt(0)\n\ts_barrier" ::: "memory");
        if (tp + 2 < NT) ATT_DMA(t_lo + tp + 2, (tp + 2) & 3);
        if (tp + 3 < NT) ATT_DMA(t_lo + tp + 3, (tp + 3) & 3);
#pragma unroll 1
        for (int sub = 0; sub < 2; ++sub) { const int tr = tp + sub; if (tr >= NT || !ATT_NEED(t_lo + tr)) continue; ATT_QK(tr); ATT_SM(tr); ATT_PV(tr); }
    }
#endif
#undef ATT_QK
#undef ATT_SM
#undef ATT_PV
    asm volatile("s_waitcnt vmcnt(0) lgkmcnt(0)\n\ts_barrier" ::: "memory");
#else
    const int nslots = 2 * NT + 2;
#if MK_DBG
    unsigned long long dbg_t0 = __builtin_amdgcn_s_memtime(), dbg_w = 0, dbg_a = 0, dbg_b = 0;
#endif
    for (int s = 0; s < nslots; ++s) {
        if ((s & 1) == 0) { const int tt = s >> 1; if (tt + 2 < NT) ATT_DMA(t_lo + tt + 2, (tt + 2) & 3); }
        const int k = s - half;
#if MK_DBG
        const unsigned long long dbg_pp = __builtin_amdgcn_s_memtime();
#endif
        if (k >= 0 && k <= 2 * NT) {
            const int tr = k >> 1, t = t_lo + tr;
            if ((k & 1) == 0) {
                const bool doqk = (tr < NT) && ATT_NEED(t), dopv = (tr >= 1) && ATT_NEED(t - 1);
                if (dopv) {
                    unsigned vb_ = vbx + ((tr - 1) & 3) * RSLOT; asm volatile("" : "+v"(vb_));
                    s16x4 vl[16], vh[16];
#pragma unroll
                    for (int i = 0; i < 16; ++i) { vl[i] = vtr(ldsc + (vb_ ^ (unsigned)(64 * (i >> 2))) + (i & 3) * 4096); vh[i] = vtr(ldsc + (vb_ ^ (unsigned)(64 * (i >> 2) + 32)) + (i & 3) * 4096 + 2048); }
#pragma unroll
                    for (int i = 0; i < 16; ++i) {
                        const bf16x8 vf = (bf16x8){vl[i][0], vl[i][1], vl[i][2], vl[i][3], vh[i][0], vh[i][1], vh[i][2], vh[i][3]};
                        o[i >> 2] = __builtin_amdgcn_mfma_f32_32x32x16_bf16(pa[i & 3], vf, o[i >> 2], 0, 0, 0); }
                    __builtin_amdgcn_sched_group_barrier(0x100, 8, 0);
#pragma unroll
                    for (int i = 0; i < 12; ++i) { __builtin_amdgcn_sched_group_barrier(0x8, 1, 0); __builtin_amdgcn_sched_group_barrier(0x100, 2, 0); }
#pragma unroll
                    for (int i = 0; i < 4; ++i) __builtin_amdgcn_sched_group_barrier(0x8, 1, 0);
                }
                __builtin_amdgcn_sched_barrier(0);
                if (doqk) {
                    const float tb = slope2 * (float)(64 * t + 4 * hi - qrow) - cref;
#pragma unroll
                    for (int r = 0; r < 16; ++r) { p0[r] = __builtin_fmaf(slope2, (float)((r & 3) + 8 * (r >> 2)), tb); p1[r] = __builtin_fmaf(slope2, (float)(32 + (r & 3) + 8 * (r >> 2)), tb); }
                    unsigned kb_ = kbx + (tr & 3) * RSLOT; asm volatile("" : "+v"(kb_));
#pragma unroll
                    for (int blk = 0; blk < NKS / 4; ++blk) {
                        unsigned ka[4];
#pragma unroll
                        for (int j = 0; j < 4; ++j) ka[j] = kb_ ^ (unsigned)(32 * (4 * blk + j));
                        bf16x8 kb0[4], kb1[4];
#pragma unroll
                        for (int j = 0; j < 4; ++j) { ATT_LAS const char* kp = ldsc + ka[j]; kb0[j] = *(ATT_LAS const bf16x8*)kp; kb1[j] = *(ATT_LAS const bf16x8*)(kp + 32 * DK * 2); }
                        __builtin_amdgcn_sched_barrier(0);
#pragma unroll
                        for (int j = 0; j < 4; ++j) { p0 = __builtin_amdgcn_mfma_f32_32x32x16_bf16(kb0[j], qr[4 * blk + j], p0, 0, 0, 0); p1 = __builtin_amdgcn_mfma_f32_32x32x16_bf16(kb1[j], qr[4 * blk + j], p1, 0, 0, 0); }
                        __builtin_amdgcn_sched_barrier(0);
                    }
                }
            } else if (tr < NT && ATT_NEED(t)) {
                if (64 * t + 63 > qmin_w || 64 * t < qmax_w - win) {
                    const int kb = 64 * t + 4 * hi, lo = qrow - win;
#pragma unroll
                    for (int r = 0; r < 16; ++r) { const int kv = kb + (r & 3) + 8 * (r >> 2);
                        if (kv > qrow || kv < lo) p0[r] = -INFINITY; if (kv + 32 > qrow || kv + 32 < lo) p1[r] = -INFINITY; }
                }
                float sa = 0.f, sb = 0.f, sc = 0.f, sd = 0.f;
#pragma unroll
                for (int r = 0; r < 16; r += 2) { p0[r] = __builtin_amdgcn_exp2f(p0[r]); p0[r + 1] = __builtin_amdgcn_exp2f(p0[r + 1]); p1[r] = __builtin_amdgcn_exp2f(p1[r]); p1[r + 1] = __builtin_amdgcn_exp2f(p1[r + 1]);
                    sa += p0[r]; sb += p0[r + 1]; sc += p1[r]; sd += p1[r + 1]; }
                l_run += (sa + sb) + (sc + sd);
                { u32x4 w;
                  w.x = cvtpk(p0[0], p0[1]); w.y = cvtpk(p0[2], p0[3]); w.z = cvtpk(p0[4], p0[5]); w.w = cvtpk(p0[6], p0[7]); pa[0] = __builtin_bit_cast(bf16x8, w);
                  w.x = cvtpk(p0[8], p0[9]); w.y = cvtpk(p0[10], p0[11]); w.z = cvtpk(p0[12], p0[13]); w.w = cvtpk(p0[14], p0[15]); pa[1] = __builtin_bit_cast(bf16x8, w);
                  w.x = cvtpk(p1[0], p1[1]); w.y = cvtpk(p1[2], p1[3]); w.z = cvtpk(p1[4], p1[5]); w.w = cvtpk(p1[6], p1[7]); pa[2] = __builtin_bit_cast(bf16x8, w);
                  w.x = cvtpk(p1[8], p1[9]); w.y = cvtpk(p1[10], p1[11]); w.z = cvtpk(p1[12], p1[13]); w.w = cvtpk(p1[14], p1[15]); pa[3] = __builtin_bit_cast(bf16x8, w); }
            }
        }
#if MK_DBG
        const unsigned long long dbg_t1 = __builtin_amdgcn_s_memtime();
        if (k >= 0 && k <= 2 * NT) { if ((k & 1) == 0) dbg_a += dbg_t1 - dbg_pp; else dbg_b += dbg_t1 - dbg_pp; }
#endif
        if (s & 1) { if ((s >> 1) + 2 < NT) { if (NKW * ATT_KDUP == 1) asm volatile("s_waitcnt vmcnt(3)" ::: "memory"); else if (NKW * ATT_KDUP == 2) asm volatile("s_waitcnt vmcnt(4)" ::: "memory"); else asm volatile("s_waitcnt vmcnt(6)" ::: "memory"); } else asm volatile("s_waitcnt vmcnt(0)" ::: "memory"); }
        asm volatile("s_waitcnt lgkmcnt(0)\n\ts_barrier" ::: "memory");
#if MK_DBG
        dbg_w += __builtin_amdgcn_s_memtime() - dbg_t1;
#endif
    }
#if MK_DBG
    if (dbgp != nullptr && tid == 0) { const unsigned long long tt = __builtin_amdgcn_s_memtime() - dbg_t0; dbgp[0] = (unsigned)(tt / (unsigned long long)nslots); dbgp[1] = (unsigned)(dbg_w / (unsigned long long)nslots); dbgp[2] = (unsigned)nslots; dbgp[3] = (unsigned)(dbg_a / (unsigned long long)(NT + 1)); dbgp[4] = (unsigned)(dbg_b / (unsigned long long)NT); }
#endif
#endif
#undef ATT_DMA
#undef ATT_NEED
    int lane_e = lane; asm volatile("" : "+v"(lane_e));
    const int r32e = lane_e & 31, hie = lane_e >> 5;
    const float l_tot = swapsum(l_run);
    if (hie == 0) wsf[32 + r32e] = l_tot;
    if (lsep != nullptr && hie == 0) lsep[(long)(i0 + 32 * wid + r32e) * lstride] = __builtin_amdgcn_logf(l_tot) + cref;
    {
        ATT_LAS unsigned short* stg = (ATT_LAS unsigned short*)(lds + wid * 8192);
#pragma unroll
        for (int r = 0; r < 16; ++r) { const int orow = crow(r, hie); const float rl = __builtin_amdgcn_rcpf(wsf[32 + orow]);
#pragma unroll
            for (int d0 = 0; d0 < 4; ++d0) stg[orow * 128 + d0 * 32 + r32e] = (unsigned short)(cvtpk(o[d0][r] * rl, 0.f) & 0xffffu); }
        asm volatile("s_waitcnt lgkmcnt(0)" ::: "memory");
        bf16_t* Ow = Op + (long)(i0 + 32 * wid) * ostride;
#pragma unroll
        for (int i = 0; i < 8; ++i) { const int row = i * 4 + (lane_e >> 4), ch = lane_e & 15; const u32x4 v = *(ATT_LAS const u32x4*)(stg + row * 128 + ch * 8); *(u32x4*)(Ow + (long)row * ostride + ch * 8) = v; }
    }
    asm volatile("s_waitcnt lgkmcnt(0)\n\ts_barrier" ::: "memory");
}
}
constexpr int NWAVES = 8;
constexpr int BATCH = 2, SEQ = 8192, DM = 2048, M = BATCH * SEQ;
constexpr int NIN = 11776;
#ifndef MK_NINP
#define MK_NINP 11776
#endif
constexpr int NINP = MK_NINP;
constexpr int C_DAQ = 0, C_DAK = 1024, C_DAV = 2048, C_DLQ = 3072, C_DLK = 4608, C_DLV = 6144, C_GA = 7680, C_GB = 9728;
constexpr int NE = 32, DFF = 1024, TK = 2 * M;
constexpr int XS_ROWS = TK + NE * 256;
constexpr float EPS = 1e-6f, LOG2E = 1.4426950408889634f;
constexpr float LAM_INIT = 0.2f;

#ifndef MK_N_LAUNCHES
#define MK_N_LAUNCHES 1
#endif
constexpr int N_PHASES = 12;
#ifndef MK_DBG_Q
#define MK_DBG_Q 250u
#endif
#ifndef MK_DBG_THR
#define MK_DBG_THR 0u
#endif
#ifndef MK_DBG_UNIT
#define MK_DBG_UNIT 0
#endif
#ifndef MK_SPLIT_AT
#define MK_SPLIT_AT (-1)
#endif
#ifndef MK_REPEAT_SUB
#define MK_REPEAT_SUB 3
#endif

constexpr size_t MiB = 1u << 20;
constexpr size_t WS_CTL = 0, CTL_ZERO_BYTES = 256 * 1024;
constexpr size_t WS_WR   = 1 * MiB;
constexpr size_t WS_GAIN = 1 * MiB + 512 * 1024;
constexpr size_t WS_ROUTE = 2 * MiB;
constexpr size_t WS_LSE  = 3 * MiB;
constexpr size_t WS_WIN  = 4 * MiB;
constexpr size_t WS_WIN8 = 36 * MiB;
constexpr size_t WS_XN8  = 672 * MiB;
constexpr size_t WS_WA   = 50 * MiB;
constexpr size_t WS_WB   = 54 * MiB;
constexpr size_t WS_WO   = 56 * MiB;
constexpr size_t WS_WGU  = 64 * MiB;
constexpr size_t WS_WD   = 320 * MiB;
constexpr size_t WS_XN   = 448 * MiB;
constexpr size_t WS_ODA  = 512 * MiB;
constexpr size_t WS_ODL  = 576 * MiB;
constexpr size_t WS_OA   = 624 * MiB;
constexpr size_t WS_OB   = 656 * MiB;
constexpr size_t WS_MIX  = 672 * MiB;
constexpr size_t WS_PROJ = 736 * MiB;
constexpr size_t WS_XS   = WS_PROJ;
constexpr size_t WS_Y8   = WS_PROJ + 240 * MiB;
constexpr size_t WS_HB   = WS_PROJ + 160 * MiB;
constexpr size_t WS_LIST = WS_PROJ + 376 * MiB;
constexpr size_t WS_RSL  = WS_LIST + 2 * MiB;
constexpr size_t WS_END  = WS_RSL + 2 * MiB;
static_assert((size_t)XS_ROWS * 2048 * 2 <= 160 * MiB && (size_t)XS_ROWS * 1024 * 2 <= 80 * MiB && (size_t)M * NINP * 2 <= 376 * MiB, "ws map");
constexpr int CW_TMO = 0, CW_CODE = 1;
constexpr int CW_BAR = 4096;
constexpr int CW_CNT = 16384, CW_FILL = 16384 + 64;
static_assert(true, "");
constexpr int CW_TQ = 24576;
constexpr int CW_DBG = 20480;
constexpr int CW_QUEUE = 20544;

constexpr int RING_OFF = 0, RING_BYTES = 131072;
constexpr int LDSCTL_OFF = RING_BYTES, MISC_OFF = LDSCTL_OFF + 320;
constexpr int TILE_E_OFF = LDSCTL_OFF + 1024;
constexpr int XCH_OFF = LDSCTL_OFF + 2048;
constexpr int LDS_BYTES = 147456;
static_assert(XCH_OFF + 8192 <= LDS_BYTES && att::ATT_LDS_BYTES <= RING_BYTES, "LDS map");

#define GAS __attribute__((address_space(1)))
#define LAS __attribute__((address_space(3)))
typedef unsigned short bf16;
typedef unsigned v4u __attribute__((ext_vector_type(4)));
typedef float f32x4 __attribute__((ext_vector_type(4)));
typedef short bf16x8 __attribute__((ext_vector_type(8)));
typedef GAS unsigned gu32;
typedef GAS unsigned long long gu64;
#define RLX_AGENT __ATOMIC_RELAXED, __HIP_MEMORY_SCOPE_AGENT
#define LDS_WAIT() asm volatile("s_waitcnt lgkmcnt(0)" ::: "memory")
#define VM_WAIT() asm volatile("s_waitcnt vmcnt(0)" ::: "memory")
__device__ __forceinline__ unsigned long long rt() { return __builtin_amdgcn_s_memrealtime(); }
__device__ __forceinline__ unsigned f2bf(float f) { unsigned u = __builtin_bit_cast(unsigned, f); return (u + 0x7fffu + ((u >> 16) & 1u)) >> 16; }
__device__ __forceinline__ unsigned pk2(float lo, float hi) { return f2bf(lo) | (f2bf(hi) << 16); }

#define XB_TMO      128
#define XB_XCNT(j)  (256  + 64 * (j))
#define XB_XSUB(j)  (1280 + 64 * (j))
#define XB_XGEN(j)  (2304 + 64 * (j))
#define XB_TOP      3328
#define XB_TOPGEN   3392
#define XCD_BAR_WORDS 3456
#define XB_SPIN_CAP (1u << 18)

__device__ __forceinline__ unsigned xb_ld(unsigned* p)              { return __hip_atomic_load(p, __ATOMIC_RELAXED, __HIP_MEMORY_SCOPE_AGENT); }
__device__ __forceinline__ unsigned xb_add(unsigned* p, unsigned v) { return __hip_atomic_fetch_add(p, v, __ATOMIC_RELAXED, __HIP_MEMORY_SCOPE_AGENT); }
__device__ __forceinline__ unsigned xb_xcc_id() { return (unsigned)__builtin_amdgcn_s_getreg((3 << 11) | 20) & 0xFu; }
#define XB_SPIN(cond, bar) do { unsigned _sp = 0; while (cond) { __builtin_amdgcn_s_sleep(1); \
    if ((++_sp & 255u) == 0u) { if (xb_ld(&(bar)[XB_TMO])) break; if (_sp > XB_SPIN_CAP) { atomicAdd(&(bar)[XB_TMO], 1u); break; } } } } while (0)

struct XcdBarrier {
    unsigned* bar; unsigned x; unsigned w0;
    volatile LAS unsigned* st;
};

__device__ __forceinline__ XcdBarrier xcd_barrier_post(unsigned* bar, volatile LAS unsigned* st, unsigned w0) {
    XcdBarrier b; b.bar = bar; b.x = xb_xcc_id(); b.st = st; b.w0 = w0;
    if (w0 && mk_lane() == 0) (void)xb_add(&bar[XB_XCNT(b.x)], 1u);
    return b;
}
__device__ __forceinline__ void xcd_barrier_complete(unsigned* bar, unsigned x, unsigned& nloc, unsigned& nx) {
    const unsigned G = gridDim.x * gridDim.y * gridDim.z;
    unsigned sum, cnt, mine, sp = 0u;
    for (;;) {
        sum = 0u; cnt = 0u; mine = 0u;
#pragma unroll
        for (unsigned j = 0; j < 16; ++j) { const unsigned c = xb_ld(&bar[XB_XCNT(j)]); sum += c; cnt += (c > 0u) ? 1u : 0u; mine = (j == x) ? c : mine; }
        if (sum == G) break;
        __builtin_amdgcn_s_sleep(1);
        if ((++sp & 255u) == 0u) { if (xb_ld(&bar[XB_TMO])) break; if (sp > XB_SPIN_CAP) { atomicAdd(&bar[XB_TMO], 1u); break; } }
    }
    nloc = mine > 0u ? mine : 1u; nx = cnt > 0u ? cnt : 1u;
}

__device__ __forceinline__ void xcd_barrier(const XcdBarrier& b) {
    asm volatile("s_waitcnt vmcnt(0)" ::: "memory");
    __syncthreads();
    if (b.w0 && mk_lane() == 0) {
        unsigned* bar = b.bar;
        __builtin_amdgcn_s_waitcnt(0);
        unsigned nloc = b.st[0], nx = b.st[1];
        if (nloc == 0u) { xcd_barrier_complete(bar, b.x, nloc, nx); b.st[0] = nloc; b.st[1] = nx; }
        const unsigned old = xb_add(&bar[XB_XSUB(b.x)], 1u);
        const unsigned gen = old / nloc;
        if (old + 1u == (gen + 1u) * nloc) {
            __builtin_amdgcn_fence(__ATOMIC_RELEASE, "agent");
            asm volatile("s_waitcnt vmcnt(0)" ::: "memory");
            const unsigned og = xb_add(&bar[XB_TOP], 1u);
            const unsigned tg = og / nx;
            if (og + 1u == (tg + 1u) * nx) xb_add(&bar[XB_TOPGEN], 1u);
            else XB_SPIN(xb_ld(&bar[XB_TOPGEN]) == tg, bar);
            __builtin_amdgcn_fence(__ATOMIC_ACQUIRE, "agent");
            xb_add(&bar[XB_XGEN(b.x)], 1u);
            asm volatile("s_waitcnt vmcnt(0)" ::: "memory");
        } else {
            XB_SPIN(xb_ld(&bar[XB_XGEN(b.x)]) == gen, bar);
            __builtin_amdgcn_fence(__ATOMIC_ACQUIRE, "agent");
            asm volatile("s_waitcnt vmcnt(0)" ::: "memory");
        }
    }
    __syncthreads();
}
struct Args { const float* in[18]; float* out; unsigned char* ws; int ph_lo, ph_hi, li, sub; };
struct Frame {
    const Args* ka;
    LAS unsigned char* lds;
    volatile LAS unsigned* MISC;
    gu32* ctl;
    int wave;
    int vcu, G, li;
    unsigned char* ws;
    float* out;
};
__device__ __forceinline__ float wave_sum(float v) {
#pragma unroll
    for (int o = 1; o < 64; o <<= 1) v += __shfl_xor(v, o);
    return v;
}
__device__ __forceinline__ void p0_transpose_item(const float* W, int K, int N, bf16* WT, int k0, int n0, int dst_row0, LAS unsigned char* scr, int lane, int kdst = -1) {
    if (kdst < 0) kdst = k0;
    const int q = lane >> 4, m = lane & 15;
    const GAS f32x4* src = (const GAS f32x4*)(W + (size_t)(k0 + 2 * q) * N + n0) + m;
    f32x4 v[16];
#pragma unroll
    for (int i = 0; i < 16; ++i) v[i] = src[((size_t)(8 * (i >> 1) + (i & 1)) * N) >> 2];
#pragma unroll
    for (int j = 0; j < 8; ++j) {
#pragma unroll
        for (int c = 0; c < 4; ++c) {
            const int n = 4 * m + c, col = (4 * j + q) ^ ((m & 7) << 2);
            *(LAS unsigned*)(scr + n * 128 + col * 4) = pg8::cvt_pk_bf16(v[2 * j][c], v[2 * j + 1][c]);
        }
    }
    LDS_WAIT(); asm volatile("" ::: "memory");
    const int ch = lane & 7;
#pragma unroll
    for (int i = 0; i < 8; ++i) { const int n = 8 * i + (lane >> 3);
        const v4u o = *(const LAS v4u*)(scr + n * 128 + ((ch ^ ((n >> 2) & 7)) << 4));
        *(GAS v4u*)(WT + (size_t)(dst_row0 + n) * K + kdst + 8 * ch) = o; }
    LDS_WAIT(); asm volatile("" ::: "memory");
}
__device__ __forceinline__ void p0_item_load(const float* W, int N, int k0, int n0, int lane, f32x4 (&v)[16]) {
    const int q = lane >> 4, m = lane & 15;
    const GAS f32x4* src = (const GAS f32x4*)(W + (size_t)(k0 + 2 * q) * N + n0) + m;
#pragma unroll
    for (int i = 0; i < 16; ++i) v[i] = src[((size_t)(8 * (i >> 1) + (i & 1)) * N) >> 2];
}
__device__ __forceinline__ void p0_item_store(const f32x4 (&v)[16], int K, bf16* WT, int k0, int dst_row0, LAS unsigned char* scr, int lane) {
    const int q = lane >> 4, m = lane & 15;
#pragma unroll
    for (int j = 0; j < 8; ++j) {
#pragma unroll
        for (int c = 0; c < 4; ++c) {
            const int n = 4 * m + c, col = (4 * j + q) ^ ((m & 7) << 2);
            *(LAS unsigned*)(scr + n * 128 + col * 4) = pg8::cvt_pk_bf16(v[2 * j][c], v[2 * j + 1][c]);
        }
    }
    LDS_WAIT(); asm volatile("" ::: "memory");
    const int ch = lane & 7;
#pragma unroll
    for (int i = 0; i < 8; ++i) { const int n = 8 * i + (lane >> 3);
        const v4u o = *(const LAS v4u*)(scr + n * 128 + ((ch ^ ((n >> 2) & 7)) << 4));
        *(GAS v4u*)(WT + (size_t)(dst_row0 + n) * K + k0 + 8 * ch) = o; }
    LDS_WAIT(); asm volatile("" ::: "memory");
}
__device__ __forceinline__ void p0_item_store_fp8(const f32x4 (&v)[16], int K, unsigned char* WT, int k0, int dst_row0, LAS unsigned char* scr, int lane) {
    const int q = lane >> 4, m = lane & 15;
#pragma unroll
    for (int j = 0; j < 8; ++j) {
#pragma unroll
        for (int c = 0; c < 4; ++c) {
            const int n = 4 * m + c, kb = 8 * j + 2 * q;
            const int p = __builtin_amdgcn_cvt_pk_fp8_f32(v[2 * j][c] * pg8::WSCALE, v[2 * j + 1][c] * pg8::WSCALE, 0, false);
            *(LAS unsigned short*)(scr + n * 64 + ((((kb >> 4) ^ (m & 3)) << 4) | (kb & 15))) = (unsigned short)p;
        }
    }
    LDS_WAIT(); asm volatile("" ::: "memory");
    const int ch = lane & 3;
#pragma unroll
    for (int i = 0; i < 4; ++i) { const int n = 16 * i + (lane >> 2);
        const v4u o = *(const LAS v4u*)(scr + n * 64 + ((ch ^ ((n >> 2) & 3)) << 4));
        *(GAS v4u*)(WT + (size_t)(dst_row0 + n) * K + k0 + 16 * ch) = o; }
    LDS_WAIT(); asm volatile("" ::: "memory");
}
struct MoeItem { const float* W; bf16* WT; int K, N, k0, n0, drow, f8; };
__device__ __forceinline__ MoeItem moe_item(Frame& F, int r) {
    constexpr int I_GU1 = (DM / 64) * (2048 / 64), I_GU = NE * I_GU1, I_D1 = (DFF / 64) * (DM / 64);
    MoeItem it;
    if (r < I_GU) { const int e = r / I_GU1, q = r % I_GU1, nblk = 2048 / 64, kb = q / nblk, nb = q % nblk, n0 = 64 * nb, j = n0 & 1023, up = n0 >> 10;
        it.W = F.ka->in[16] + (size_t)e * DM * 2048; it.WT = (bf16*)(F.ws + WS_WGU + (size_t)e * 2048 * DM); it.K = DM; it.N = 2048; it.k0 = 64 * kb; it.n0 = n0; it.drow = 256 * (j >> 7) + 128 * up + (j & 127); it.f8 = 1; }
    else { r -= I_GU; const int e = r / I_D1, q = r % I_D1, nblk = DM / 64, kb = q / nblk, nb = q % nblk;
        it.W = F.ka->in[17] + (size_t)e * DFF * DM; it.WT = (bf16*)(F.ws + WS_WD + (size_t)e * DM * DFF); it.K = DFF; it.N = DM; it.k0 = 64 * kb; it.n0 = 64 * nb; it.drow = 64 * nb; it.f8 = 1; }
    return it;
}
__device__ __forceinline__ void p0_moe_weights(Frame& F, int gw, int NGW) {
    constexpr int NIT = NE * ((DM / 64) * (2048 / 64) + (DFF / 64) * (DM / 64));
    LAS unsigned char* scr = F.lds + RING_OFF + F.wave * 8192;
    f32x4 va[16], vb[16];
    int r = gw;
    if (r < NIT) { const MoeItem a = moe_item(F, r); p0_item_load(a.W, a.N, a.k0, a.n0, mk_lane(), va); }
    for (; r < NIT; r += 2 * NGW) {
        const MoeItem a = moe_item(F, r);
        const bool hb = r + NGW < NIT; MoeItem b = a;
        if (hb) { b = moe_item(F, r + NGW); p0_item_load(b.W, b.N, b.k0, b.n0, mk_lane(), vb); }
        if (a.f8) p0_item_store_fp8(va, a.K, (unsigned char*)a.WT, a.k0, a.drow, scr, mk_lane()); else p0_item_store(va, a.K, a.WT, a.k0, a.drow, scr, mk_lane());
        if (r + 2 * NGW < NIT) { const MoeItem c = moe_item(F, r + 2 * NGW); p0_item_load(c.W, c.N, c.k0, c.n0, mk_lane(), va); }
        if (hb) { if (b.f8) p0_item_store_fp8(vb, b.K, (unsigned char*)b.WT, b.k0, b.drow, scr, mk_lane()); else p0_item_store(vb, b.K, b.WT, b.k0, b.drow, scr, mk_lane()); }
    }
}
__device__ __forceinline__ void p0_prologue(Frame& F, int which, int gw, int NGW) {
    LAS unsigned char* scr = F.lds + RING_OFF + F.wave * 8192;
    constexpr int I_IN = (DM / 64) * (NIN / 64), I_A = (1024 / 64) * (DM / 64), I_B = (512 / 64) * (DM / 64), I_O = (DM / 64) * (DM / 64);
    constexpr int I_GU1 = (DM / 64) * (2048 / 64), I_GU = NE * I_GU1, I_D1 = (DFF / 64) * (DM / 64), I_D = NE * I_D1;
    constexpr int NITEMS = I_IN + I_A + I_B + I_O + I_GU + I_D;
    bf16* WIN = (bf16*)(F.ws + WS_WIN); bf16* WA = (bf16*)(F.ws + WS_WA); bf16* WB = (bf16*)(F.ws + WS_WB); bf16* WO = (bf16*)(F.ws + WS_WO); bf16* WGU = (bf16*)(F.ws + WS_WGU); bf16* WD = (bf16*)(F.ws + WS_WD);
    for (int it = gw; it < NITEMS; it += NGW) {
        int r = it;
        if (!(which & 1) && r < I_IN + I_A + I_B + I_O) continue;
        if (!(which & 2) && r >= I_IN + I_A + I_B + I_O) break;
        if (r < I_IN) { const int nblk = NIN / 64, kb = r / nblk, nb = r % nblk;
            const int n0 = 64 * nb, r8 = (n0 >= C_GA) ? n0 - C_GA : (n0 >= C_DAV && n0 < C_DLQ) ? 4096 + (n0 - C_DAV) : (n0 >= C_DLV) ? 5120 + (n0 - C_DLV) : -1;
            if (r8 < 0) p0_transpose_item(F.ka->in[2], DM, NIN, WIN, 64 * kb, n0, n0, scr, mk_lane());
            else { f32x4 v[16]; p0_item_load(F.ka->in[2], NIN, 64 * kb, n0, mk_lane(), v); p0_item_store_fp8(v, DM, (unsigned char*)(F.ws + WS_WIN8), 64 * kb, r8, scr, mk_lane()); }
            continue; } r -= I_IN;
        if (r < I_A)  { const int nblk = DM / 64, kb = r / nblk, nb = r % nblk; p0_transpose_item(F.ka->in[10], 1536, DM, WA, 64 * kb, 64 * nb, 64 * nb, scr, mk_lane()); continue; } r -= I_A;
        if (r < I_B)  { const int nblk = DM / 64, kb = r / nblk, nb = r % nblk; p0_transpose_item(F.ka->in[11], 1536, DM, WA, 64 * kb, 64 * nb, 64 * nb, scr, mk_lane(), 1024 + 64 * kb); continue; } r -= I_B;
        if (r < I_O)  { const int nblk = DM / 64, kb = r / nblk, nb = r % nblk; p0_transpose_item(F.ka->in[12], DM, DM, WO, 64 * kb, 64 * nb, 64 * nb, scr, mk_lane()); continue; } r -= I_O;
        if (r < I_GU) { const int e = r / I_GU1, q = r % I_GU1, nblk = 2048 / 64, kb = q / nblk, nb = q % nblk, n0 = 64 * nb, j = n0 & 1023, up = n0 >> 10;
                        p0_transpose_item(F.ka->in[16] + (size_t)e * DM * 2048, DM, 2048, WGU + (size_t)e * 2048 * DM, 64 * kb, n0, 256 * (j >> 7) + 128 * up + (j & 127), scr, mk_lane()); continue; } r -= I_GU;
        { const int e = r / I_D1, q = r % I_D1, nblk = DM / 64, kb = q / nblk, nb = q % nblk;
          p0_transpose_item(F.ka->in[17] + (size_t)e * DFF * DM, DFF, DM, WD + (size_t)e * DM * DFF, 64 * kb, 64 * nb, 64 * nb, scr, mk_lane()); }
    }
    bf16* XN = (bf16*)(F.ws + WS_XN);
    if (which & 4) {
        f32x4 g[8];
#pragma unroll
        for (int j = 0; j < 8; ++j) g[j] = *((const GAS f32x4*)F.ka->in[1] + mk_lane() + 64 * j);
        for (int m = gw; m < M; m += 2 * NGW) {
            const int m2 = (m + NGW < M) ? m + NGW : m;
            const GAS f32x4* xr = (const GAS f32x4*)(F.ka->in[0] + (size_t)m * DM) + mk_lane(); const GAS f32x4* xr2 = (const GAS f32x4*)(F.ka->in[0] + (size_t)m2 * DM) + mk_lane();
            f32x4 v[8], w[8]; float s = 0.f, s2 = 0.f;
#pragma unroll
            for (int j = 0; j < 8; ++j) { v[j] = xr[64 * j]; w[j] = xr2[64 * j]; }
#pragma unroll
            for (int j = 0; j < 8; ++j) { s += (v[j].x * v[j].x + v[j].y * v[j].y) + (v[j].z * v[j].z + v[j].w * v[j].w); s2 += (w[j].x * w[j].x + w[j].y * w[j].y) + (w[j].z * w[j].z + w[j].w * w[j].w); }
            const float rstd = 1.0f / sqrtf(wave_sum(s) * (1.f / DM) + EPS), rstd2 = 1.0f / sqrtf(wave_sum(s2) * (1.f / DM) + EPS);
            GAS unsigned long long* o8 = (GAS unsigned long long*)(XN + (size_t)m * DM) + mk_lane(); GAS unsigned long long* o82 = (GAS unsigned long long*)(XN + (size_t)m2 * DM) + mk_lane();
            GAS unsigned* q8 = (GAS unsigned*)((unsigned char*)(F.ws + WS_XN8) + (size_t)m * DM) + mk_lane(); GAS unsigned* q82 = (GAS unsigned*)((unsigned char*)(F.ws + WS_XN8) + (size_t)m2 * DM) + mk_lane();
#pragma unroll
            for (int j = 0; j < 8; ++j) { const f32x4 t = v[j] * rstd * g[j]; o8[64 * j] = (unsigned long long)pk2(t.x, t.y) | ((unsigned long long)pk2(t.z, t.w) << 32); q8[64 * j] = pg8::pk_fp8x4(t.x * pg8::XSCALE, t.y * pg8::XSCALE, t.z * pg8::XSCALE, t.w * pg8::XSCALE);
                                          const f32x4 t2 = w[j] * rstd2 * g[j]; o82[64 * j] = (unsigned long long)pk2(t2.x, t2.y) | ((unsigned long long)pk2(t2.z, t2.w) << 32); q82[64 * j] = pg8::pk_fp8x4(t2.x * pg8::XSCALE, t2.y * pg8::XSCALE, t2.z * pg8::XSCALE, t2.w * pg8::XSCALE); }
        }
    }
    if ((which & 4) && F.vcu == 0 && (F.wave * 64 + mk_lane()) < 384) { float* GN = (float*)(F.ws + WS_GAIN); const int t = (F.wave * 64 + mk_lane()); GN[t] = (t < 64) ? F.ka->in[3][t] : (t < 128) ? F.ka->in[4][t - 64] : (t < 256) ? F.ka->in[8][t - 128] : F.ka->in[9][t - 256]; }
    if (which & 4) { float* WR = (float*)(F.ws + WS_WR);
      for (int i = (F.vcu * NWAVES * 64) + (F.wave * 64 + mk_lane()); i < DM * 48; i += F.G * NWAVES * 64) { const int k = i / 48, c = i % 48; const float gn = F.ka->in[13][k];
          WR[i] = (c < 32) ? F.ka->in[15][k * 32 + c] * gn : (c < 36) ? F.ka->in[14][k * 4 + (c - 32)] * gn : 0.f; } }
}
__device__ __forceinline__ void p2_attention(Frame& F, int which) {
    const bf16* PROJ = (const bf16*)(F.ws + WS_PROJ);
    bf16* ODA = (bf16*)(F.ws + WS_ODA); bf16* ODL = (bf16*)(F.ws + WS_ODL); float* LSE = (float*)(F.ws + WS_LSE);
    float gq = fabsf(F.ka->in[3][mk_lane()]), gk = fabsf(F.ka->in[4][mk_lane()]);
#pragma unroll
    for (int o = 1; o < 64; o <<= 1) { gq = fmaxf(gq, __shfl_xor(gq, o)); gk = fmaxf(gk, __shfl_xor(gk, o)); }
    const float Bq = 8.0f * gq * gk * 1.02f;
    float g1 = fmaxf(fabsf(F.ka->in[8][mk_lane()]), fabsf(F.ka->in[8][64 + mk_lane()])), g2 = fmaxf(fabsf(F.ka->in[9][mk_lane()]), fabsf(F.ka->in[9][64 + mk_lane()]));
#pragma unroll
    for (int o = 1; o < 64; o <<= 1) { g1 = fmaxf(g1, __shfl_xor(g1, o)); g2 = fmaxf(g2, __shfl_xor(g2, o)); }
    const float Bl = 11.313708f * g1 * g2 * 1.02f;
    volatile LAS int* QW = (volatile LAS int*)(F.MISC + 16);
    for (;;) {
        if ((F.wave * 64 + mk_lane()) == 0) QW[0] = (int)atomicAdd((unsigned*)(F.ctl + CW_QUEUE) + 64 * F.li, 1u);
        __syncthreads();
        const int u = __builtin_amdgcn_readfirstlane(QW[0]);
        if (u >= 1024 + 768) break;
        if (u < 1024) {
            const int h = 7 - (u >> 7), rem = u & 127, b = rem >> 6, mp = (rem >> 5) & 1, qb = 31 - (rem & 31);
            const float slope = exp2f(-(float)(h + 1));
            const float Df = (2.0f * Bq + logf(1.0f / slope) + 30.0f) / slope;
            const int Dk = (Df < 1.0e6f) ? (int)Df + 1 : (1 << 20);
            int t_lo = (256 * qb - Dk) >> 6; if (t_lo < 0) t_lo = 0;
            if (which & 1)
            att::attn_unit<64>(PROJ + pg8::PJ_QA + (size_t)((b * 8 + h) * 2 + mp) * SEQ * 64, PROJ + pg8::PJ_KA + (size_t)((b * 8 + h) * 2 + mp) * SEQ * 64, PROJ + pg8::PJ_VA + (size_t)(b * 8 + h) * SEQ * 128,
                               256 * qb, t_lo, 4 * (qb + 1), 1 << 30, Dk, slope * LOG2E, Bq * LOG2E - 20.0f,
                               ODA + (size_t)mp * M * 1024 + (size_t)b * SEQ * 1024 + h * 128, 1024L, nullptr, 0L, F.lds + RING_OFF, (LAS float*)(F.lds + XCH_OFF), F.wave, (u == MK_DBG_UNIT) ? (unsigned*)(F.ctl + CW_DBG) : nullptr);
        } else {
            const int v = u - 1024, b = v / 384, rem = v % 384, g = rem / 128, rem2 = rem % 128, h = rem2 / 32, j = rem2 % 32;
            const int d = (g == 0) ? 1 : (g == 1) ? 4 : 16, nblk = 32 / d, r = j / nblk, iblk = j % nblk, hh = g * 4 + h;
            const size_t hoff = ((size_t)(b * 12 + hh) * SEQ + (size_t)r * (SEQ / d)) * 128;
            const float slope2 = exp2f(-8.0f * (float)(hh + 1) / 12.0f) * (float)d * LOG2E;
            if (which & 2)
            att::attn_unit<128>(PROJ + pg8::PJ_QL + hoff, PROJ + pg8::PJ_KL + hoff, PROJ + pg8::PJ_VL + hoff, 256 * iblk, (4 * iblk - 2 < 0) ? 0 : 4 * iblk - 2, 4 * iblk + 4, 128, 128, slope2, Bl * LOG2E - 20.0f,
                                ODL + (size_t)g * M * 512 + ((size_t)b * SEQ + r) * 512 + h * 128, 512L * d, LSE + (size_t)g * M * 4 + ((size_t)b * SEQ + r) * 4 + h, 4L * d, F.lds + RING_OFF, (LAS float*)(F.lds + XCH_OFF), F.wave);
        }
        __syncthreads();
    }
}
__device__ __forceinline__ void p3_merge(Frame& F) {
    const int gw = F.vcu * NWAVES + F.wave, NGW = F.G * NWAVES, lane = mk_lane();
    const bf16* ODA = (const bf16*)(F.ws + WS_ODA); const bf16* ODL = (const bf16*)(F.ws + WS_ODL); const float* LSE = (const float*)(F.ws + WS_LSE);
    bf16* OA = (bf16*)(F.ws + WS_OA); bf16* OB = (bf16*)(F.ws + WS_OB);
    const float s0 = wave_sum(F.ka->in[5][lane] * F.ka->in[6][lane]), s1 = wave_sum(F.ka->in[5][64 + lane] * F.ka->in[6][64 + lane]);
    const float lam = expf(s0) - expf(s1) + LAM_INIT;
    float sg[16];
#pragma unroll
    for (int j = 0; j < 16; ++j) sg[j] = F.ka->in[7][(lane & 7) * 16 + j] * (1.0f - LAM_INIT);
    for (int m = gw; m < M; m += NGW) {
        {
            const v4u* p0 = (const v4u*)(ODA + (size_t)m * 1024 + lane * 16); const v4u* p1 = (const v4u*)(ODA + (size_t)M * 1024 + (size_t)m * 1024 + lane * 16);
            float a[16], b[16]; pg8::unpack8(p0[0], *(float(*)[8])&a[0]); pg8::unpack8(p0[1], *(float(*)[8])&a[8]); pg8::unpack8(p1[0], *(float(*)[8])&b[0]); pg8::unpack8(p1[1], *(float(*)[8])&b[8]);
            float ss = 0.f;
#pragma unroll
            for (int j = 0; j < 16; ++j) { a[j] = a[j] - lam * b[j]; ss += a[j] * a[j]; }
            ss += __shfl_xor(ss, 1); ss += __shfl_xor(ss, 2); ss += __shfl_xor(ss, 4);
            const float rstd = 1.0f / sqrtf(ss * (1.f / 128.f) + EPS);
            v4u o0, o1;
            o0.x = pk2(a[0] * rstd * sg[0], a[1] * rstd * sg[1]); o0.y = pk2(a[2] * rstd * sg[2], a[3] * rstd * sg[3]); o0.z = pk2(a[4] * rstd * sg[4], a[5] * rstd * sg[5]); o0.w = pk2(a[6] * rstd * sg[6], a[7] * rstd * sg[7]);
            o1.x = pk2(a[8] * rstd * sg[8], a[9] * rstd * sg[9]); o1.y = pk2(a[10] * rstd * sg[10], a[11] * rstd * sg[11]); o1.z = pk2(a[12] * rstd * sg[12], a[13] * rstd * sg[13]); o1.w = pk2(a[14] * rstd * sg[14], a[15] * rstd * sg[15]);
            v4u* q = (v4u*)(OA + (size_t)m * 1536 + lane * 16); q[0] = o0; q[1] = o1;
        }
        {
            const int h = lane >> 4;
            const float l0 = LSE[(size_t)m * 4 + h], l1 = LSE[(size_t)M * 4 + (size_t)m * 4 + h], l2 = LSE[(size_t)2 * M * 4 + (size_t)m * 4 + h];
            const float mx = fmaxf(l0, fmaxf(l1, l2)); float w0 = exp2f(l0 - mx), w1 = exp2f(l1 - mx), w2 = exp2f(l2 - mx); const float inv = 1.0f / (w0 + w1 + w2); w0 *= inv; w1 *= inv; w2 *= inv;
            float a[8], b[8], c[8];
            pg8::unpack8(*(const v4u*)(ODL + (size_t)m * 512 + lane * 8), a); pg8::unpack8(*(const v4u*)(ODL + (size_t)M * 512 + (size_t)m * 512 + lane * 8), b); pg8::unpack8(*(const v4u*)(ODL + (size_t)2 * M * 512 + (size_t)m * 512 + lane * 8), c);
            v4u o;
            o.x = pk2(w0 * a[0] + w1 * b[0] + w2 * c[0], w0 * a[1] + w1 * b[1] + w2 * c[1]); o.y = pk2(w0 * a[2] + w1 * b[2] + w2 * c[2], w0 * a[3] + w1 * b[3] + w2 * c[3]);
            o.z = pk2(w0 * a[4] + w1 * b[4] + w2 * c[4], w0 * a[5] + w1 * b[5] + w2 * c[5]); o.w = pk2(w0 * a[6] + w1 * b[6] + w2 * c[6], w0 * a[7] + w1 * b[7] + w2 * c[7]);
            *(v4u*)(OA + (size_t)m * 1536 + 1024 + lane * 8) = o;
        }
    }
}
__device__ __forceinline__ f32x4 bf4_to_f32(unsigned long long a) {
    f32x4 r; r.x = __uint_as_float((unsigned)a << 16); r.y = __uint_as_float((unsigned)a & 0xffff0000u); r.z = __uint_as_float((unsigned)(a >> 32) << 16); r.w = __uint_as_float((unsigned)(a >> 32) & 0xffff0000u); return r; }
__device__ __forceinline__ void p7_router(Frame& F) {
    typedef float f32x4v __attribute__((ext_vector_type(4)));
    LAS float* LG = (LAS float*)(F.lds);
    LAS float* SS = (LAS float*)(F.lds + 24576);
    LAS float* RS = (LAS float*)(F.lds + 25088);
    const float* WR = (const float*)(F.ws + WS_WR);
    int* EIDX = (int*)(F.ws + WS_ROUTE); float* EW = (float*)(F.ws + WS_ROUTE + 131072); int* POS = (int*)(F.ws + WS_ROUTE + 262144); int* LIST = (int*)(F.ws + WS_LIST); float* RSL = (float*)(F.ws + WS_RSL);
    unsigned char* XQ = (unsigned char*)(F.ws + WS_XS);
    bf16* XN2 = (bf16*)(F.ws + WS_XN); const bf16* DELTA = (const bf16*)(F.ws + WS_ODA);
    const int lane = mk_lane(), wave = F.wave, rg = wave & 3, kh = wave >> 2, i = lane & 15, kq = lane >> 4;
    for (int it = F.vcu; it < M / 64; it += F.G) {
        const int row0 = 64 * it;
        const size_t eo = (size_t)(row0 + 16 * rg + i) * DM + 1024 * kh + 16 * kq;
        const float* xr = F.ka->in[0] + eo;
        const bf16* dr = DELTA + eo;
        const float* gp = F.ka->in[13] + 1024 * kh + 16 * kq;
        unsigned char* xq = XQ + eo;
        const float* wr = WR + (size_t)(1024 * kh + 16 * kq) * 48 + i;
        f32x4v a0 = {0.f, 0.f, 0.f, 0.f}, a1 = a0, a2 = a0; float ssq = 0.f;
        for (int T = 0; T < 16; ++T) {
            v4u q;
#pragma unroll
            for (int tt = 0; tt < 4; ++tt) {
                const f32x4 xv = *(const f32x4*)(xr + 64 * T + 4 * tt) + bf4_to_f32(*(const unsigned long long*)(dr + 64 * T + 4 * tt));
                const f32x4 gv = *(const f32x4*)(gp + 64 * T + 4 * tt) * pg8::XSCALE;
                ssq += (xv.x * xv.x + xv.y * xv.y) + (xv.z * xv.z + xv.w * xv.w);
                q[tt] = pg8::pk_fp8x4(xv.x * gv.x, xv.y * gv.y, xv.z * gv.z, xv.w * gv.w);
#pragma unroll
                for (int c = 0; c < 4; ++c) { const float* w = wr + (size_t)(64 * T + 4 * tt + c) * 48; const float xa = xv[c];
                    a0 = __builtin_amdgcn_mfma_f32_16x16x4f32(xa, w[0], a0, 0, 0, 0); a1 = __builtin_amdgcn_mfma_f32_16x16x4f32(xa, w[16], a1, 0, 0, 0); a2 = __builtin_amdgcn_mfma_f32_16x16x4f32(xa, w[32], a2, 0, 0, 0); }
            }
            *(v4u*)(xq + 64 * T) = q;
        }
        ssq += __shfl_xor(ssq, 16); ssq += __shfl_xor(ssq, 32);
#pragma unroll
        for (int reg = 0; reg < 4; ++reg) { LAS float* p = LG + (kh * 64 + 16 * rg + 4 * kq + reg) * 48 + i; p[0] = a0[reg]; p[16] = a1[reg]; p[32] = a2[reg]; }
        if (kq == 0) SS[kh * 64 + 16 * rg + i] = ssq;
        __syncthreads();
        if ((F.wave * 64 + mk_lane()) < 64) {
            const int r = (F.wave * 64 + mk_lane()); const float rstd = 1.0f / sqrtf((SS[r] + SS[64 + r]) * (1.f / DM) + EPS);
            const LAS float* l0 = LG + r * 48; const LAS float* l1 = LG + (64 + r) * 48;
            float gl[4];
#pragma unroll
            for (int j = 0; j < 4; ++j) gl[j] = (l0[32 + j] + l1[32 + j]) * rstd;
            int g = 0; float gmax = gl[0];
#pragma unroll
            for (int j = 1; j < 4; ++j) if (gl[j] > gmax) { gmax = gl[j]; g = j; }
            float gs = 0.f;
#pragma unroll
            for (int j = 0; j < 4; ++j) gs += expf(gl[j] - gmax);
            const float gw = 1.0f / gs;
            float t0 = -INFINITY, t1 = -INFINITY; int i0 = 0, i1 = 0;
#pragma unroll
            for (int j = 0; j < 8; ++j) { const float v = (l0[8 * g + j] + l1[8 * g + j]) * rstd;
                if (v > t0) { t1 = t0; i1 = i0; t0 = v; i0 = j; } else if (v > t1) { t1 = v; i1 = j; } }
            const float e1 = expf(t1 - t0), w0 = gw / (1.0f + e1), w1 = gw * e1 / (1.0f + e1);
            const int e0i = 8 * g + i0, e1i = 8 * g + i1, row = row0 + r;
            EIDX[2 * row] = e0i; EIDX[2 * row + 1] = e1i; EW[2 * row] = w0; EW[2 * row + 1] = w1;
            if (!(MK_SPLIT_AT == 7 && F.li == 1)) {
                const int p0 = (int)atomicAdd((unsigned*)(F.ctl + CW_CNT) + e0i, 1u), p1 = (int)atomicAdd((unsigned*)(F.ctl + CW_CNT) + e1i, 1u);
                LIST[(size_t)e0i * M + p0] = row; LIST[(size_t)e1i * M + p1] = row; POS[2 * row] = p0; POS[2 * row + 1] = p1;
                RSL[(size_t)e0i * M + p0] = rstd; RSL[(size_t)e1i * M + p1] = rstd;
            }
        }
        __syncthreads();
        __syncthreads();
    }
}
__device__ __forceinline__ void build_tables(Frame& F, LAS int* PS, LAS int* CN, LAS int* TE) {
    if ((F.wave * 64 + mk_lane()) == 0) {
        int acc = 0, t = 0;
        for (int e = 0; e < NE; ++e) { PS[e] = acc; const int c = (int)__hip_atomic_load(F.ctl + CW_CNT + e, RLX_AGENT); CN[e] = c; const int nt = (c + 255) >> 8; for (int k = 0; k < nt; ++k) TE[t++] = e; acc += nt << 8; }
        PS[NE] = acc; TE[160] = t;
    }
    __syncthreads();
}
__device__ __forceinline__ void p11_combine(Frame& F) {
    const int gw = F.vcu * NWAVES + F.wave, NGW = F.G * NWAVES, lane = mk_lane();
    const float* EW = (const float*)(F.ws + WS_ROUTE + 131072); const int* POS = (const int*)(F.ws + WS_ROUTE + 262144); const int* EIDX = (const int*)(F.ws + WS_ROUTE);
    const LAS int* PS = (const LAS int*)(F.lds + XCH_OFF);
    const unsigned char* Y = (const unsigned char*)(F.ws + WS_Y8); const bf16* DELTA = (const bf16*)(F.ws + WS_ODA);
    typedef float f32x2c __attribute__((ext_vector_type(2)));
    for (int m = gw; m < M; m += NGW) {
        const int s0 = PS[EIDX[2 * m]] + POS[2 * m], s1 = PS[EIDX[2 * m + 1]] + POS[2 * m + 1]; const float w0 = EW[2 * m] * (1.0f / pg8::YSCALE), w1 = EW[2 * m + 1] * (1.0f / pg8::YSCALE);
        GAS f32x4* op = (GAS f32x4*)(F.out + (size_t)m * DM) + lane; const GAS f32x4* xp = (const GAS f32x4*)(F.ka->in[0] + (size_t)m * DM) + lane; const GAS unsigned long long* dp = (const GAS unsigned long long*)(DELTA + (size_t)m * DM) + lane;
        const GAS unsigned* y0 = (const GAS unsigned*)(Y + (size_t)s0 * DM) + lane; const GAS unsigned* y1 = (const GAS unsigned*)(Y + (size_t)s1 * DM) + lane;
#pragma unroll
        for (int j = 0; j < 8; ++j) { f32x4 v = xp[64 * j] + bf4_to_f32(dp[64 * j]); const unsigned a = y0[64 * j], b = y1[64 * j];
            const f32x2c a0 = __builtin_amdgcn_cvt_pk_f32_fp8((int)a, false), a1 = __builtin_amdgcn_cvt_pk_f32_fp8((int)a, true), b0 = __builtin_amdgcn_cvt_pk_f32_fp8((int)b, false), b1 = __builtin_amdgcn_cvt_pk_f32_fp8((int)b, true);
            v.x += w0 * a0.x + w1 * b0.x; v.y += w0 * a0.y + w1 * b0.y; v.z += w0 * a1.x + w1 * b1.x; v.w += w0 * a1.y + w1 * b1.y;
            op[64 * j] = v; }
    }
}

__global__ void __launch_bounds__(NWAVES * 64, 2) mk_fwd(Args args) {
    extern __shared__ __attribute__((aligned(16))) unsigned char lds[];
    Frame F;
    F.lds = (LAS unsigned char*)lds;
    F.MISC = (volatile LAS unsigned*)(F.lds + MISC_OFF);
    F.wave = __builtin_amdgcn_readfirstlane((int)threadIdx.x >> 6);
    F.G = gridDim.x; { const int bx = blockIdx.x; F.vcu = (F.G % 8 == 0) ? (bx % 8) * (F.G / 8) + bx / 8 : bx; }
    F.ws = args.ws; F.ctl = (gu32*)(args.ws + WS_CTL); F.out = args.out; F.li = args.li;
    F.ka = &args;
    for (int u = (F.wave * 64 + mk_lane()); u < (LDS_BYTES - LDSCTL_OFF) / 4; u += NWAVES * 64) ((LAS unsigned*)(F.lds + LDSCTL_OFF))[u] = 0u;
    __syncthreads();
    XcdBarrier bar; bar.bar = (unsigned*)(F.ctl + CW_BAR) + args.li * XCD_BAR_WORDS; bar.x = 0; bar.st = nullptr; bar.w0 = 0;
    if (MK_N_LAUNCHES == 1) bar = xcd_barrier_post((unsigned*)(F.ctl + CW_BAR) + args.li * XCD_BAR_WORDS, F.MISC + 8, F.wave == 0 ? 1u : 0u);
    const int lo = args.ph_lo, hi = args.ph_hi;
#define IN(k) (lo <= (k) && (k) < hi)
#define SEAM(k) do { if (IN(k) && IN((k) + 1)) xcd_barrier(bar); } while (0)
    bf16* XN = (bf16*)(F.ws + WS_XN); bf16* PROJ = (bf16*)(F.ws + WS_PROJ); bf16* MIX = (bf16*)(F.ws + WS_MIX);

    const bool conv_wg = (F.G == 256) && (((int)blockIdx.x >> 3) & 3) == 3; const int conv_idx = ((int)blockIdx.x & 7) * 8 + ((int)blockIdx.x >> 5);
    if (IN(0)) { p0_prologue(F, ((args.li == 1) ? args.sub : 7) & ((F.G == 256) ? 5 : 7), F.vcu * NWAVES + F.wave, F.G * NWAVES); } SEAM(0);
    if (IN(1)) {
        if (conv_wg && !(MK_SPLIT_AT == 1 && args.li == 1)) { p0_moe_weights(F, conv_idx * NWAVES + F.wave, 64 * NWAVES); __syncthreads(); }
        pg8::EpiProj E{PROJ, (const float*)(F.ws + WS_GAIN), (LAS float*)(F.lds + XCH_OFF), 0.125f * LOG2E, 0.08838834764831845f * LOG2E, EPS};
        if (F.G == 256) {
            { pg8::Gemm g{XN, (const bf16*)(F.ws + WS_WIN), M, C_GA, DM, 0};
              pg8::TicketOrder S{(unsigned*)(F.ctl + CW_TQ) + 64 * ((int)blockIdx.x & 7) + 1024 * F.li, (int)blockIdx.x & 7, 8 * 20, (volatile LAS int*)(F.MISC + 20), F.wave, 1};
              pg8::gemm_phase<pg8::EpiProj, pg8::TicketOrder, true, true>(F.wave, F.lds + RING_OFF, g, S, E); }
            { pg8::Gemm g{(const bf16*)(F.ws + WS_XN8), (const bf16*)(F.ws + WS_WIN8), M, 6656, DM / 2, 0};
              pg8::TicketOrder S{(unsigned*)(F.ctl + CW_TQ) + 512 + 64 * ((int)blockIdx.x & 7) + 1024 * F.li, (int)blockIdx.x & 7, 8 * 26, (volatile LAS int*)(F.MISC + 22), F.wave, 0};
              pg8::EpiGateSig EG{(unsigned char*)(PROJ + pg8::PJ_G), 1.0f / (pg8::XSCALE * pg8::WSCALE), PROJ};
              pg8::gemm_phase<pg8::EpiGateSig, pg8::TicketOrder, true, true, false, true>(F.wave, F.lds + RING_OFF, g, S, EG); }
        } else {
            pg8::Gemm g{XN, (const bf16*)(F.ws + WS_WIN), M, C_GA, DM, 0}; pg8::SkipOrder S0; S0.base.init(M, 20 * 256, F.G, (int)blockIdx.x); pg8::gemm_phase<pg8::EpiProj, pg8::SkipOrder, true, true>(F.wave, F.lds + RING_OFF, g, S0, E);
            pg8::Gemm g2{(const bf16*)(F.ws + WS_XN8), (const bf16*)(F.ws + WS_WIN8), M, 6656, DM / 2, 0}; pg8::StaticOrder S1; S1.init(M, 6656, F.G, (int)blockIdx.x);
            pg8::EpiGateSig EG{(unsigned char*)(PROJ + pg8::PJ_G), 1.0f / (pg8::XSCALE * pg8::WSCALE), PROJ}; pg8::gemm_phase<pg8::EpiGateSig, pg8::StaticOrder, true, true, false, true>(F.wave, F.lds + RING_OFF, g2, S1, EG);
        }
    } SEAM(1);
    if (IN(2)) { p2_attention(F, (args.li == 1 && lo == 2) ? args.sub : 3); } SEAM(2);
    if (IN(3)) { p3_merge(F); } SEAM(3);
    if (IN(4)) {
        pg8::Gemm g{(const bf16*)(F.ws + WS_OA), (const bf16*)(F.ws + WS_WA), M, DM, 1536, 0}; pg8::MixOrder S; S.base.init(M, DM, F.G, (int)blockIdx.x);
        pg8::EpiMix E{MIX, DM, (const unsigned char*)(PROJ + pg8::PJ_G)};
        pg8::gemm_phase<pg8::EpiMix, pg8::MixOrder, true, true>(F.wave, F.lds + RING_OFF, g, S, E);
    }
    if (IN(4) && IN(6)) xcd_barrier(bar);
    if (IN(6)) {
        pg8::Gemm g{MIX, (const bf16*)(F.ws + WS_WO), M, DM, DM, 0}; pg8::StaticOrder S; S.init(M, DM, F.G, (int)blockIdx.x);
        pg8::EpiPlain E{(bf16*)(F.ws + WS_ODA), DM, 1.0f};
        pg8::gemm_phase<pg8::EpiPlain, pg8::StaticOrder, true, true>(F.wave, F.lds + RING_OFF, g, S, E);
    } SEAM(6);
    if (IN(7)) { p7_router(F); }
    if (IN(7) && (IN(8) || IN(9))) xcd_barrier(bar);
    LAS int* TE = (LAS int*)(F.lds + TILE_E_OFF); LAS int* PS = (LAS int*)(F.lds + XCH_OFF); LAS int* CN = (LAS int*)(F.lds + XCH_OFF + 256);
    if (hi > 8 && lo <= 11) build_tables(F, PS, CN, TE);
    if (IN(9)) {
        pg8::Gemm g{(const bf16*)(F.ws + WS_XS), (const bf16*)(F.ws + WS_WGU), M, 2048, DM / 2, (size_t)2048 * DM};
        pg8::GroupOrder S{TE[160], F.G, (int)blockIdx.x, TE, PS, CN, (const int*)(F.ws + WS_LIST), M};
        pg8::EpiSwiglu E{(unsigned char*)(F.ws + WS_HB), DFF, 1.0f / (pg8::XSCALE * pg8::WSCALE), (const float*)(F.ws + WS_RSL), PS, M};
        pg8::gemm_phase<pg8::EpiSwiglu, pg8::GroupOrder, true, true, true, true>(F.wave, F.lds + RING_OFF, g, S, E);
    } SEAM(9);
    if (IN(10)) {
        pg8::Gemm g{(const bf16*)(F.ws + WS_HB), (const bf16*)(F.ws + WS_WD), XS_ROWS, DM, DFF / 2, (size_t)DM * DFF};
        pg8::GroupOrder S{TE[160], F.G, (int)blockIdx.x, TE, PS, CN, (const int*)(F.ws + WS_LIST), M};
        pg8::EpiFp8 E{(unsigned char*)(F.ws + WS_Y8), DM, pg8::YSCALE / (pg8::HSCALE * pg8::WSCALE)};
        pg8::gemm_phase<pg8::EpiFp8, pg8::GroupOrder, true, true, false, true>(F.wave, F.lds + RING_OFF, g, S, E);
    } SEAM(10);
    if (IN(11)) { p11_combine(F); }
#undef IN
#undef SEAM
}

extern "C" void kernel_launch(void* const* d_in, const int* in_sizes, int n_in, void* d_out, int out_size, void* d_ws, size_t ws_size, hipStream_t stream) {
    static int grid = 0;
    if (grid == 0) {
        if (n_in != 18 || out_size != M * DM || ws_size < WS_END) { fprintf(stderr, "kernel_launch: unexpected problem shape or workspace (%d inputs, out %d, ws %zu < %zu)\n", n_in, out_size, ws_size, (size_t)WS_END); grid = -1; return; }
        int dev = 0, cus = 0, per_cu = 0;
        if (hipGetDevice(&dev) != hipSuccess || hipDeviceGetAttribute(&cus, hipDeviceAttributeMultiprocessorCount, dev) != hipSuccess) { grid = -1; return; }
        if (hipFuncSetAttribute((const void*)mk_fwd, hipFuncAttributeMaxDynamicSharedMemorySize, LDS_BYTES) != hipSuccess) { fprintf(stderr, "kernel_launch: hipFuncSetAttribute failed\n"); grid = -1; return; }
        if (hipOccupancyMaxActiveBlocksPerMultiprocessor(&per_cu, (const void*)mk_fwd, NWAVES * 64, LDS_BYTES) != hipSuccess || per_cu < 1) { fprintf(stderr, "kernel_launch: occupancy query says %d blocks per CU\n", per_cu); (void)hipGetLastError(); grid = -1; return; }
        grid = cus;
        if (grid != 256) fprintf(stderr, "kernel_launch: %d CUs (tuned for 256)\n", grid);
    }
    if (grid < 0) return;
    (void)hipMemsetAsync((char*)d_ws + WS_CTL, 0, CTL_ZERO_BYTES, stream);
    Args a{};
    for (int i = 0; i < 18; ++i) a.in[i] = (const float*)d_in[i];
    a.out = (float*)d_out; a.ws = (unsigned char*)d_ws;
    if (MK_N_LAUNCHES == 1) {
        if (MK_SPLIT_AT >= 0) {
            a.ph_lo = 0; a.ph_hi = MK_SPLIT_AT + 1 + (MK_SPLIT_AT == 4 ? 1 : 0); a.li = 0; a.sub = 3;
            hipLaunchKernelGGL(mk_fwd, dim3(grid), dim3(NWAVES * 64), LDS_BYTES, stream, a);
            a.ph_lo = MK_SPLIT_AT; a.ph_hi = N_PHASES; a.li = 1; a.sub = MK_REPEAT_SUB;
            hipLaunchKernelGGL(mk_fwd, dim3(grid), dim3(NWAVES * 64), LDS_BYTES, stream, a);
            return;
        }
        a.ph_lo = 0; a.ph_hi = N_PHASES; a.li = 0; a.sub = 3;
        hipLaunchKernelGGL(mk_fwd, dim3(grid), dim3(NWAVES * 64), LDS_BYTES, stream, a);
    } else {
        for (int p = 0; p < N_PHASES; ++p) {
            if (p == 5) continue;
            a.ph_lo = p; a.ph_hi = (p == 4) ? 6 : p + 1; a.li = 0; a.sub = 3;
            hipLaunchKernelGGL(mk_fwd, dim3(grid), dim3(NWAVES * 64), LDS_BYTES, stream, a);
        }
    }
}
```

```cpp
#include <hip/hip_runtime.h>
#include <cstdio>
#include <cstdint>
#ifndef MK_EPI2
#define MK_EPI2 0
#endif
#ifndef MK_DBG
#define MK_DBG 0
#endif
#ifndef MK_DBG_GEMM
#define MK_DBG_GEMM 0
#endif
__device__ __forceinline__ int mk_lane() { int l; asm volatile("v_mbcnt_lo_u32_b32 %0, -1, 0\n\tv_mbcnt_hi_u32_b32 %0, -1, %0" : "=v"(l)); return l; }
namespace pg8 {
#define PG8_LAS __attribute__((address_space(3)))
typedef unsigned short bf16_t;
typedef short bf16x8 __attribute__((ext_vector_type(8)));
typedef float f32x4 __attribute__((ext_vector_type(4)));
typedef unsigned u32x4 __attribute__((ext_vector_type(4)));
typedef int i32x8 __attribute__((ext_vector_type(8)));
constexpr int BM = 256, BK = 64, HALF = 128, HTB = HALF * BK * 2  , STAGE_BYTES = 8 * HTB, NXCD = 8, WGM = 8;

__host__ __device__ __forceinline__ int lds_byte(int r, int c) { const int st = (r >> 4) * 2 + (c >> 5), rr = r & 15, cc = c & 31, ob = rr * 64 + cc * 2; return st * 1024 + (ob ^ (((ob >> 9) & 1) << 5)); }
__host__ __device__ __forceinline__ void stage_rc(int b, int& R, int& C) { const int st = b / 1024, sb = b % 1024, swz = sb ^ (((sb >> 9) & 1) << 5); R = (st >> 1) * 16 + swz / 64; C = (st & 1) * 32 + (swz % 64) / 2; }
__host__ __device__ __forceinline__ int perm32(int rho) { const int n = rho >> 4, i = rho & 15; return 8 * (i >> 2) + 4 * n + (i & 3); }

struct Unit { int pm, pn, e, nt, kofs, keep; };
struct Gemm { const bf16_t* A; const bf16_t* Bt; int M, N, K; size_t estride; };

struct StaticOrder {
    int nM, nN, nwg, G, c;
    __host__ __device__ void init(int M, int N, int G_, int c_) { nM = M / BM; nN = N / BM; nwg = nM * nN; G = G_; c = c_; }
    __host__ __device__ bool next(int i, Unit& u) const {
        const long L = (long)i * G + c; if (L >= nwg) return false;
        int wgid = (int)L; { const int q = nwg / NXCD, r = nwg % NXCD, xcd = wgid % NXCD, off = wgid / NXCD; wgid = (xcd < r ? xcd * (q + 1) : r * (q + 1) + (xcd - r) * q) + off; }
        const int nig = WGM * nN, gid = wgid / nig, fm = gid * WGM, gsz = (nM - fm) < WGM ? (nM - fm) : WGM;
        u.pm = fm + ((wgid % nig) % gsz); u.pn = (wgid % nig) / gsz; u.e = 0; u.nt = 0; u.kofs = 0; u.keep = 0; return true;
    }
    __device__ __forceinline__ int arow(const Unit&, int R) const { return R; }
    __device__ __forceinline__ void a_ready(const Unit&) const {}
    __device__ __forceinline__ void done(const Unit&) const {}
};

typedef float f32x2_c __attribute__((ext_vector_type(2))); typedef __bf16 bf16x2_c __attribute__((ext_vector_type(2)));
__device__ __forceinline__ unsigned cvt_pk_bf16(float lo, float hi) { f32x2_c v = {lo, hi}; bf16x2_c b = __builtin_convertvector(v, bf16x2_c); return __builtin_bit_cast(unsigned, b); }
__device__ __forceinline__ float bf2f(unsigned short b) { return __uint_as_float((unsigned)b << 16); }
__device__ __forceinline__ void unpack8(const u32x4 w, float (&f)[8]) {
    f[0] = __uint_as_float(w.x << 16); f[1] = __uint_as_float(w.x & 0xffff0000u); f[2] = __uint_as_float(w.y << 16); f[3] = __uint_as_float(w.y & 0xffff0000u);
    f[4] = __uint_as_float(w.z << 16); f[5] = __uint_as_float(w.z & 0xffff0000u); f[6] = __uint_as_float(w.w << 16); f[7] = __uint_as_float(w.w & 0xffff0000u);
}
__device__ __forceinline__ u32x4 pack8(const f32x4 v0, const f32x4 v1) { u32x4 w; w.x = cvt_pk_bf16(v0[0], v0[1]); w.y = cvt_pk_bf16(v0[2], v0[3]); w.z = cvt_pk_bf16(v1[0], v1[1]); w.w = cvt_pk_bf16(v1[2], v1[3]); return w; }

constexpr size_t PJ_QA = 0, PJ_KA = (size_t)16384 * 1024, PJ_VA = (size_t)16384 * 2048, PJ_QL = (size_t)16384 * 3072, PJ_KL = (size_t)16384 * 4608, PJ_VL = (size_t)16384 * 6144, PJ_G = (size_t)16384 * 7680;
struct EpiProj {
    static constexpr bool PERM = true, AFTER_DRAIN = false, IDEM = true; static constexpr int MIDT = 0;
    bf16_t* O;
    const float* gains;
    PG8_LAS float* xch;
    float c2_da, c2_dl, eps;
    __device__ __forceinline__ void operator()(const f32x4 (&acc)[2][2][4][2], const Unit& u, int wr, int wc, int fr, int fq) const {
        constexpr int S = 8192;
        const int pn = u.pn;
        const int kind = (pn < 8) ? 1 : (pn < 12) ? 0 : (pn < 24) ? 2 : (pn < 30) ? 0 : 3;
        const int rowl0 = wr * 64 + fr;
        const int b = u.pm >> 5, t0 = (u.pm & 31) * BM + rowl0;
        size_t hb0; int hstep, pitch, dil = 1;
        if (pn < 8) {
            const int pq = pn & 3; pitch = 64; hstep = 2 * S * 64;
            hb0 = (pn < 4 ? PJ_QA : PJ_KA) + ((size_t)((b * 8 + 2 * pq) * 2 + (wc >> 1)) * S) * 64 + (wc & 1) * 32 + 8 * fq;
        } else if (pn < 12) {
            const int pq = pn - 8; pitch = 128; hstep = S * 128;
            hb0 = PJ_VA + ((size_t)(b * 8 + 2 * pq) * S) * 128 + wc * 32 + 8 * fq;
        } else if (pn < 30) {
            const int sec = (pn - 12) / 6, pq = (pn - 12) % 6; pitch = 128; hstep = S * 128; dil = (pq < 2) ? 1 : (pq < 4) ? 4 : 16;
            hb0 = (sec == 0 ? PJ_QL : sec == 1 ? PJ_KL : PJ_VL) + ((size_t)(b * 12 + 2 * pq) * S) * 128 + wc * 32 + 8 * fq;
        } else {
            pitch = 4096; hstep = HALF;
            hb0 = PJ_G + ((size_t)b * S) * 4096 + (pn - 30) * BM + wc * 32 + 8 * fq;
        }
        bf16_t* const hb = O + hb0;
        const int lsh = (dil == 1) ? 0 : (dil == 4) ? 2 : 4;
        if (kind == 1 || kind == 2) {
#pragma unroll
            for (int ai = 0; ai < 2; ++ai)
#pragma unroll
                for (int m = 0; m < 4; ++m)
#pragma unroll
                    for (int bj = 0; bj < 2; ++bj) {
                        const f32x4 a = acc[ai][bj][m][0], bq = acc[ai][bj][m][1];
                        float s = (a[0] * a[0] + a[1] * a[1]) + (a[2] * a[2] + a[3] * a[3]) + (bq[0] * bq[0] + bq[1] * bq[1]) + (bq[2] * bq[2] + bq[3] * bq[3]);
                        s += __shfl_xor(s, 16); s += __shfl_xor(s, 32);
                        if (fq == 0) xch[(ai * HALF + rowl0 + m * 16) * 8 + bj * 4 + wc] = s;
                    }
            asm volatile("s_waitcnt lgkmcnt(0)" ::: "memory"); __builtin_amdgcn_s_barrier(); asm volatile("" ::: "memory");
            const bool isq = (pn < 4) || (pn >= 12 && pn < 18);
            const int goff = (kind == 1) ? ((isq ? 0 : 64) + (wc & 1) * 32 + 8 * fq) : ((isq ? 128 : 256) + wc * 32 + 8 * fq);
            const float* gp = gains + goff;
            const f32x4 g0 = *(const f32x4*)gp, g1 = *(const f32x4*)(gp + 4);
            const float sc = isq ? (kind == 1 ? c2_da : c2_dl) : 1.0f;
            const float inv = (kind == 1) ? (1.0f / 64.0f) : (1.0f / 128.0f);
#pragma unroll
            for (int ai = 0; ai < 2; ++ai)
#pragma unroll
                for (int m = 0; m < 4; ++m) {
                    const PG8_LAS f32x4* xr = (const PG8_LAS f32x4*)(xch + (ai * HALF + rowl0 + m * 16) * 8);
                    const int t = t0 + ai * HALF + m * 16; const size_t ro = (size_t)(((t & (dil - 1)) * (S >> lsh)) + (t >> lsh)) * pitch;
#pragma unroll
                    for (int bj = 0; bj < 2; ++bj) {
                        const f32x4 tt = xr[bj];
                        const float tot = (kind == 1) ? ((wc < 2) ? (tt[0] + tt[1]) : (tt[2] + tt[3])) : ((tt[0] + tt[1]) + (tt[2] + tt[3]));
                        const float rs = __builtin_amdgcn_rsqf(tot * inv + eps) * sc;
                        const f32x4 v0 = acc[ai][bj][m][0] * rs * g0, v1 = acc[ai][bj][m][1] * rs * g1;
                        *(u32x4*)(hb + ro + (size_t)bj * hstep) = pack8(v0, v1);
                    }
                }
        } else {
#pragma unroll
            for (int ai = 0; ai < 2; ++ai)
#pragma unroll
                for (int m = 0; m < 4; ++m) {
                    const int t = t0 + ai * HALF + m * 16; const size_t ro = (size_t)(((t & (dil - 1)) * (S >> lsh)) + (t >> lsh)) * pitch;
#pragma unroll
                    for (int bj = 0; bj < 2; ++bj) {
                        f32x4 v0 = acc[ai][bj][m][0], v1 = acc[ai][bj][m][1];
                        if (kind == 3) {
#pragma unroll
                            for (int j = 0; j < 4; ++j) { v0[j] = __builtin_amdgcn_rcpf(1.0f + __builtin_amdgcn_exp2f(-1.4426950408889634f * v0[j])); v1[j] = __builtin_amdgcn_rcpf(1.0f + __builtin_amdgcn_exp2f(-1.4426950408889634f * v1[j])); }
                        }
                        *(u32x4*)(hb + ro + (size_t)bj * hstep) = pack8(v0, v1);
                    }
                }
        }
    }
};

struct EpiGateSig {
    static constexpr bool PERM = true, AFTER_DRAIN = false, IDEM = true; static constexpr int MIDT = 0;
    unsigned char* G; float ascale; bf16_t* O;
    __device__ __forceinline__ void operator()(const f32x4 (&acc)[2][2][4][2], const Unit& u, int wr, int wc, int fr, int fq) const {
        constexpr int S = 8192;
        const bool gate = u.pn < 16;
        const int pv = u.pn - 16, b = u.pm >> 5, t0 = (u.pm & 31) * BM + wr * 64 + fr;
        const bool da = pv < 4; const int pq = da ? pv : pv - 4, dil = (gate || da || pq < 2) ? 1 : (pq < 4) ? 4 : 16, lsh = (dil == 1) ? 0 : (dil == 4) ? 2 : 4;
        const size_t ubase = gate ? (size_t)(u.pm * BM) * 4096 + 2 * ((u.pn & 7) * BM) + ((u.pn >> 3) << 3) : 2 * (da ? PJ_VA + ((size_t)(b * 8 + 2 * pq) * S) * 128 : PJ_VL + ((size_t)(b * 12 + 2 * pq) * S) * 128);
        unsigned char* const base = (gate ? G : (unsigned char*)O) + ubase + (gate ? (unsigned)(wr * 64 + fr) * 4096u : 0u) + 2 * (wc * 32 + 8 * fq);
        const unsigned pitch = gate ? 4096u : 256u, bjs = gate ? (unsigned)(2 * HALF) : (unsigned)(S * 256);
        const float ns = gate ? -1.4426950408889634f * ascale : ascale;
        typedef unsigned u32x2 __attribute__((ext_vector_type(2)));
#pragma unroll
        for (int ai = 0; ai < 2; ++ai)
#pragma unroll
            for (int m = 0; m < 4; ++m) {
                const int t = gate ? ai * HALF + m * 16 : t0 + ai * HALF + m * 16; const unsigned ro = (unsigned)(((t & (dil - 1)) * (S >> lsh)) + (t >> lsh)) * pitch;
#pragma unroll
                for (int bj = 0; bj < 2; ++bj) {
                    f32x4 v0 = acc[ai][bj][m][0] * ns, v1 = acc[ai][bj][m][1] * ns;
                    if (gate) {
#pragma unroll
                        for (int j = 0; j < 4; ++j) { v0[j] = fmaxf(255.0f * __builtin_amdgcn_rcpf(1.0f + __builtin_amdgcn_exp2f(v0[j])), 1.0f); v1[j] = fmaxf(255.0f * __builtin_amdgcn_rcpf(1.0f + __builtin_amdgcn_exp2f(v1[j])), 1.0f); }
                        unsigned lo = 0, hi = 0;
                        lo = __builtin_amdgcn_cvt_pk_u8_f32(v0[0], 0, lo); lo = __builtin_amdgcn_cvt_pk_u8_f32(v0[1], 1, lo); lo = __builtin_amdgcn_cvt_pk_u8_f32(v0[2], 2, lo); lo = __builtin_amdgcn_cvt_pk_u8_f32(v0[3], 3, lo);
                        hi = __builtin_amdgcn_cvt_pk_u8_f32(v1[0], 0, hi); hi = __builtin_amdgcn_cvt_pk_u8_f32(v1[1], 1, hi); hi = __builtin_amdgcn_cvt_pk_u8_f32(v1[2], 2, hi); hi = __builtin_amdgcn_cvt_pk_u8_f32(v1[3], 3, hi);
                        *(u32x2*)(base + ro + bj * bjs) = (u32x2){lo, hi};
                    } else *(u32x4*)(base + ro + bj * bjs) = pack8(v0, v1);
                }
            }
    }
};

struct EpiMix {
    static constexpr bool PERM = true, AFTER_DRAIN = false, IDEM = false; static constexpr int MIDT = 0;
    bf16_t* MIX; int ldm; const unsigned char* G;
    __device__ __forceinline__ void operator()(f32x4 (&acc)[2][2][4][2], const Unit& u, int wr, int wc, int fr, int fq) const {
        const int row0 = u.pm * BM + wr * 64 + fr, col0 = u.pn * BM + wc * 32 + 8 * fq;
        const unsigned char* const gp = G + (size_t)row0 * 4096 + 2 * col0;
#define PG8_UB(w, k) ((float)(((w) >> (8 * (k))) & 0xffu))
        if (!u.keep) {
#pragma unroll
            for (int ai = 0; ai < 2; ++ai)
#pragma unroll
                for (int m = 0; m < 4; ++m) {
#pragma unroll
                    for (int bj = 0; bj < 2; ++bj) {
                        const u32x4 g = *(const u32x4*)(gp + (size_t)(ai * HALF + m * 16) * 4096 + 2 * bj * HALF);
#pragma unroll
                        for (int j = 0; j < 4; ++j) { acc[ai][bj][m][0][j] *= PG8_UB(g.x, j) * __builtin_amdgcn_rcpf(PG8_UB(g.z, j)); acc[ai][bj][m][1][j] *= PG8_UB(g.y, j) * __builtin_amdgcn_rcpf(PG8_UB(g.w, j)); }
                    }
                    if (m & 1) asm volatile("" ::: "memory");
                }
        } else {
#pragma unroll
            for (int ai = 0; ai < 2; ++ai)
#pragma unroll
                for (int m = 0; m < 4; ++m) {
                    const size_t r = (size_t)(row0 + ai * HALF + m * 16);
#pragma unroll
                    for (int bj = 0; bj < 2; ++bj) {
                        typedef unsigned u32x2 __attribute__((ext_vector_type(2)));
                        const u32x2 g = *(const u32x2*)(gp + (size_t)(ai * HALF + m * 16) * 4096 + 2 * bj * HALF + 8);
                        f32x4 v0 = acc[ai][bj][m][0], v1 = acc[ai][bj][m][1];
#pragma unroll
                        for (int j = 0; j < 4; ++j) { v0[j] *= PG8_UB(g.x, j) * (1.0f / 255.0f); v1[j] *= PG8_UB(g.y, j) * (1.0f / 255.0f); }
                        *(u32x4*)(MIX + r * ldm + col0 + bj * HALF) = pack8(v0, v1);
                    }
                }
        }
#undef PG8_UB
    }
};
struct MixOrder {
    StaticOrder base;
    __device__ __forceinline__ bool next(int i, Unit& u) const { if (!base.next(i >> 1, u)) return false; const int part = i & 1; u.nt = part ? 8 : 16; u.kofs = part ? 2048 : 0; u.keep = part; return true; }
    __device__ __forceinline__ int arow(const Unit&, int R) const { return R; }
    __device__ __forceinline__ void a_ready(const Unit&) const {}
    __device__ __forceinline__ void done(const Unit&) const {}
};

struct EpiRes {
    static constexpr bool PERM = false, AFTER_DRAIN = false, IDEM = true; static constexpr int MIDT = 0;
    const float* X; float* Out; int ldc;
    __device__ __forceinline__ void operator()(const f32x4 (&acc)[2][2][4][2], const Unit& u, int wr, int wc, int fr, int fq) const {
        const int row0 = u.pm * BM + wr * 64 + fr, col0 = u.pn * BM + wc * 32 + 4 * fq;
#pragma unroll
        for (int ai = 0; ai < 2; ++ai)
#pragma unroll
            for (int m = 0; m < 4; ++m) {
                const size_t off = (size_t)(row0 + ai * HALF + m * 16) * ldc + col0;
#pragma unroll
                for (int bj = 0; bj < 2; ++bj)
#pragma unroll
                    for (int n = 0; n < 2; ++n) { const f32x4 xv = *(const f32x4*)(X + off + bj * HALF + n * 16); *(f32x4*)(Out + off + bj * HALF + n * 16) = xv + acc[ai][bj][m][n]; }
            }
    }
};

constexpr float HSCALE = 4.0f, WSCALE = 64.0f, XSCALE = 8.0f;
__device__ __forceinline__ unsigned pk_fp8x4(float a, float b, float c, float d) {
    a = fminf(fmaxf(a, -448.f), 448.f); b = fminf(fmaxf(b, -448.f), 448.f); c = fminf(fmaxf(c, -448.f), 448.f); d = fminf(fmaxf(d, -448.f), 448.f);
    int p = __builtin_amdgcn_cvt_pk_fp8_f32(a, b, 0, false); p = __builtin_amdgcn_cvt_pk_fp8_f32(c, d, p, true); return (unsigned)p; }
__device__ __forceinline__ unsigned pk_fp8x4_nc(float a, float b, float c, float d) { int p = __builtin_amdgcn_cvt_pk_fp8_f32(a, b, 0, false); p = __builtin_amdgcn_cvt_pk_fp8_f32(c, d, p, true); return (unsigned)p; }
struct EpiSwiglu {
    static constexpr bool PERM = true, AFTER_DRAIN = false, IDEM = true; static constexpr int MIDT = 0;
    unsigned char* H; int ldh; float ascale;
    const float* rsl; const PG8_LAS int* ps; int lcap;
    __device__ __forceinline__ void operator()(const f32x4 (&acc)[2][2][4][2], const Unit& u, int wr, int wc, int fr, int fq) const {
        const int row0 = u.pm * BM + wr * 64 + fr, col0 = u.pn * HALF + wc * 32 + 8 * fq;
        const float* rb = rsl + (size_t)u.e * lcap + (row0 - ps[u.e]);
#pragma unroll
        for (int ai = 0; ai < 2; ++ai)
#pragma unroll
            for (int m = 0; m < 4; ++m) {
                float v[8]; const float rs = rb[ai * HALF + m * 16] * ascale;
#pragma unroll
                for (int n = 0; n < 2; ++n)
#pragma unroll
                    for (int j = 0; j < 4; ++j) { const float gt = acc[ai][0][m][n][j] * rs, up = acc[ai][1][m][n][j] * rs; v[4 * n + j] = gt * __builtin_amdgcn_rcpf(1.0f + __builtin_amdgcn_exp2f(-1.4426950408889634f * gt)) * up * HSCALE; }
                typedef unsigned u32x2 __attribute__((ext_vector_type(2)));
                *(u32x2*)(H + (size_t)(row0 + ai * HALF + m * 16) * ldh + col0) = (u32x2){pk_fp8x4_nc(v[0], v[1], v[2], v[3]), pk_fp8x4_nc(v[4], v[5], v[6], v[7])};
            }
    }
};

constexpr float YSCALE = 16.0f;
struct EpiFp8 {
    static constexpr bool PERM = true, AFTER_DRAIN = false, IDEM = true; static constexpr int MIDT = 0;
    unsigned char* O; int ldc; float scale;
    __device__ __forceinline__ void operator()(const f32x4 (&acc)[2][2][4][2], const Unit& u, int wr, int wc, int fr, int fq) const {
        const int row0 = u.pm * BM + wr * 64 + fr, col0 = u.pn * BM + wc * 32 + 8 * fq;
        typedef unsigned u32x2 __attribute__((ext_vector_type(2)));
#pragma unroll
        for (int ai = 0; ai < 2; ++ai)
#pragma unroll
            for (int m = 0; m < 4; ++m)
#pragma unroll
                for (int bj = 0; bj < 2; ++bj) { const f32x4 a = acc[ai][bj][m][0] * scale, b = acc[ai][bj][m][1] * scale;
                    *(u32x2*)(O + (size_t)(row0 + ai * HALF + m * 16) * ldc + col0 + bj * HALF) = (u32x2){pk_fp8x4_nc(a[0], a[1], a[2], a[3]), pk_fp8x4_nc(b[0], b[1], b[2], b[3])}; }
    }
};
struct EpiPlain {
    static constexpr bool PERM = true, AFTER_DRAIN = false, IDEM = true; static constexpr int MIDT = 0;
    bf16_t* O; int ldc; float scale;
    __device__ __forceinline__ void operator()(const f32x4 (&acc)[2][2][4][2], const Unit& u, int wr, int wc, int fr, int fq) const {
        const int row0 = u.pm * BM + wr * 64 + fr, col0 = u.pn * BM + wc * 32 + 8 * fq;
#pragma unroll
        for (int ai = 0; ai < 2; ++ai)
#pragma unroll
            for (int m = 0; m < 4; ++m)
#pragma unroll
                for (int bj = 0; bj < 2; ++bj) *(u32x4*)(O + (size_t)(row0 + ai * HALF + m * 16) * ldc + col0 + bj * HALF) = pack8(acc[ai][bj][m][0] * scale, acc[ai][bj][m][1] * scale);
    }
};

struct TicketOrder {
    unsigned* q; int xcd, per; volatile PG8_LAS int* tick; int wave; int skipv;
    __device__ __forceinline__ bool next(int i, Unit& u) const {
        const bool t0 = (wave == 0) && (mk_lane() == 0);
        if (i == 0) { if (t0) { tick[0] = (int)atomicAdd(q, 1u); tick[1] = (int)atomicAdd(q, 1u); } __syncthreads(); }
        else if (t0) tick[(i + 1) & 1] = (int)atomicAdd(q, 1u);
        const int tk = __builtin_amdgcn_readfirstlane(tick[i & 1]);
        if (tk >= per) return false;
        u.pm = 8 * xcd + (tk & 7); u.pn = tk >> 3; if (skipv && u.pn >= 8) u.pn += 4; u.e = 0; u.nt = 0; u.kofs = 0; u.keep = 0; return true;
    }
    __device__ __forceinline__ int arow(const Unit&, int R) const { return R; }
    __device__ __forceinline__ void a_ready(const Unit&) const {}
    __device__ __forceinline__ void done(const Unit&) const {}
};

struct SkipOrder { StaticOrder base;
    __device__ __forceinline__ bool next(int i, Unit& u) const { if (!base.next(i, u)) return false; if (u.pn >= 8) u.pn += 4; return true; }
    __device__ __forceinline__ int arow(const Unit&, int R) const { return R; }
    __device__ __forceinline__ void a_ready(const Unit&) const {}
    __device__ __forceinline__ void done(const Unit&) const {}
};
struct OffOrder { StaticOrder base; int off;
    __device__ __forceinline__ bool next(int i, Unit& u) const { if (!base.next(i, u)) return false; u.pn += off; return true; }
    __device__ __forceinline__ int arow(const Unit&, int R) const { return R; }
    __device__ __forceinline__ void a_ready(const Unit&) const {}
    __device__ __forceinline__ void done(const Unit&) const {}
};
struct GroupOrder {
    int nT, G, c; const PG8_LAS int* tile_e; const PG8_LAS int* ps; const PG8_LAS int* cn; const int* list; int lcap;
    __device__ __forceinline__ bool next(int i, Unit& u) const {
        const int L = i * G + c; if (L >= nT * 8) return false;
        const int wgid = (L & 7) * nT + (L >> 3);
        u.pm = wgid >> 3; u.pn = wgid & 7; u.e = __builtin_amdgcn_readfirstlane(tile_e[u.pm]); u.nt = 0; u.kofs = 0; u.keep = 0; return true;
    }
    __device__ __forceinline__ int arow(const Unit& u, int R) const { const int lr = u.pm * BM - ps[u.e] + R; return (lr < cn[u.e]) ? list[(size_t)u.e * lcap + lr] : 0; }
    __device__ __forceinline__ void a_ready(const Unit&) const {}
    __device__ __forceinline__ void done(const Unit&) const {}
};
template <class Epi, class Sched, bool ALIGN_EPI = false, bool SP2 = false, bool GATHER = false, bool MX = false>
__device__ __forceinline__ void gemm_phase(const int wv  , PG8_LAS unsigned char* lds, const Gemm g, const Sched& S, const Epi& E, unsigned* dbg_out = nullptr) {
    const int lane = mk_lane(), wid = wv, tid = wid * 64 + lane, wr = wid >> 2, wc = wid & 3, fr = lane & 15, fq = lane >> 4;
    const int K = g.K, nt_all = K / BK;
    unsigned voffA[2], voffB[2];
#pragma unroll
    for (int i = 0; i < 2; ++i) { int R, C; stage_rc(tid * 16 + i * 8192, R, C); const int Rb = Epi::PERM ? ((R & ~31) + perm32(R & 31)) : R;
        voffA[i] = (unsigned)(R * K + C) * 2u; voffB[i] = (unsigned)(Rb * K + C) * 2u; }
    static_assert(!GATHER || SP2, "GATHER needs the SP2 loop");
    unsigned vc0[2], vc1[2];
#define PG8_V(arr) (GATHER ? (arr) : voffA)
#define PG8_GOFF(dst0, dst1, uu) do { _Pragma("unroll") for (int i_ = 0; i_ < 2; ++i_) { int R_, C_; stage_rc(tid * 16 + i_ * 8192, R_, C_); \
        dst0[i_] = (unsigned)(S.arow(uu, R_) * K + C_) * 2u; dst1[i_] = (unsigned)(S.arow(uu, R_ + HALF) * K + C_) * 2u; } } while (0)
    const size_t kstep = (size_t)(BK * 2);
    const size_t hstep = (size_t)HALF * K * 2;
    const size_t tstep = 2 * hstep;
    const size_t hstepA = GATHER ? (size_t)0 : hstep;
    const unsigned ldsw = (unsigned)wid * 1024u; const unsigned lds0 = (unsigned)(uintptr_t)lds;
    const int aoff = lds_byte(wr * 64 + fr, fq * 8), boff = lds_byte(wc * 32 + fr, fq * 8);
#define PG8_SA(b, h) (((b) * 2 + (h)) * HTB)
#define PG8_SB(b, h) ((4 + (b) * 2 + (h)) * HTB)
#define PG8_STAGE(bufoff, gbase, voff) do { const char* sb_ = (const char*)(gbase);       \
        _Pragma("unroll") for (int _i = 0; _i < 2; ++_i) { unsigned keep_; const unsigned ld_ = lds0 + (unsigned)(bufoff) + ldsw + (unsigned)_i * 8192u; \
            asm volatile("s_mov_b32 %0, m0\n\ts_mov_b32 m0, %3\n\ts_nop 2\n\tglobal_load_lds_dwordx4 %1, %2\n\ts_mov_b32 m0, %0" : "=&s"(keep_) : "v"((voff)[_i]), "s"(sb_), "s"(ld_) : "memory"); } } while (0)
#define PG8_LDA(dst, b, h) do { unsigned ab_ = (unsigned)(PG8_SA(b, h) + aoff); asm volatile("" : "+v"(ab_));   \
        _Pragma("unroll") for (int m = 0; m < 4; ++m) _Pragma("unroll") for (int k = 0; k < 2; ++k) dst[m][k] = *(const PG8_LAS bf16x8*)(lds + ab_ + m * 2048 + k * 1024); } while (0)
#define PG8_LDB(dst, b, h) do { unsigned bb_ = (unsigned)(PG8_SB(b, h) + boff); asm volatile("" : "+v"(bb_)); \
        _Pragma("unroll") for (int n = 0; n < 2; ++n) _Pragma("unroll") for (int k = 0; k < 2; ++k) dst[n][k] = *(const PG8_LAS bf16x8*)(lds + bb_ + n * 2048 + k * 1024); } while (0)
#define PG8_CAT8(x, y) __builtin_bit_cast(i32x8, __builtin_shufflevector(x, y, 0, 1, 2, 3, 4, 5, 6, 7, 8, 9, 10, 11, 12, 13, 14, 15))
#define PG8_MMA(ai, bj, At, Bt) do { __builtin_amdgcn_s_setprio(1); _Pragma("unroll") for (int m = 0; m < 4; ++m) _Pragma("unroll") for (int n = 0; n < 2; ++n) { \
        if constexpr (MX) acc[ai][bj][m][n] = __builtin_amdgcn_mfma_scale_f32_16x16x128_f8f6f4(PG8_CAT8(Bt[n][0], Bt[n][1]), PG8_CAT8(At[m][0], At[m][1]), acc[ai][bj][m][n], 0, 0, 0, 0x7f7f7f7f, 0, 0x7f7f7f7f); \
        else { _Pragma("unroll") for (int k = 0; k < 2; ++k) acc[ai][bj][m][n] = __builtin_amdgcn_mfma_f32_16x16x32_bf16(Bt[n][k], At[m][k], acc[ai][bj][m][n], 0, 0, 0); } } __builtin_amdgcn_s_setprio(0); } while (0)
#define PG8_WAIT_V(n) asm volatile("s_waitcnt vmcnt(" #n ")" ::: "memory")
#define PG8_WAIT_L(n) asm volatile("s_waitcnt lgkmcnt(" #n ")" ::: "memory")
#define PG8_BAR __builtin_amdgcn_s_barrier()
#define PG8_SCHED __builtin_amdgcn_sched_barrier(0)
    Unit cur, nxt; int ui = 0;
    if (!S.next(0, cur)) return;
    f32x4 acc[2][2][4][2];
#pragma unroll
    for (int a = 0; a < 2; ++a)
#pragma unroll
        for (int b = 0; b < 2; ++b)
#pragma unroll
            for (int m = 0; m < 4; ++m)
#pragma unroll
                for (int n = 0; n < 2; ++n) acc[a][b][m][n] = (f32x4){0.f, 0.f, 0.f, 0.f};
    bf16x8 At[4][2], B0[2][2], B1[2][2];
    const char* cA = (const char*)g.A + (GATHER ? (size_t)0 : (size_t)cur.pm * tstep) + cur.kofs; const char* cB = (const char*)g.Bt + (size_t)cur.pn * tstep + (size_t)cur.e * g.estride + cur.kofs;
    S.a_ready(cur);
    if constexpr (GATHER) { PG8_GOFF(vc0, vc1, cur); } else {
#pragma unroll
        for (int i = 0; i < 2; ++i) { vc0[i] = voffA[i]; vc1[i] = voffA[i]; } }
    if constexpr (SP2) {
        PG8_STAGE(PG8_SB(0, 0), cB, voffB); PG8_STAGE(PG8_SB(0, 1), cB + hstep, voffB); PG8_STAGE(PG8_SA(0, 0), cA, PG8_V(vc0)); PG8_STAGE(PG8_SA(0, 1), cA + hstepA, PG8_V(vc1));
        if (wr == 1) PG8_BAR;
        PG8_WAIT_V(2); PG8_BAR;
        PG8_STAGE(PG8_SB(1, 0), cB + kstep, voffB); PG8_STAGE(PG8_SA(1, 0), cA + kstep, PG8_V(vc0)); PG8_STAGE(PG8_SB(1, 1), cB + hstep + kstep, voffB);
        PG8_WAIT_V(6); PG8_BAR;
    } else {
        PG8_STAGE(PG8_SB(0, 0), cB, voffB); PG8_STAGE(PG8_SA(0, 0), cA, voffA); PG8_STAGE(PG8_SB(0, 1), cB + hstep, voffB); PG8_STAGE(PG8_SA(0, 1), cA + hstep, voffA);
        if (wr == 1) PG8_BAR;
        PG8_WAIT_V(4); PG8_BAR;
        PG8_STAGE(PG8_SB(1, 0), cB + kstep, voffB); PG8_STAGE(PG8_SA(1, 0), cA + kstep, voffA); PG8_STAGE(PG8_SB(1, 1), cB + hstep + kstep, voffB);
        PG8_WAIT_V(6); PG8_BAR;
    }
    for (;;) {
        const bool has_next = S.next(ui + 1, nxt);
        const char* nA = (has_next && !GATHER) ? (const char*)g.A + (size_t)nxt.pm * tstep + nxt.kofs : (GATHER ? (const char*)g.A : cA);
        const char* nB = has_next ? (const char*)g.Bt + (size_t)nxt.pn * tstep + (size_t)nxt.e * g.estride + nxt.kofs : cB;
        const int nt = cur.nt > 0 ? cur.nt : nt_all;
#if MK_DBG
        const unsigned long long dbg_k0 = __builtin_amdgcn_s_memtime();
#endif
        for (int t = 0; t < nt; t += 2) {
            const bool last = (t == nt - 2);
            const char* a1 = cA + (size_t)(t + 1) * kstep;
            const char* a2 = last ? nA : cA + (size_t)(t + 2) * kstep; const char* b2 = last ? nB : cB + (size_t)(t + 2) * kstep;
            const char* a3 = a2 + kstep; const char* b3 = b2 + kstep;
            if (last && has_next) S.a_ready(nxt);
            if constexpr (SP2) {
            PG8_LDB(B0, 0, 0); PG8_LDB(B1, 0, 1); PG8_SCHED; PG8_LDA(At, 0, 0); PG8_STAGE(PG8_SA(1, 1), a1 + hstepA, PG8_V(vc1));
            if constexpr (GATHER) { if (last && has_next) { PG8_GOFF(vc0, vc1, nxt); } }
            PG8_WAIT_V(8); PG8_WAIT_L(0); PG8_BAR; PG8_MMA(0, 0, At, B0); PG8_MMA(0, 1, At, B1); PG8_BAR; PG8_SCHED;
            PG8_LDA(At, 0, 1); PG8_STAGE(PG8_SB(0, 0), b2, voffB); PG8_STAGE(PG8_SB(0, 1), b2 + hstep, voffB); PG8_STAGE(PG8_SA(0, 0), a2, PG8_V(vc0));
            PG8_WAIT_V(8); PG8_WAIT_L(0); PG8_BAR; PG8_MMA(1, 0, At, B0); PG8_MMA(1, 1, At, B1); PG8_BAR; PG8_SCHED;
            PG8_LDB(B0, 1, 0); PG8_LDB(B1, 1, 1); PG8_SCHED; PG8_LDA(At, 1, 0); PG8_STAGE(PG8_SA(0, 1), a2 + hstepA, PG8_V(vc1));
            PG8_WAIT_V(8); PG8_WAIT_L(0); PG8_BAR; PG8_MMA(0, 0, At, B0); PG8_MMA(0, 1, At, B1); PG8_BAR; PG8_SCHED;
            PG8_LDA(At, 1, 1); PG8_STAGE(PG8_SB(1, 0), b3, voffB); PG8_STAGE(PG8_SB(1, 1), b3 + hstep, voffB); PG8_STAGE(PG8_SA(1, 0), a3, PG8_V(vc0));
            PG8_WAIT_V(8); PG8_WAIT_L(0); PG8_BAR; PG8_MMA(1, 0, At, B0); PG8_MMA(1, 1, At, B1); PG8_BAR; PG8_SCHED;
            } else {
            PG8_LDB(B0, 0, 0); PG8_SCHED; PG8_LDA(At, 0, 0); PG8_STAGE(PG8_SA(1, 1), a1 + hstep, voffA);
            PG8_WAIT_L(8); PG8_BAR; PG8_WAIT_L(0); PG8_MMA(0, 0, At, B0); PG8_BAR; PG8_SCHED;
            PG8_LDB(B1, 0, 1); PG8_STAGE(PG8_SB(0, 0), b2, voffB);
            PG8_BAR; PG8_WAIT_L(0); PG8_MMA(0, 1, At, B1); PG8_BAR;
            PG8_LDA(At, 0, 1); PG8_STAGE(PG8_SA(0, 0), a2, voffA);
            PG8_BAR; PG8_WAIT_L(0); PG8_MMA(1, 0, At, B0); PG8_BAR; PG8_SCHED;
            PG8_STAGE(PG8_SB(0, 1), b2 + hstep, voffB);
            PG8_WAIT_V(6); PG8_BAR; PG8_MMA(1, 1, At, B1); PG8_BAR;
            PG8_LDB(B0, 1, 0); PG8_SCHED; PG8_LDA(At, 1, 0); PG8_STAGE(PG8_SA(0, 1), a2 + hstep, voffA);
            PG8_WAIT_L(8); PG8_BAR; PG8_WAIT_L(0); PG8_MMA(0, 0, At, B0); PG8_BAR; PG8_SCHED;
            PG8_LDB(B1, 1, 1); PG8_STAGE(PG8_SB(1, 0), b3, voffB);
            PG8_BAR; PG8_WAIT_L(0); PG8_MMA(0, 1, At, B1); PG8_BAR;
            PG8_LDA(At, 1, 1); PG8_STAGE(PG8_SA(1, 0), a3, voffA);
            PG8_BAR; PG8_WAIT_L(0); PG8_MMA(1, 0, At, B0); PG8_BAR; PG8_SCHED;
            PG8_STAGE(PG8_SB(1, 1), b3 + hstep, voffB);
            PG8_WAIT_V(6); PG8_BAR; PG8_MMA(1, 1, At, B1); PG8_BAR;
            }
        }
#if MK_DBG
        if (MK_DBG_GEMM && dbg_out != nullptr && ui == 2 && blockIdx.x == 0 && tid == 0) { const unsigned long long d = __builtin_amdgcn_s_memtime() - dbg_k0; dbg_out[7] = (unsigned)(d / (unsigned long long)nt); }
#endif
        if constexpr (ALIGN_EPI) { if (wr == 0) PG8_BAR; }
        int lane_e = mk_lane(); asm volatile("" : "+v"(lane_e));
        const int fr_e = lane_e & 15, fq_e = lane_e >> 4;
        if constexpr (!Epi::AFTER_DRAIN) { E(acc, cur, wr, wc, fr_e, fq_e); if (MK_EPI2 && Epi::IDEM) { asm volatile("" ::: "memory"); E(acc, cur, wr, wc, fr_e, fq_e); } S.done(cur); }
        if (!has_next) break;
        if (!nxt.keep) {
#pragma unroll
        for (int a = 0; a < 2; ++a)
#pragma unroll
            for (int b = 0; b < 2; ++b)
#pragma unroll
                for (int m = 0; m < 4; ++m)
#pragma unroll
                    for (int n = 0; n < 2; ++n) acc[a][b][m][n] = (f32x4){0.f, 0.f, 0.f, 0.f};
        }
        cur = nxt; cA = nA; cB = nB; ++ui;
        if constexpr (ALIGN_EPI) { if (wr == 1) PG8_BAR; }
    }
    PG8_WAIT_V(0);
    if constexpr (!ALIGN_EPI) { if (wr == 0) PG8_BAR; }
    PG8_BAR;
    if constexpr (Epi::AFTER_DRAIN) { E.fused(acc, cur, wr, wc, fr, fq, lds, wid, lane); S.done(cur); }
#undef PG8_SA
#undef PG8_SB
#undef PG8_STAGE
#undef PG8_LDA
#undef PG8_LDB
#undef PG8_MMA
#undef PG8_WAIT_V
#undef PG8_WAIT_L
#undef PG8_BAR
#undef PG8_SCHED
#undef PG8_GOFF
#undef PG8_V
}
}
#include <cmath>
#ifndef ATT_KDUP
#define ATT_KDUP 1
#endif
#ifndef ATT_HALF
#define ATT_HALF(w) ((w) >> 2)
#endif
#ifndef MK_DBG
#define MK_DBG 0
#endif
#ifndef MK_DBG_SEL
#define MK_DBG_SEL 0
#endif
#ifndef ATT_PRIO
#define ATT_PRIO 0
#endif
#ifndef ATT_SIMPLE
#define ATT_SIMPLE 1
#endif
namespace att {
typedef unsigned short bf16_t;
typedef short bf16x8 __attribute__((ext_vector_type(8)));
typedef short s16x4 __attribute__((ext_vector_type(4)));
typedef short v4i16_t __attribute__((ext_vector_type(4)));
typedef float f32x16 __attribute__((ext_vector_type(16)));
typedef unsigned u32x4 __attribute__((ext_vector_type(4)));
#define ATT_LAS __attribute__((address_space(3)))
constexpr int SLOT = 16384, RSLOT = 2 * SLOT  , ATT_LDS_BYTES = 4 * RSLOT;
__device__ __forceinline__ int crow(int r, int hi) { return (r & 3) + 8 * (r >> 2) + 4 * hi; }
__device__ __forceinline__ void glds16(const void* gsrc, unsigned lds_dst) { unsigned keep;
    asm volatile("s_mov_b32 %0, m0\n\ts_mov_b32 m0, %2\n\ts_nop 0\n\tglobal_load_lds_dwordx4 %1, off\n\ts_mov_b32 m0, %0" : "=&s"(keep) : "v"(gsrc), "s"(lds_dst) : "memory"); }
__device__ __forceinline__ const void* uniform_ptr(const void* p) { const unsigned long long v = (unsigned long long)p;
    return (const void*)(((unsigned long long)(unsigned)__builtin_amdgcn_readfirstlane((unsigned)(v >> 32)) << 32) | (unsigned long long)(unsigned)__builtin_amdgcn_readfirstlane((unsigned)v)); }
__device__ __forceinline__ void glds16s(const void* sbase, unsigned voff, unsigned lds_dst) { unsigned keep;
    asm volatile("s_mov_b32 %0, m0\n\ts_mov_b32 m0, %3\n\ts_nop 4\n\tglobal_load_lds_dwordx4 %1, %2\n\ts_mov_b32 m0, %0" : "=&s"(keep) : "v"(voff), "s"(sbase), "s"(lds_dst) : "memory"); }
typedef float f32x2_t __attribute__((ext_vector_type(2))); typedef __bf16 bf16x2_t __attribute__((ext_vector_type(2)));
__device__ __forceinline__ unsigned cvtpk(float lo, float hi) { f32x2_t v = {lo, hi}; bf16x2_t b = __builtin_convertvector(v, bf16x2_t); return __builtin_bit_cast(unsigned, b); }
__device__ __forceinline__ s16x4 vtr(ATT_LAS const char* p) { return __builtin_bit_cast(s16x4, __builtin_amdgcn_ds_read_tr16_b64_v4i16((ATT_LAS v4i16_t*)p)); }
__device__ __forceinline__ float swapsum(float m) { auto rr = __builtin_amdgcn_permlane32_swap(__float_as_uint(m), __float_as_uint(m), false, false); return __uint_as_float(rr[0]) + __uint_as_float(rr[1]); }

template <int DK>
__device__ __forceinline__ void attn_unit(const bf16_t* Qp, const bf16_t* Kp, const bf16_t* Vp, int i0, int t_lo, int t_hi, int win, int wskip, float slope2, float cref,
                                          bf16_t* Op, long ostride, float* lsep, long lstride, ATT_LAS unsigned char* lds, ATT_LAS float* wsbase, const int wv, unsigned* dbgp = nullptr) {
    constexpr int NKS = DK / 16;
    constexpr int NKW = DK / 64;
    const int lane = mk_lane(), r32 = lane & 31, hi = lane >> 5; const int wid = wv; const int tid = wid * 64 + lane;
    i0 = __builtin_amdgcn_readfirstlane(i0); t_lo = __builtin_amdgcn_readfirstlane(t_lo); t_hi = __builtin_amdgcn_readfirstlane(t_hi); win = __builtin_amdgcn_readfirstlane(win); wskip = __builtin_amdgcn_readfirstlane(wskip);
    const int half = ATT_HALF(wid);
    const int qrow = i0 + 32 * wid + r32, qmin_w = i0 + 32 * wid, qmax_w = qmin_w + 31;
    const unsigned lds0 = (unsigned)(uintptr_t)lds;
    ATT_LAS float* wsf = wsbase + wid * 64;
    const int NT = t_hi - t_lo;
    unsigned koff[NKW], voff[2];
#pragma unroll
    for (int i = 0; i < NKW; ++i) { const int p = wid + 8 * i;
        if (DK == 64) { const int r = 8 * p + (lane >> 3), pc = lane & 7; koff[i] = (unsigned)(r * 128 + ((pc ^ ((r >> 1) & 7)) << 4)); }
        else          { const int r = 4 * p + (lane >> 4), pc = lane & 15; koff[i] = (unsigned)(r * 256 + ((pc ^ (r & 15)) << 4)); } }
#pragma unroll
    for (int i = 0; i < 2; ++i) { const int p = wid + 8 * i, r = 4 * p + (lane >> 4), pc = lane & 15; voff[i] = (unsigned)(r * 256 + ((pc ^ (((r & 3) << 2) | ((r >> 2) & 3))) << 4)); }
    constexpr long ktile = 64L * DK, vtile = 64L * 128;
#define ATT_DMA(t, slot) do { \
        _Pragma("unroll") for (int d_ = 0; d_ < ATT_KDUP; ++d_) _Pragma("unroll") for (int i_ = 0; i_ < NKW; ++i_) glds16s(uniform_ptr(Kp + (long)(t) * ktile), koff[i_], (unsigned)__builtin_amdgcn_readfirstlane(lds0 + (slot) * RSLOT + (wid + 8 * i_) * 1024)); \
        _Pragma("unroll") for (int i_ = 0; i_ < 2; ++i_)   glds16s(uniform_ptr(Vp + (long)(t) * vtile), voff[i_], (unsigned)__builtin_amdgcn_readfirstlane(lds0 + (slot) * RSLOT + SLOT + (wid + 8 * i_) * 1024)); } while (0)
#define ATT_NEED(t) (!(64 * (t) > qmax_w || 64 * (t) + 63 < qmin_w - wskip))
    ATT_DMA(t_lo, 0);
    if (NT > 1) ATT_DMA(t_lo + 1, 1);
    bf16x8 qr[NKS];
#pragma unroll
    for (int d0 = 0; d0 < NKS; ++d0) qr[d0] = *reinterpret_cast<const bf16x8*>(Qp + (long)qrow * DK + d0 * 16 + hi * 8);
    float l_run = 0.f;
    f32x16 o[4];
#pragma unroll
    for (int d = 0; d < 4; ++d)
#pragma unroll
        for (int r = 0; r < 16; ++r) o[d][r] = 0.f;
    f32x16 p0, p1; bf16x8 pa[4];
#pragma unroll
    for (int r = 0; r < 16; ++r) { p0[r] = 0.f; p1[r] = 0.f; }
#pragma unroll
    for (int i = 0; i < 4; ++i) pa[i] = (bf16x8){0, 0, 0, 0, 0, 0, 0, 0};
    const int ksw = (DK == 64) ? ((r32 >> 1) & 7) : (r32 & 15);
    const unsigned kbx = (unsigned)(r32 * (DK * 2) + ((hi ^ (ksw & 1)) << 4) + ((ksw >> 1) << 5));
    const int vq = (lane & 15) >> 2, vpp = lane & 3, vblk = (lane >> 4) & 1;
    const unsigned vbx = (unsigned)(SLOT + 1024 * hi + 256 * vq + 8 * (vpp & 1) + 64 * vq + 16 * ((2 * vblk + (vpp >> 1)) ^ hi));
    ATT_LAS const char* const ldsc = (ATT_LAS const char*)lds;
    if (NT > 1) { if (NKW * ATT_KDUP == 1) asm volatile("s_waitcnt vmcnt(3)" ::: "memory"); else if (NKW * ATT_KDUP == 2) asm volatile("s_waitcnt vmcnt(4)" ::: "memory"); else asm volatile("s_waitcnt vmcnt(6)" ::: "memory"); } else asm volatile("s_waitcnt vmcnt(0)" ::: "memory");
    asm volatile("s_waitcnt lgkmcnt(0)\n\ts_barrier" ::: "memory");
#pragma unroll
    for (int d0 = 0; d0 < NKS; ++d0) asm volatile("" : "+v"(qr[d0]));
#if ATT_SIMPLE
#define ATT_QK(tr_) do { const int t_ = t_lo + (tr_); \
        const float tb = slope2 * (float)(64 * t_ + 4 * hi - qrow) - cref; \
        _Pragma("unroll") for (int r = 0; r < 16; ++r) { p0[r] = __builtin_fmaf(slope2, (float)((r & 3) + 8 * (r >> 2)), tb); p1[r] = __builtin_fmaf(slope2, (float)(32 + (r & 3) + 8 * (r >> 2)), tb); } \
        unsigned kb_ = kbx + ((tr_) & 3) * RSLOT; asm volatile("" : "+v"(kb_)); \
        _Pragma("unroll") for (int blk = 0; blk < NKS / 4; ++blk) { \
            unsigned ka[4]; \
            _Pragma("unroll") for (int j = 0; j < 4; ++j) ka[j] = kb_ ^ (unsigned)(32 * (4 * blk + j)); \
            bf16x8 kb0[4], kb1[4]; \
            _Pragma("unroll") for (int j = 0; j < 4; ++j) { ATT_LAS const char* kp = ldsc + ka[j]; kb0[j] = *(ATT_LAS const bf16x8*)kp; kb1[j] = *(ATT_LAS const bf16x8*)(kp + 32 * DK * 2); } \
            __builtin_amdgcn_sched_barrier(0); if (ATT_PRIO) __builtin_amdgcn_s_setprio(1); \
            _Pragma("unroll") for (int j = 0; j < 4; ++j) { p0 = __builtin_amdgcn_mfma_f32_32x32x16_bf16(kb0[j], qr[4 * blk + j], p0, 0, 0, 0); p1 = __builtin_amdgcn_mfma_f32_32x32x16_bf16(kb1[j], qr[4 * blk + j], p1, 0, 0, 0); } \
            if (ATT_PRIO) __builtin_amdgcn_s_setprio(0); __builtin_amdgcn_sched_barrier(0); } } while (0)
#define ATT_SM(tr_) do { const int t_ = t_lo + (tr_); \
        if (64 * t_ + 63 > qmin_w || 64 * t_ < qmax_w - win) {        \
            const int dq = qrow - 64 * t_ - 4 * hi; const unsigned uw = (unsigned)win; \
            _Pragma("unroll") for (int r = 0; r < 16; ++r) { const int c = (r & 3) + 8 * (r >> 2); \
                if ((unsigned)(dq - c) > uw) p0[r] = -INFINITY; if ((unsigned)(dq - c - 32) > uw) p1[r] = -INFINITY; } } \
        float sa = 0.f, sb = 0.f, sc = 0.f, sd = 0.f; \
        _Pragma("unroll") for (int r = 0; r < 16; r += 2) { p0[r] = __builtin_amdgcn_exp2f(p0[r]); p0[r + 1] = __builtin_amdgcn_exp2f(p0[r + 1]); p1[r] = __builtin_amdgcn_exp2f(p1[r]); p1[r + 1] = __builtin_amdgcn_exp2f(p1[r + 1]); \
            sa += p0[r]; sb += p0[r + 1]; sc += p1[r]; sd += p1[r + 1]; } \
        l_run += (sa + sb) + (sc + sd); \
        u32x4 w; \
        w.x = cvtpk(p0[0], p0[1]); w.y = cvtpk(p0[2], p0[3]); w.z = cvtpk(p0[4], p0[5]); w.w = cvtpk(p0[6], p0[7]); pa[0] = __builtin_bit_cast(bf16x8, w); \
        w.x = cvtpk(p0[8], p0[9]); w.y = cvtpk(p0[10], p0[11]); w.z = cvtpk(p0[12], p0[13]); w.w = cvtpk(p0[14], p0[15]); pa[1] = __builtin_bit_cast(bf16x8, w); \
        w.x = cvtpk(p1[0], p1[1]); w.y = cvtpk(p1[2], p1[3]); w.z = cvtpk(p1[4], p1[5]); w.w = cvtpk(p1[6], p1[7]); pa[2] = __builtin_bit_cast(bf16x8, w); \
        w.x = cvtpk(p1[8], p1[9]); w.y = cvtpk(p1[10], p1[11]); w.z = cvtpk(p1[12], p1[13]); w.w = cvtpk(p1[14], p1[15]); pa[3] = __builtin_bit_cast(bf16x8, w); } while (0)
#define ATT_PV(tr_) do { unsigned vb_ = vbx + ((tr_) & 3) * RSLOT; asm volatile("" : "+v"(vb_)); if (ATT_PRIO) __builtin_amdgcn_s_setprio(1); \
        s16x4 vl[16], vh[16]; \
        _Pragma("unroll") for (int i = 0; i < 16; ++i) { vl[i] = vtr(ldsc + (vb_ ^ (unsigned)(64 * (i >> 2))) + (i & 3) * 4096); vh[i] = vtr(ldsc + (vb_ ^ (unsigned)(64 * (i >> 2) + 32)) + (i & 3) * 4096 + 2048); } \
        _Pragma("unroll") for (int i = 0; i < 16; ++i) { \
            const bf16x8 vf = (bf16x8){vl[i][0], vl[i][1], vl[i][2], vl[i][3], vh[i][0], vh[i][1], vh[i][2], vh[i][3]}; \
            o[i >> 2] = __builtin_amdgcn_mfma_f32_32x32x16_bf16(pa[i & 3], vf, o[i >> 2], 0, 0, 0); } \
        __builtin_amdgcn_sched_group_barrier(0x100, 8, 0); \
        _Pragma("unroll") for (int i = 0; i < 12; ++i) { __builtin_amdgcn_sched_group_barrier(0x8, 1, 0); __builtin_amdgcn_sched_group_barrier(0x100, 2, 0); } \
        _Pragma("unroll") for (int i = 0; i < 4; ++i) __builtin_amdgcn_sched_group_barrier(0x8, 1, 0); if (ATT_PRIO) __builtin_amdgcn_s_setprio(0); } while (0)
#if ATT_SIMPLE == 3
    if (half) asm volatile("s_waitcnt lgkmcnt(0)\n\ts_barrier" ::: "memory");
    for (int tr = 0; tr <= NT; ++tr) {
        if (tr + 2 < NT) ATT_DMA(t_lo + tr + 2, (tr + 2) & 3);
        if (tr > 0 && ATT_NEED(t_lo + tr - 1)) { ATT_PV(tr - 1); }
        if (tr < NT && ATT_NEED(t_lo + tr)) { ATT_QK(tr); }
        if (tr + 2 < NT) { if (NKW == 1) asm volatile("s_waitcnt vmcnt(3)" ::: "memory"); else asm volatile("s_waitcnt vmcnt(4)" ::: "memory"); } else asm volatile("s_waitcnt vmcnt(0)" ::: "memory");
        asm volatile("s_waitcnt lgkmcnt(0)\n\ts_barrier" ::: "memory");
        if (tr == NT) break;
        if (ATT_NEED(t_lo + tr)) { ATT_SM(tr); }
        asm volatile("s_waitcnt lgkmcnt(0)\n\ts_barrier" ::: "memory");
    }
    if (!half) asm volatile("s_waitcnt lgkmcnt(0)\n\ts_barrier" ::: "memory");
#elif ATT_SIMPLE == 2
    for (int tr = 0; tr < NT; ++tr) {
        if (tr + 1 < NT) { if (NKW == 1) asm volatile("s_waitcnt vmcnt(3)" ::: "memory"); else asm volatile("s_waitcnt vmcnt(4)" ::: "memory"); } else asm volatile("s_waitcnt vmcnt(0)" ::: "memory");
        asm volatile("s_waitcnt lgkmcnt(0)\n\ts_barrier" ::: "memory");
        if (tr + 2 < NT) ATT_DMA(t_lo + tr + 2, (tr + 2) & 3);
        if (half == 0) {
            if (ATT_NEED(t_lo + tr)) { ATT_QK(tr); ATT_SM(tr); ATT_PV(tr); }
        } else {
            if (tr > 0 && ATT_NEED(t_lo + tr - 1)) { ATT_SM(tr - 1); ATT_PV(tr - 1); }
            if (ATT_NEED(t_lo + tr)) { ATT_QK(tr); }
        }
    }
    if (half != 0 && ATT_NEED(t_lo + NT - 1)) { ATT_SM(NT - 1); ATT_PV(NT - 1); }
#else
    for (int tp = 0; tp < NT; tp += 2) {
        asm volatile("s_waitcnt vmcnt(0)" ::: "memory");
        asm volatile("s_waitcnt lgkmcnt(0)\n\ts_barrier" ::: "memory");
        if (tp + 2 < NT) ATT_DMA(t_lo + tp + 2, (tp + 2) & 3);
        if (tp + 3 < NT) ATT_DMA(t_lo + tp + 3, (tp + 3) & 3);
#pragma unroll 1
        for (int sub = 0; sub < 2; ++sub) { const int tr = tp + sub; if (tr >= NT || !ATT_NEED(t_lo + tr)) continue; ATT_QK(tr); ATT_SM(tr); ATT_PV(tr); }
    }
#endif
#undef ATT_QK
#undef ATT_SM
#undef ATT_PV
    asm volatile("s_waitcnt vmcnt(0) lgkmcnt(0)\n\ts_barrier" ::: "memory");
#else
    const int nslots = 2 * NT + 2;
#if MK_DBG
    unsigned long long dbg_t0 = __builtin_amdgcn_s_memtime(), dbg_w = 0, dbg_a = 0, dbg_b = 0;
#endif
    for (int s = 0; s < nslots; ++s) {
        if ((s & 1) == 0) { const int tt = s >> 1; if (tt + 2 < NT) ATT_DMA(t_lo + tt + 2, (tt + 2) & 3); }
        const int k = s - half;
#if MK_DBG
        const unsigned long long dbg_pp = __builtin_amdgcn_s_memtime();
#endif
        if (k >= 0 && k <= 2 * NT) {
            const int tr = k >> 1, t = t_lo + tr;
            if ((k & 1) == 0) {
                const bool doqk = (tr < NT) && ATT_NEED(t), dopv = (tr >= 1) && ATT_NEED(t - 1);
                if (dopv) {
                    unsigned vb_ = vbx + ((tr - 1) & 3) * RSLOT; asm volatile("" : "+v"(vb_));
                    s16x4 vl[16], vh[16];
#pragma unroll
                    for (int i = 0; i < 16; ++i) { vl[i] = vtr(ldsc + (vb_ ^ (unsigned)(64 * (i >> 2))) + (i & 3) * 4096); vh[i] = vtr(ldsc + (vb_ ^ (unsigned)(64 * (i >> 2) + 32)) + (i & 3) * 4096 + 2048); }
#pragma unroll
                    for (int i = 0; i < 16; ++i) {
                        const bf16x8 vf = (bf16x8){vl[i][0], vl[i][1], vl[i][2], vl[i][3], vh[i][0], vh[i][1], vh[i][2], vh[i][3]};
                        o[i >> 2] = __builtin_amdgcn_mfma_f32_32x32x16_bf16(pa[i & 3], vf, o[i >> 2], 0, 0, 0); }
                    __builtin_amdgcn_sched_group_barrier(0x100, 8, 0);
#pragma unroll
                    for (int i = 0; i < 12; ++i) { __builtin_amdgcn_sched_group_barrier(0x8, 1, 0); __builtin_amdgcn_sched_group_barrier(0x100, 2, 0); }
#pragma unroll
                    for (int i = 0; i < 4; ++i) __builtin_amdgcn_sched_group_barrier(0x8, 1, 0);
                }
                __builtin_amdgcn_sched_barrier(0);
                if (doqk) {
                    const float tb = slope2 * (float)(64 * t + 4 * hi - qrow) - cref;
#pragma unroll
                    for (int r = 0; r < 16; ++r) { p0[r] = __builtin_fmaf(slope2, (float)((r & 3) + 8 * (r >> 2)), tb); p1[r] = __builtin_fmaf(slope2, (float)(32 + (r & 3) + 8 * (r >> 2)), tb); }
                    unsigned kb_ = kbx + (tr & 3) * RSLOT; asm volatile("" : "+v"(kb_));
#pragma unroll
                    for (int blk = 0; blk < NKS / 4; ++blk) {
                        unsigned ka[4];
#pragma unroll
                        for (int j = 0; j < 4; ++j) ka[j] = kb_ ^ (unsigned)(32 * (4 * blk + j));
                        bf16x8 kb0[4], kb1[4];
#pragma unroll
                        for (int j = 0; j < 4; ++j) { ATT_LAS const char* kp = ldsc + ka[j]; kb0[j] = *(ATT_LAS const bf16x8*)kp; kb1[j] = *(ATT_LAS const bf16x8*)(kp + 32 * DK * 2); }
                        __builtin_amdgcn_sched_barrier(0);
#pragma unroll
                        for (int j = 0; j < 4; ++j) { p0 = __builtin_amdgcn_mfma_f32_32x32x16_bf16(kb0[j], qr[4 * blk + j], p0, 0, 0, 0); p1 = __builtin_amdgcn_mfma_f32_32x32x16_bf16(kb1[j], qr[4 * blk + j], p1, 0, 0, 0); }
                        __builtin_amdgcn_sched_barrier(0);
                    }
                }
            } else if (tr < NT && ATT_NEED(t)) {
                if (64 * t + 63 > qmin_w || 64 * t < qmax_w - win) {
                    const int kb = 64 * t + 4 * hi, lo = qrow - win;
#pragma unroll
                    for (int r = 0; r < 16; ++r) { const int kv = kb + (r & 3) + 8 * (r >> 2);
                        if (kv > qrow || kv < lo) p0[r] = -INFINITY; if (kv + 32 > qrow || kv + 32 < lo) p1[r] = -INFINITY; }
                }
                float sa = 0.f, sb = 0.f, sc = 0.f, sd = 0.f;
#pragma unroll
                for (int r = 0; r < 16; r += 2) { p0[r] = __builtin_amdgcn_exp2f(p0[r]); p0[r + 1] = __builtin_amdgcn_exp2f(p0[r + 1]); p1[r] = __builtin_amdgcn_exp2f(p1[r]); p1[r + 1] = __builtin_amdgcn_exp2f(p1[r + 1]);
                    sa += p0[r]; sb += p0[r + 1]; sc += p1[r]; sd += p1[r + 1]; }
                l_run += (sa + sb) + (sc + sd);
                { u32x4 w;
                  w.x = cvtpk(p0[0], p0[1]); w.y = cvtpk(p0[2], p0[3]); w.z = cvtpk(p0[4], p0[5]); w.w = cvtpk(p0[6], p0[7]); pa[0] = __builtin_bit_cast(bf16x8, w);
                  w.x = cvtpk(p0[8], p0[9]); w.y = cvtpk(p0[10], p0[11]); w.z = cvtpk(p0[12], p0[13]); w.w = cvtpk(p0[14], p0[15]); pa[1] = __builtin_bit_cast(bf16x8, w);
                  w.x = cvtpk(p1[0], p1[1]); w.y = cvtpk(p1[2], p1[3]); w.z = cvtpk(p1[4], p1[5]); w.w = cvtpk(p1[6], p1[7]); pa[2] = __builtin_bit_cast(bf16x8, w);
                  w.x = cvtpk(p1[8], p1[9]); w.y = cvtpk(p1[10], p1[11]); w.z = cvtpk(p1[12], p1[13]); w.w = cvtpk(p1[14], p1[15]); pa[3] = __builtin_bit_cast(bf16x8, w); }
            }
        }
#if MK_DBG
        const unsigned long long dbg_t1 = __builtin_amdgcn_s_memtime();
        if (k >= 0 && k <= 2 * NT) { if ((k & 1) == 0) dbg_a += dbg_t1 - dbg_pp; else dbg_b += dbg_t1 - dbg_pp; }
#endif
        if (s & 1) { if ((s >> 1) + 2 < NT) { if (NKW * ATT_KDUP == 1) asm volatile("s_waitcnt vmcnt(3)" ::: "memory"); else if (NKW * ATT_KDUP == 2) asm volatile("s_waitcnt vmcnt(4)" ::: "memory"); else asm volatile("s_waitcnt vmcnt(6)" ::: "memory"); } else asm volatile("s_waitcnt vmcnt(0)" ::: "memory"); }
        asm volatile("s_waitcnt lgkmcnt(0)\n\ts_barrier" ::: "memory");
#if MK_DBG
        dbg_w += __builtin_amdgcn_s_memtime() - dbg_t1;
#endif
    }
#if MK_DBG
    if (dbgp != nullptr && tid == 0) { const unsigned long long tt = __builtin_amdgcn_s_memtime() - dbg_t0; dbgp[0] = (unsigned)(tt / (unsigned long long)nslots); dbgp[1] = (unsigned)(dbg_w / (unsigned long long)nslots); dbgp[2] = (unsigned)nslots; dbgp[3] = (unsigned)(dbg_a / (unsigned long long)(NT + 1)); dbgp[4] = (unsigned)(dbg_b / (unsigned long long)NT); }
#endif
#endif
#undef ATT_DMA
#undef ATT_NEED
    int lane_e = lane; asm volatile("" : "+v"(lane_e));
    const int r32e = lane_e & 31, hie = lane_e >> 5;
    const float l_tot = swapsum(l_run);
    if (hie == 0) wsf[32 + r32e] = l_tot;
    if (lsep != nullptr && hie == 0) lsep[(long)(i0 + 32 * wid + r32e) * lstride] = __builtin_amdgcn_logf(l_tot) + cref;
    {
        ATT_LAS unsigned short* stg = (ATT_LAS unsigned short*)(lds + wid * 8192);
#pragma unroll
        for (int r = 0; r < 16; ++r) { const int orow = crow(r, hie); const float rl = __builtin_amdgcn_rcpf(wsf[32 + orow]);
#pragma unroll
            for (int d0 = 0; d0 < 4; ++d0) stg[orow * 128 + d0 * 32 + r32e] = (unsigned short)(cvtpk(o[d0][r] * rl, 0.f) & 0xffffu); }
        asm volatile("s_waitcnt lgkmcnt(0)" ::: "memory");
        bf16_t* Ow = Op + (long)(i0 + 32 * wid) * ostride;
#pragma unroll
        for (int i = 0; i < 8; ++i) { const int row = i * 4 + (lane_e >> 4), ch = lane_e & 15; const u32x4 v = *(ATT_LAS const u32x4*)(stg + row * 128 + ch * 8); *(u32x4*)(Ow + (long)row * ostride + ch * 8) = v; }
    }
    asm volatile("s_waitcnt lgkmcnt(0)\n\ts_barrier" ::: "memory");
}
}
constexpr int NWAVES = 8;
constexpr int BATCH = 2, SEQ = 8192, DM = 2048, M = BATCH * SEQ;
constexpr int NIN = 11776;
#ifndef MK_NINP
#define MK_NINP 11776
#endif
constexpr int NINP = MK_NINP;
constexpr int C_DAQ = 0, C_DAK = 1024, C_DAV = 2048, C_DLQ = 3072, C_DLK = 4608, C_DLV = 6144, C_GA = 7680, C_GB = 9728;
constexpr int NE = 32, DFF = 1024, TK = 2 * M;
constexpr int XS_ROWS = TK + NE * 256;
constexpr float EPS = 1e-6f, LOG2E = 1.4426950408889634f;
constexpr float LAM_INIT = 0.2f;

#ifndef MK_N_LAUNCHES
#define MK_N_LAUNCHES 1
#endif
constexpr int N_PHASES = 12;
#ifndef MK_DBG_Q
#define MK_DBG_Q 250u
#endif
#ifndef MK_DBG_THR
#define MK_DBG_THR 0u
#endif
#ifndef MK_DBG_UNIT
#define MK_DBG_UNIT 0
#endif
#ifndef MK_SPLIT_AT
#define MK_SPLIT_AT (-1)
#endif
#ifndef MK_REPEAT_SUB
#define MK_REPEAT_SUB 3
#endif

constexpr size_t MiB = 1u << 20;
constexpr size_t WS_CTL = 0, CTL_ZERO_BYTES = 256 * 1024;
constexpr size_t WS_WR   = 1 * MiB;
constexpr size_t WS_GAIN = 1 * MiB + 512 * 1024;
constexpr size_t WS_ROUTE = 2 * MiB;
constexpr size_t WS_LSE  = 3 * MiB;
constexpr size_t WS_WIN  = 4 * MiB;
constexpr size_t WS_WIN8 = 36 * MiB;
constexpr size_t WS_XN8  = 672 * MiB;
constexpr size_t WS_WA   = 50 * MiB;
constexpr size_t WS_WB   = 54 * MiB;
constexpr size_t WS_WO   = 56 * MiB;
constexpr size_t WS_WGU  = 64 * MiB;
constexpr size_t WS_WD   = 320 * MiB;
constexpr size_t WS_XN   = 448 * MiB;
constexpr size_t WS_ODA  = 512 * MiB;
constexpr size_t WS_ODL  = 576 * MiB;
constexpr size_t WS_OA   = 624 * MiB;
constexpr size_t WS_OB   = 656 * MiB;
constexpr size_t WS_MIX  = 672 * MiB;
constexpr size_t WS_PROJ = 736 * MiB;
constexpr size_t WS_XS   = WS_PROJ;
constexpr size_t WS_Y8   = WS_PROJ + 240 * MiB;
constexpr size_t WS_HB   = WS_PROJ + 160 * MiB;
constexpr size_t WS_LIST = WS_PROJ + 376 * MiB;
constexpr size_t WS_RSL  = WS_LIST + 2 * MiB;
constexpr size_t WS_END  = WS_RSL + 2 * MiB;
static_assert((size_t)XS_ROWS * 2048 * 2 <= 160 * MiB && (size_t)XS_ROWS * 1024 * 2 <= 80 * MiB && (size_t)M * NINP * 2 <= 376 * MiB, "ws map");
constexpr int CW_TMO = 0, CW_CODE = 1;
constexpr int CW_BAR = 4096;
constexpr int CW_CNT = 16384, CW_FILL = 16384 + 64;
static_assert(true, "");
constexpr int CW_TQ = 24576;
constexpr int CW_DBG = 20480;
constexpr int CW_QUEUE = 20544;

constexpr int RING_OFF = 0, RING_BYTES = 131072;
constexpr int LDSCTL_OFF = RING_BYTES, MISC_OFF = LDSCTL_OFF + 320;
constexpr int TILE_E_OFF = LDSCTL_OFF + 1024;
constexpr int XCH_OFF = LDSCTL_OFF + 2048;
constexpr int LDS_BYTES = 147456;
static_assert(XCH_OFF + 8192 <= LDS_BYTES && att::ATT_LDS_BYTES <= RING_BYTES, "LDS map");

#define GAS __attribute__((address_space(1)))
#define LAS __attribute__((address_space(3)))
typedef unsigned short bf16;
typedef unsigned v4u __attribute__((ext_vector_type(4)));
typedef float f32x4 __attribute__((ext_vector_type(4)));
typedef short bf16x8 __attribute__((ext_vector_type(8)));
typedef GAS unsigned gu32;
typedef GAS unsigned long long gu64;
#define RLX_AGENT __ATOMIC_RELAXED, __HIP_MEMORY_SCOPE_AGENT
#define LDS_WAIT() asm volatile("s_waitcnt lgkmcnt(0)" ::: "memory")
#define VM_WAIT() asm volatile("s_waitcnt vmcnt(0)" ::: "memory")
__device__ __forceinline__ unsigned long long rt() { return __builtin_amdgcn_s_memrealtime(); }
__device__ __forceinline__ unsigned f2bf(float f) { unsigned u = __builtin_bit_cast(unsigned, f); return (u + 0x7fffu + ((u >> 16) & 1u)) >> 16; }
__device__ __forceinline__ unsigned pk2(float lo, float hi) { return f2bf(lo) | (f2bf(hi) << 16); }

#define XB_TMO      128
#define XB_XCNT(j)  (256  + 64 * (j))
#define XB_XSUB(j)  (1280 + 64 * (j))
#define XB_XGEN(j)  (2304 + 64 * (j))
#define XB_TOP      3328
#define XB_TOPGEN   3392
#define XCD_BAR_WORDS 3456
#define XB_SPIN_CAP (1u << 18)

__device__ __forceinline__ unsigned xb_ld(unsigned* p)              { return __hip_atomic_load(p, __ATOMIC_RELAXED, __HIP_MEMORY_SCOPE_AGENT); }
__device__ __forceinline__ unsigned xb_add(unsigned* p, unsigned v) { return __hip_atomic_fetch_add(p, v, __ATOMIC_RELAXED, __HIP_MEMORY_SCOPE_AGENT); }
__device__ __forceinline__ unsigned xb_xcc_id() { return (unsigned)__builtin_amdgcn_s_getreg((3 << 11) | 20) & 0xFu; }
#define XB_SPIN(cond, bar) do { unsigned _sp = 0; while (cond) { __builtin_amdgcn_s_sleep(1); \
    if ((++_sp & 255u) == 0u) { if (xb_ld(&(bar)[XB_TMO])) break; if (_sp > XB_SPIN_CAP) { atomicAdd(&(bar)[XB_TMO], 1u); break; } } } } while (0)

struct XcdBarrier {
    unsigned* bar; unsigned x; unsigned w0;
    volatile LAS unsigned* st;
};

__device__ __forceinline__ XcdBarrier xcd_barrier_post(unsigned* bar, volatile LAS unsigned* st, unsigned w0) {
    XcdBarrier b; b.bar = bar; b.x = xb_xcc_id(); b.st = st; b.w0 = w0;
    if (w0 && mk_lane() == 0) (void)xb_add(&bar[XB_XCNT(b.x)], 1u);
    return b;
}
__device__ __forceinline__ void xcd_barrier_complete(unsigned* bar, unsigned x, unsigned& nloc, unsigned& nx) {
    const unsigned G = gridDim.x * gridDim.y * gridDim.z;
    unsigned sum, cnt, mine, sp = 0u;
    for (;;) {
        sum = 0u; cnt = 0u; mine = 0u;
#pragma unroll
        for (unsigned j = 0; j < 16; ++j) { const unsigned c = xb_ld(&bar[XB_XCNT(j)]); sum += c; cnt += (c > 0u) ? 1u : 0u; mine = (j == x) ? c : mine; }
        if (sum == G) break;
        __builtin_amdgcn_s_sleep(1);
        if ((++sp & 255u) == 0u) { if (xb_ld(&bar[XB_TMO])) break; if (sp > XB_SPIN_CAP) { atomicAdd(&bar[XB_TMO], 1u); break; } }
    }
    nloc = mine > 0u ? mine : 1u; nx = cnt > 0u ? cnt : 1u;
}

__device__ __forceinline__ void xcd_barrier(const XcdBarrier& b) {
    asm volatile("s_waitcnt vmcnt(0)" ::: "memory");
    __syncthreads();
    if (b.w0 && mk_lane() == 0) {
        unsigned* bar = b.bar;
        __builtin_amdgcn_s_waitcnt(0);
        unsigned nloc = b.st[0], nx = b.st[1];
        if (nloc == 0u) { xcd_barrier_complete(bar, b.x, nloc, nx); b.st[0] = nloc; b.st[1] = nx; }
        const unsigned old = xb_add(&bar[XB_XSUB(b.x)], 1u);
        const unsigned gen = old / nloc;
        if (old + 1u == (gen + 1u) * nloc) {
            __builtin_amdgcn_fence(__ATOMIC_RELEASE, "agent");
            asm volatile("s_waitcnt vmcnt(0)" ::: "memory");
            const unsigned og = xb_add(&bar[XB_TOP], 1u);
            const unsigned tg = og / nx;
            if (og + 1u == (tg + 1u) * nx) xb_add(&bar[XB_TOPGEN], 1u);
            else XB_SPIN(xb_ld(&bar[XB_TOPGEN]) == tg, bar);
            __builtin_amdgcn_fence(__ATOMIC_ACQUIRE, "agent");
            xb_add(&bar[XB_XGEN(b.x)], 1u);
            asm volatile("s_waitcnt vmcnt(0)" ::: "memory");
        } else {
            XB_SPIN(xb_ld(&bar[XB_XGEN(b.x)]) == gen, bar);
            __builtin_amdgcn_fence(__ATOMIC_ACQUIRE, "agent");
            asm volatile("s_waitcnt vmcnt(0)" ::: "memory");
        }
    }
    __syncthreads();
}
struct Args { const float* in[18]; float* out; unsigned char* ws; int ph_lo, ph_hi, li, sub; };
struct Frame {
    const Args* ka;
    LAS unsigned char* lds;
    volatile LAS unsigned* MISC;
    gu32* ctl;
    int wave;
    int vcu, G, li;
    unsigned char* ws;
    float* out;
};
__device__ __forceinline__ float wave_sum(float v) {
#pragma unroll
    for (int o = 1; o < 64; o <<= 1) v += __shfl_xor(v, o);
    return v;
}
__device__ __forceinline__ void p0_transpose_item(const float* W, int K, int N, bf16* WT, int k0, int n0, int dst_row0, LAS unsigned char* scr, int lane, int kdst = -1) {
    if (kdst < 0) kdst = k0;
    const int q = lane >> 4, m = lane & 15;
    const GAS f32x4* src = (const GAS f32x4*)(W + (size_t)(k0 + 2 * q) * N + n0) + m;
    f32x4 v[16];
#pragma unroll
    for (int i = 0; i < 16; ++i) v[i] = src[((size_t)(8 * (i >> 1) + (i & 1)) * N) >> 2];
#pragma unroll
    for (int j = 0; j < 8; ++j) {
#pragma unroll
        for (int c = 0; c < 4; ++c) {
            const int n = 4 * m + c, col = (4 * j + q) ^ ((m & 7) << 2);
            *(LAS unsigned*)(scr + n * 128 + col * 4) = pg8::cvt_pk_bf16(v[2 * j][c], v[2 * j + 1][c]);
        }
    }
    LDS_WAIT(); asm volatile("" ::: "memory");
    const int ch = lane & 7;
#pragma unroll
    for (int i = 0; i < 8; ++i) { const int n = 8 * i + (lane >> 3);
        const v4u o = *(const LAS v4u*)(scr + n * 128 + ((ch ^ ((n >> 2) & 7)) << 4));
        *(GAS v4u*)(WT + (size_t)(dst_row0 + n) * K + kdst + 8 * ch) = o; }
    LDS_WAIT(); asm volatile("" ::: "memory");
}
__device__ __forceinline__ void p0_item_load(const float* W, int N, int k0, int n0, int lane, f32x4 (&v)[16]) {
    const int q = lane >> 4, m = lane & 15;
    const GAS f32x4* src = (const GAS f32x4*)(W + (size_t)(k0 + 2 * q) * N + n0) + m;
#pragma unroll
    for (int i = 0; i < 16; ++i) v[i] = src[((size_t)(8 * (i >> 1) + (i & 1)) * N) >> 2];
}
__device__ __forceinline__ void p0_item_store(const f32x4 (&v)[16], int K, bf16* WT, int k0, int dst_row0, LAS unsigned char* scr, int lane) {
    const int q = lane >> 4, m = lane & 15;
#pragma unroll
    for (int j = 0; j < 8; ++j) {
#pragma unroll
        for (int c = 0; c < 4; ++c) {
            const int n = 4 * m + c, col = (4 * j + q) ^ ((m & 7) << 2);
            *(LAS unsigned*)(scr + n * 128 + col * 4) = pg8::cvt_pk_bf16(v[2 * j][c], v[2 * j + 1][c]);
        }
    }
    LDS_WAIT(); asm volatile("" ::: "memory");
    const int ch = lane & 7;
#pragma unroll
    for (int i = 0; i < 8; ++i) { const int n = 8 * i + (lane >> 3);
        const v4u o = *(const LAS v4u*)(scr + n * 128 + ((ch ^ ((n >> 2) & 7)) << 4));
        *(GAS v4u*)(WT + (size_t)(dst_row0 + n) * K + k0 + 8 * ch) = o; }
    LDS_WAIT(); asm volatile("" ::: "memory");
}
__device__ __forceinline__ void p0_item_store_fp8(const f32x4 (&v)[16], int K, unsigned char* WT, int k0, int dst_row0, LAS unsigned char* scr, int lane) {
    const int q = lane >> 4, m = lane & 15;
#pragma unroll
    for (int j = 0; j < 8; ++j) {
#pragma unroll
        for (int c = 0; c < 4; ++c) {
            const int n = 4 * m + c, kb = 8 * j + 2 * q;
            const int p = __builtin_amdgcn_cvt_pk_fp8_f32(v[2 * j][c] * pg8::WSCALE, v[2 * j + 1][c] * pg8::WSCALE, 0, false);
            *(LAS unsigned short*)(scr + n * 64 + ((((kb >> 4) ^ (m & 3)) << 4) | (kb & 15))) = (unsigned short)p;
        }
    }
    LDS_WAIT(); asm volatile("" ::: "memory");
    const int ch = lane & 3;
#pragma unroll
    for (int i = 0; i < 4; ++i) { const int n = 16 * i + (lane >> 2);
        const v4u o = *(const LAS v4u*)(scr + n * 64 + ((ch ^ ((n >> 2) & 3)) << 4));
        *(GAS v4u*)(WT + (size_t)(dst_row0 + n) * K + k0 + 16 * ch) = o; }
    LDS_WAIT(); asm volatile("" ::: "memory");
}
struct MoeItem { const float* W; bf16* WT; int K, N, k0, n0, drow, f8; };
__device__ __forceinline__ MoeItem moe_item(Frame& F, int r) {
    constexpr int I_GU1 = (DM / 64) * (2048 / 64), I_GU = NE * I_GU1, I_D1 = (DFF / 64) * (DM / 64);
    MoeItem it;
    if (r < I_GU) { const int e = r / I_GU1, q = r % I_GU1, nblk = 2048 / 64, kb = q / nblk, nb = q % nblk, n0 = 64 * nb, j = n0 & 1023, up = n0 >> 10;
        it.W = F.ka->in[16] + (size_t)e * DM * 2048; it.WT = (bf16*)(F.ws + WS_WGU + (size_t)e * 2048 * DM); it.K = DM; it.N = 2048; it.k0 = 64 * kb; it.n0 = n0; it.drow = 256 * (j >> 7) + 128 * up + (j & 127); it.f8 = 1; }
    else { r -= I_GU; const int e = r / I_D1, q = r % I_D1, nblk = DM / 64, kb = q / nblk, nb = q % nblk;
        it.W = F.ka->in[17] + (size_t)e * DFF * DM; it.WT = (bf16*)(F.ws + WS_WD + (size_t)e * DM * DFF); it.K = DFF; it.N = DM; it.k0 = 64 * kb; it.n0 = 64 * nb; it.drow = 64 * nb; it.f8 = 1; }
    return it;
}
__device__ __forceinline__ void p0_moe_weights(Frame& F, int gw, int NGW) {
    constexpr int NIT = NE * ((DM / 64) * (2048 / 64) + (DFF / 64) * (DM / 64));
    LAS unsigned char* scr = F.lds + RING_OFF + F.wave * 8192;
    f32x4 va[16], vb[16];
    int r = gw;
    if (r < NIT) { const MoeItem a = moe_item(F, r); p0_item_load(a.W, a.N, a.k0, a.n0, mk_lane(), va); }
    for (; r < NIT; r += 2 * NGW) {
        const MoeItem a = moe_item(F, r);
        const bool hb = r + NGW < NIT; MoeItem b = a;
        if (hb) { b = moe_item(F, r + NGW); p0_item_load(b.W, b.N, b.k0, b.n0, mk_lane(), vb); }
        if (a.f8) p0_item_store_fp8(va, a.K, (unsigned char*)a.WT, a.k0, a.drow, scr, mk_lane()); else p0_item_store(va, a.K, a.WT, a.k0, a.drow, scr, mk_lane());
        if (r + 2 * NGW < NIT) { const MoeItem c = moe_item(F, r + 2 * NGW); p0_item_load(c.W, c.N, c.k0, c.n0, mk_lane(), va); }
        if (hb) { if (b.f8) p0_item_store_fp8(vb, b.K, (unsigned char*)b.WT, b.k0, b.drow, scr, mk_lane()); else p0_item_store(vb, b.K, b.WT, b.k0, b.drow, scr, mk_lane()); }
    }
}
__device__ __forceinline__ void p0_prologue(Frame& F, int which, int gw, int NGW) {
    LAS unsigned char* scr = F.lds + RING_OFF + F.wave * 8192;
    constexpr int I_IN = (DM / 64) * (NIN / 64), I_A = (1024 / 64) * (DM / 64), I_B = (512 / 64) * (DM / 64), I_O = (DM / 64) * (DM / 64);
    constexpr int I_GU1 = (DM / 64) * (2048 / 64), I_GU = NE * I_GU1, I_D1 = (DFF / 64) * (DM / 64), I_D = NE * I_D1;
    constexpr int NITEMS = I_IN + I_A + I_B + I_O + I_GU + I_D;
    bf16* WIN = (bf16*)(F.ws + WS_WIN); bf16* WA = (bf16*)(F.ws + WS_WA); bf16* WB = (bf16*)(F.ws + WS_WB); bf16* WO = (bf16*)(F.ws + WS_WO); bf16* WGU = (bf16*)(F.ws + WS_WGU); bf16* WD = (bf16*)(F.ws + WS_WD);
    for (int it = gw; it < NITEMS; it += NGW) {
        int r = it;
        if (!(which & 1) && r < I_IN + I_A + I_B + I_O) continue;
        if (!(which & 2) && r >= I_IN + I_A + I_B + I_O) break;
        if (r < I_IN) { const int nblk = NIN / 64, kb = r / nblk, nb = r % nblk;
            const int n0 = 64 * nb, r8 = (n0 >= C_GA) ? n0 - C_GA : (n0 >= C_DAV && n0 < C_DLQ) ? 4096 + (n0 - C_DAV) : (n0 >= C_DLV) ? 5120 + (n0 - C_DLV) : -1;
            if (r8 < 0) p0_transpose_item(F.ka->in[2], DM, NIN, WIN, 64 * kb, n0, n0, scr, mk_lane());
            else { f32x4 v[16]; p0_item_load(F.ka->in[2], NIN, 64 * kb, n0, mk_lane(), v); p0_item_store_fp8(v, DM, (unsigned char*)(F.ws + WS_WIN8), 64 * kb, r8, scr, mk_lane()); }
            continue; } r -= I_IN;
        if (r < I_A)  { const int nblk = DM / 64, kb = r / nblk, nb = r % nblk; p0_transpose_item(F.ka->in[10], 1536, DM, WA, 64 * kb, 64 * nb, 64 * nb, scr, mk_lane()); continue; } r -= I_A;
        if (r < I_B)  { const int nblk = DM / 64, kb = r / nblk, nb = r % nblk; p0_transpose_item(F.ka->in[11], 1536, DM, WA, 64 * kb, 64 * nb, 64 * nb, scr, mk_lane(), 1024 + 64 * kb); continue; } r -= I_B;
        if (r < I_O)  { const int nblk = DM / 64, kb = r / nblk, nb = r % nblk; p0_transpose_item(F.ka->in[12], DM, DM, WO, 64 * kb, 64 * nb, 64 * nb, scr, mk_lane()); continue; } r -= I_O;
        if (r < I_GU) { const int e = r / I_GU1, q = r % I_GU1, nblk = 2048 / 64, kb = q / nblk, nb = q % nblk, n0 = 64 * nb, j = n0 & 1023, up = n0 >> 10;
                        p0_transpose_item(F.ka->in[16] + (size_t)e * DM * 2048, DM, 2048, WGU + (size_t)e * 2048 * DM, 64 * kb, n0, 256 * (j >> 7) + 128 * up + (j & 127), scr, mk_lane()); continue; } r -= I_GU;
        { const int e = r / I_D1, q = r % I_D1, nblk = DM / 64, kb = q / nblk, nb = q % nblk;
          p0_transpose_item(F.ka->in[17] + (size_t)e * DFF * DM, DFF, DM, WD + (size_t)e * DM * DFF, 64 * kb, 64 * nb, 64 * nb, scr, mk_lane()); }
    }
    bf16* XN = (bf16*)(F.ws + WS_XN);
    if (which & 4) {
        f32x4 g[8];
#pragma unroll
        for (int j = 0; j < 8; ++j) g[j] = *((const GAS f32x4*)F.ka->in[1] + mk_lane() + 64 * j);
        for (int m = gw; m < M; m += 2 * NGW) {
            const int m2 = (m + NGW < M) ? m + NGW : m;
            const GAS f32x4* xr = (const GAS f32x4*)(F.ka->in[0] + (size_t)m * DM) + mk_lane(); const GAS f32x4* xr2 = (const GAS f32x4*)(F.ka->in[0] + (size_t)m2 * DM) + mk_lane();
            f32x4 v[8], w[8]; float s = 0.f, s2 = 0.f;
#pragma unroll
            for (int j = 0; j < 8; ++j) { v[j] = xr[64 * j]; w[j] = xr2[64 * j]; }
#pragma unroll
            for (int j = 0; j < 8; ++j) { s += (v[j].x * v[j].x + v[j].y * v[j].y) + (v[j].z * v[j].z + v[j].w * v[j].w); s2 += (w[j].x * w[j].x + w[j].y * w[j].y) + (w[j].z * w[j].z + w[j].w * w[j].w); }
            const float rstd = 1.0f / sqrtf(wave_sum(s) * (1.f / DM) + EPS), rstd2 = 1.0f / sqrtf(wave_sum(s2) * (1.f / DM) + EPS);
            GAS unsigned long long* o8 = (GAS unsigned long long*)(XN + (size_t)m * DM) + mk_lane(); GAS unsigned long long* o82 = (GAS unsigned long long*)(XN + (size_t)m2 * DM) + mk_lane();
            GAS unsigned* q8 = (GAS unsigned*)((unsigned char*)(F.ws + WS_XN8) + (size_t)m * DM) + mk_lane(); GAS unsigned* q82 = (GAS unsigned*)((unsigned char*)(F.ws + WS_XN8) + (size_t)m2 * DM) + mk_lane();
#pragma unroll
            for (int j = 0; j < 8; ++j) { const f32x4 t = v[j] * rstd * g[j]; o8[64 * j] = (unsigned long long)pk2(t.x, t.y) | ((unsigned long long)pk2(t.z, t.w) << 32); q8[64 * j] = pg8::pk_fp8x4(t.x * pg8::XSCALE, t.y * pg8::XSCALE, t.z * pg8::XSCALE, t.w * pg8::XSCALE);
                                          const f32x4 t2 = w[j] * rstd2 * g[j]; o82[64 * j] = (unsigned long long)pk2(t2.x, t2.y) | ((unsigned long long)pk2(t2.z, t2.w) << 32); q82[64 * j] = pg8::pk_fp8x4(t2.x * pg8::XSCALE, t2.y * pg8::XSCALE, t2.z * pg8::XSCALE, t2.w * pg8::XSCALE); }
        }
    }
    if ((which & 4) && F.vcu == 0 && (F.wave * 64 + mk_lane()) < 384) { float* GN = (float*)(F.ws + WS_GAIN); const int t = (F.wave * 64 + mk_lane()); GN[t] = (t < 64) ? F.ka->in[3][t] : (t < 128) ? F.ka->in[4][t - 64] : (t < 256) ? F.ka->in[8][t - 128] : F.ka->in[9][t - 256]; }
    if (which & 4) { float* WR = (float*)(F.ws + WS_WR);
      for (int i = (F.vcu * NWAVES * 64) + (F.wave * 64 + mk_lane()); i < DM * 48; i += F.G * NWAVES * 64) { const int k = i / 48, c = i % 48; const float gn = F.ka->in[13][k];
          WR[i] = (c < 32) ? F.ka->in[15][k * 32 + c] * gn : (c < 36) ? F.ka->in[14][k * 4 + (c - 32)] * gn : 0.f; } }
}
__device__ __forceinline__ void p2_attention(Frame& F, int which) {
    const bf16* PROJ = (const bf16*)(F.ws + WS_PROJ);
    bf16* ODA = (bf16*)(F.ws + WS_ODA); bf16* ODL = (bf16*)(F.ws + WS_ODL); float* LSE = (float*)(F.ws + WS_LSE);
    float gq = fabsf(F.ka->in[3][mk_lane()]), gk = fabsf(F.ka->in[4][mk_lane()]);
#pragma unroll
    for (int o = 1; o < 64; o <<= 1) { gq = fmaxf(gq, __shfl_xor(gq, o)); gk = fmaxf(gk, __shfl_xor(gk, o)); }
    const float Bq = 8.0f * gq * gk * 1.02f;
    float g1 = fmaxf(fabsf(F.ka->in[8][mk_lane()]), fabsf(F.ka->in[8][64 + mk_lane()])), g2 = fmaxf(fabsf(F.ka->in[9][mk_lane()]), fabsf(F.ka->in[9][64 + mk_lane()]));
#pragma unroll
    for (int o = 1; o < 64; o <<= 1) { g1 = fmaxf(g1, __shfl_xor(g1, o)); g2 = fmaxf(g2, __shfl_xor(g2, o)); }
    const float Bl = 11.313708f * g1 * g2 * 1.02f;
    volatile LAS int* QW = (volatile LAS int*)(F.MISC + 16);
    for (;;) {
        if ((F.wave * 64 + mk_lane()) == 0) QW[0] = (int)atomicAdd((unsigned*)(F.ctl + CW_QUEUE) + 64 * F.li, 1u);
        __syncthreads();
        const int u = __builtin_amdgcn_readfirstlane(QW[0]);
        if (u >= 1024 + 768) break;
        if (u < 1024) {
            const int h = 7 - (u >> 7), rem = u & 127, b = rem >> 6, mp = (rem >> 5) & 1, qb = 31 - (rem & 31);
            const float slope = exp2f(-(float)(h + 1));
            const float Df = (2.0f * Bq + logf(1.0f / slope) + 30.0f) / slope;
            const int Dk = (Df < 1.0e6f) ? (int)Df + 1 : (1 << 20);
            int t_lo = (256 * qb - Dk) >> 6; if (t_lo < 0) t_lo = 0;
            if (which & 1)
            att::attn_unit<64>(PROJ + pg8::PJ_QA + (size_t)((b * 8 + h) * 2 + mp) * SEQ * 64, PROJ + pg8::PJ_KA + (size_t)((b * 8 + h) * 2 + mp) * SEQ * 64, PROJ + pg8::PJ_VA + (size_t)(b * 8 + h) * SEQ * 128,
                               256 * qb, t_lo, 4 * (qb + 1), 1 << 30, Dk, slope * LOG2E, Bq * LOG2E - 20.0f,
                               ODA + (size_t)mp * M * 1024 + (size_t)b * SEQ * 1024 + h * 128, 1024L, nullptr, 0L, F.lds + RING_OFF, (LAS float*)(F.lds + XCH_OFF), F.wave, (u == MK_DBG_UNIT) ? (unsigned*)(F.ctl + CW_DBG) : nullptr);
        } else {
            const int v = u - 1024, b = v / 384, rem = v % 384, g = rem / 128, rem2 = rem % 128, h = rem2 / 32, j = rem2 % 32;
            const int d = (g == 0) ? 1 : (g == 1) ? 4 : 16, nblk = 32 / d, r = j / nblk, iblk = j % nblk, hh = g * 4 + h;
            const size_t hoff = ((size_t)(b * 12 + hh) * SEQ + (size_t)r * (SEQ / d)) * 128;
            const float slope2 = exp2f(-8.0f * (float)(hh + 1) / 12.0f) * (float)d * LOG2E;
            if (which & 2)
            att::attn_unit<128>(PROJ + pg8::PJ_QL + hoff, PROJ + pg8::PJ_KL + hoff, PROJ + pg8::PJ_VL + hoff, 256 * iblk, (4 * iblk - 2 < 0) ? 0 : 4 * iblk - 2, 4 * iblk + 4, 128, 128, slope2, Bl * LOG2E - 20.0f,
                                ODL + (size_t)g * M * 512 + ((size_t)b * SEQ + r) * 512 + h * 128, 512L * d, LSE + (size_t)g * M * 4 + ((size_t)b * SEQ + r) * 4 + h, 4L * d, F.lds + RING_OFF, (LAS float*)(F.lds + XCH_OFF), F.wave);
        }
        __syncthreads();
    }
}
__device__ __forceinline__ void p3_merge(Frame& F) {
    const int gw = F.vcu * NWAVES + F.wave, NGW = F.G * NWAVES, lane = mk_lane();
    const bf16* ODA = (const bf16*)(F.ws + WS_ODA); const bf16* ODL = (const bf16*)(F.ws + WS_ODL); const float* LSE = (const float*)(F.ws + WS_LSE);
    bf16* OA = (bf16*)(F.ws + WS_OA); bf16* OB = (bf16*)(F.ws + WS_OB);
    const float s0 = wave_sum(F.ka->in[5][lane] * F.ka->in[6][lane]), s1 = wave_sum(F.ka->in[5][64 + lane] * F.ka->in[6][64 + lane]);
    const float lam = expf(s0) - expf(s1) + LAM_INIT;
    float sg[16];
#pragma unroll
    for (int j = 0; j < 16; ++j) sg[j] = F.ka->in[7][(lane & 7) * 16 + j] * (1.0f - LAM_INIT);
    for (int m = gw; m < M; m += NGW) {
        {
            const v4u* p0 = (const v4u*)(ODA + (size_t)m * 1024 + lane * 16); const v4u* p1 = (const v4u*)(ODA + (size_t)M * 1024 + (size_t)m * 1024 + lane * 16);
            float a[16], b[16]; pg8::unpack8(p0[0], *(float(*)[8])&a[0]); pg8::unpack8(p0[1], *(float(*)[8])&a[8]); pg8::unpack8(p1[0], *(float(*)[8])&b[0]); pg8::unpack8(p1[1], *(float(*)[8])&b[8]);
            float ss = 0.f;
#pragma unroll
            for (int j = 0; j < 16; ++j) { a[j] = a[j] - lam * b[j]; ss += a[j] * a[j]; }
            ss += __shfl_xor(ss, 1); ss += __shfl_xor(ss, 2); ss += __shfl_xor(ss, 4);
            const float rstd = 1.0f / sqrtf(ss * (1.f / 128.f) + EPS);
            v4u o0, o1;
            o0.x = pk2(a[0] * rstd * sg[0], a[1] * rstd * sg[1]); o0.y = pk2(a[2] * rstd * sg[2], a[3] * rstd * sg[3]); o0.z = pk2(a[4] * rstd * sg[4], a[5] * rstd * sg[5]); o0.w = pk2(a[6] * rstd * sg[6], a[7] * rstd * sg[7]);
            o1.x = pk2(a[8] * rstd * sg[8], a[9] * rstd * sg[9]); o1.y = pk2(a[10] * rstd * sg[10], a[11] * rstd * sg[11]); o1.z = pk2(a[12] * rstd * sg[12], a[13] * rstd * sg[13]); o1.w = pk2(a[14] * rstd * sg[14], a[15] * rstd * sg[15]);
            v4u* q = (v4u*)(OA + (size_t)m * 1536 + lane * 16); q[0] = o0; q[1] = o1;
        }
        {
            const int h = lane >> 4;
            const float l0 = LSE[(size_t)m * 4 + h], l1 = LSE[(size_t)M * 4 + (size_t)m * 4 + h], l2 = LSE[(size_t)2 * M * 4 + (size_t)m * 4 + h];
            const float mx = fmaxf(l0, fmaxf(l1, l2)); float w0 = exp2f(l0 - mx), w1 = exp2f(l1 - mx), w2 = exp2f(l2 - mx); const float inv = 1.0f / (w0 + w1 + w2); w0 *= inv; w1 *= inv; w2 *= inv;
            float a[8], b[8], c[8];
            pg8::unpack8(*(const v4u*)(ODL + (size_t)m * 512 + lane * 8), a); pg8::unpack8(*(const v4u*)(ODL + (size_t)M * 512 + (size_t)m * 512 + lane * 8), b); pg8::unpack8(*(const v4u*)(ODL + (size_t)2 * M * 512 + (size_t)m * 512 + lane * 8), c);
            v4u o;
            o.x = pk2(w0 * a[0] + w1 * b[0] + w2 * c[0], w0 * a[1] + w1 * b[1] + w2 * c[1]); o.y = pk2(w0 * a[2] + w1 * b[2] + w2 * c[2], w0 * a[3] + w1 * b[3] + w2 * c[3]);
            o.z = pk2(w0 * a[4] + w1 * b[4] + w2 * c[4], w0 * a[5] + w1 * b[5] + w2 * c[5]); o.w = pk2(w0 * a[6] + w1 * b[6] + w2 * c[6], w0 * a[7] + w1 * b[7] + w2 * c[7]);
            *(v4u*)(OA + (size_t)m * 1536 + 1024 + lane * 8) = o;
        }
    }
}
__device__ __forceinline__ f32x4 bf4_to_f32(unsigned long long a) {
    f32x4 r; r.x = __uint_as_float((unsigned)a << 16); r.y = __uint_as_float((unsigned)a & 0xffff0000u); r.z = __uint_as_float((unsigned)(a >> 32) << 16); r.w = __uint_as_float((unsigned)(a >> 32) & 0xffff0000u); return r; }
__device__ __forceinline__ void p7_router(Frame& F) {
    typedef float f32x4v __attribute__((ext_vector_type(4)));
    LAS float* LG = (LAS float*)(F.lds);
    LAS float* SS = (LAS float*)(F.lds + 98304);
    LAS float* RS = (LAS float*)(F.lds + 25088);
    const float* WR = (const float*)(F.ws + WS_WR);
    int* EIDX = (int*)(F.ws + WS_ROUTE); float* EW = (float*)(F.ws + WS_ROUTE + 131072); int* POS = (int*)(F.ws + WS_ROUTE + 262144); int* LIST = (int*)(F.ws + WS_LIST); float* RSL = (float*)(F.ws + WS_RSL);
    unsigned char* XQ = (unsigned char*)(F.ws + WS_XS);
    bf16* XN2 = (bf16*)(F.ws + WS_XN); const bf16* DELTA = (const bf16*)(F.ws + WS_ODA);
    const int lane = mk_lane(), wave = F.wave, i = lane & 15, kq = lane >> 4;
    for (int it = F.vcu; it < M / 64; it += F.G) {
        const int row0 = 64 * it;
        const size_t eo = (size_t)(row0 + i) * DM + 256 * wave + 16 * kq;
        const float* xr = F.ka->in[0] + eo;
        const bf16* dr = DELTA + eo;
        const float* gp = F.ka->in[13] + 256 * wave + 16 * kq;
        unsigned char* xq = XQ + eo;
        const float* wr = WR + (size_t)(256 * wave + 16 * kq) * 48 + i;
        f32x4v a[4][3]; float ssq[4];
#pragma unroll
        for (int g4 = 0; g4 < 4; ++g4) { ssq[g4] = 0.f;
#pragma unroll
            for (int j = 0; j < 3; ++j) a[g4][j] = (f32x4v){0.f, 0.f, 0.f, 0.f}; }
        float wv[4][4][3]; f32x4 gv[4]; f32x4 xc[4]; unsigned long long dc[4];
#pragma unroll
        for (int tt = 0; tt < 4; ++tt) { xc[tt] = *(const f32x4*)(xr + 4 * tt); dc[tt] = *(const unsigned long long*)(dr + 4 * tt); gv[tt] = *(const f32x4*)(gp + 4 * tt);
#pragma unroll
            for (int c = 0; c < 4; ++c) { const float* w = wr + (size_t)(4 * tt + c) * 48; wv[tt][c][0] = w[0]; wv[tt][c][1] = w[16]; wv[tt][c][2] = w[32]; } }
#pragma unroll 1
        for (int T = 0; T < 4; ++T) {
            const int Tn = (T < 3) ? T + 1 : 3;
#pragma unroll
            for (int g4 = 0; g4 < 4; ++g4) {
                f32x4 xn[4]; unsigned long long dn[4];
                { const size_t no = (g4 < 3) ? (size_t)(16 * (g4 + 1)) * DM + 64 * T : (size_t)64 * Tn;
#pragma unroll
                  for (int tt = 0; tt < 4; ++tt) { xn[tt] = *(const f32x4*)(xr + no + 4 * tt); dn[tt] = *(const unsigned long long*)(dr + no + 4 * tt); } }
                v4u q;
#pragma unroll
                for (int tt = 0; tt < 4; ++tt) {
                    const f32x4 xv = xc[tt] + bf4_to_f32(dc[tt]); const f32x4 gs = gv[tt] * pg8::XSCALE;
                    ssq[g4] += (xv.x * xv.x + xv.y * xv.y) + (xv.z * xv.z + xv.w * xv.w);
                    q[tt] = pg8::pk_fp8x4(xv.x * gs.x, xv.y * gs.y, xv.z * gs.z, xv.w * gs.w);
#pragma unroll
                    for (int c = 0; c < 4; ++c) { const float xa = xv[c];
                        a[g4][0] = __builtin_amdgcn_mfma_f32_16x16x4f32(xa, wv[tt][c][0], a[g4][0], 0, 0, 0); a[g4][1] = __builtin_amdgcn_mfma_f32_16x16x4f32(xa, wv[tt][c][1], a[g4][1], 0, 0, 0); a[g4][2] = __builtin_amdgcn_mfma_f32_16x16x4f32(xa, wv[tt][c][2], a[g4][2], 0, 0, 0); }
                    if (g4 == 3) {
                        gv[tt] = *(const f32x4*)(gp + 64 * Tn + 4 * tt);
#pragma unroll
                        for (int c = 0; c < 4; ++c) { const float* w = wr + (size_t)(64 * Tn + 4 * tt + c) * 48; wv[tt][c][0] = w[0]; wv[tt][c][1] = w[16]; wv[tt][c][2] = w[32]; }
                    }
                }
                *(v4u*)(xq + (size_t)(16 * g4) * DM + 64 * T) = q;
#pragma unroll
                for (int tt = 0; tt < 4; ++tt) { xc[tt] = xn[tt]; dc[tt] = dn[tt]; }
            }
        }
#pragma unroll
        for (int g4 = 0; g4 < 4; ++g4) { float s = ssq[g4]; s += __shfl_xor(s, 16); s += __shfl_xor(s, 32);
#pragma unroll
            for (int reg = 0; reg < 4; ++reg) { LAS float* p = LG + (wave * 64 + 16 * g4 + 4 * kq + reg) * 48 + i; p[0] = a[g4][0][reg]; p[16] = a[g4][1][reg]; p[32] = a[g4][2][reg]; }
            if (kq == 0) SS[wave * 64 + 16 * g4 + i] = s; }
        __syncthreads();
        if ((F.wave * 64 + mk_lane()) < 64) {
            const int r = (F.wave * 64 + mk_lane());
            float sst = 0.f;
#pragma unroll
            for (int w8 = 0; w8 < 8; ++w8) sst += SS[w8 * 64 + r];
            const float rstd = 1.0f / sqrtf(sst * (1.f / DM) + EPS);
            const LAS float* l0 = LG + r * 48;
#define P7_L(c) (((l0[(c)] + l0[64 * 48 + (c)]) + (l0[2 * 64 * 48 + (c)] + l0[3 * 64 * 48 + (c)])) + ((l0[4 * 64 * 48 + (c)] + l0[5 * 64 * 48 + (c)]) + (l0[6 * 64 * 48 + (c)] + l0[7 * 64 * 48 + (c)])))
            float gl[4];
#pragma unroll
            for (int j = 0; j < 4; ++j) gl[j] = P7_L(32 + j) * rstd;
            int g = 0; float gmax = gl[0];
#pragma unroll
            for (int j = 1; j < 4; ++j) if (gl[j] > gmax) { gmax = gl[j]; g = j; }
            float gs = 0.f;
#pragma unroll
            for (int j = 0; j < 4; ++j) gs += expf(gl[j] - gmax);
            const float gw = 1.0f / gs;
            float t0 = -INFINITY, t1 = -INFINITY; int i0 = 0, i1 = 0;
#pragma unroll
            for (int j = 0; j < 8; ++j) { const float v = P7_L(8 * g + j) * rstd;
                if (v > t0) { t1 = t0; i1 = i0; t0 = v; i0 = j; } else if (v > t1) { t1 = v; i1 = j; } }
            const float e1 = expf(t1 - t0), w0 = gw / (1.0f + e1), w1 = gw * e1 / (1.0f + e1);
            const int e0i = 8 * g + i0, e1i = 8 * g + i1, row = row0 + r;
            EIDX[2 * row] = e0i; EIDX[2 * row + 1] = e1i; EW[2 * row] = w0; EW[2 * row + 1] = w1;
            if (!(MK_SPLIT_AT == 7 && F.li == 1)) {
                const int p0 = (int)atomicAdd((unsigned*)(F.ctl + CW_CNT) + e0i, 1u), p1 = (int)atomicAdd((unsigned*)(F.ctl + CW_CNT) + e1i, 1u);
                LIST[(size_t)e0i * M + p0] = row; LIST[(size_t)e1i * M + p1] = row; POS[2 * row] = p0; POS[2 * row + 1] = p1;
                RSL[(size_t)e0i * M + p0] = rstd; RSL[(size_t)e1i * M + p1] = rstd;
            }
        }
        __syncthreads();
        __syncthreads();
    }
#undef P7_L
}
__device__ __forceinline__ void build_tables(Frame& F, LAS int* PS, LAS int* CN, LAS int* TE) {
    if ((F.wave * 64 + mk_lane()) == 0) {
        int acc = 0, t = 0;
        for (int e = 0; e < NE; ++e) { PS[e] = acc; const int c = (int)__hip_atomic_load(F.ctl + CW_CNT + e, RLX_AGENT); CN[e] = c; const int nt = (c + 255) >> 8; for (int k = 0; k < nt; ++k) TE[t++] = e; acc += nt << 8; }
        PS[NE] = acc; TE[160] = t;
    }
    __syncthreads();
}
__device__ __forceinline__ void p11_combine(Frame& F) {
    const int gw = F.vcu * NWAVES + F.wave, NGW = F.G * NWAVES, lane = mk_lane();
    const float* EW = (const float*)(F.ws + WS_ROUTE + 131072); const int* POS = (const int*)(F.ws + WS_ROUTE + 262144); const int* EIDX = (const int*)(F.ws + WS_ROUTE);
    const LAS int* PS = (const LAS int*)(F.lds + XCH_OFF);
    const unsigned char* Y = (const unsigned char*)(F.ws + WS_Y8); const bf16* DELTA = (const bf16*)(F.ws + WS_ODA);
    typedef float f32x2c __attribute__((ext_vector_type(2)));
    for (int m = gw; m < M; m += NGW) {
        const int s0 = PS[EIDX[2 * m]] + POS[2 * m], s1 = PS[EIDX[2 * m + 1]] + POS[2 * m + 1]; const float w0 = EW[2 * m] * (1.0f / pg8::YSCALE), w1 = EW[2 * m + 1] * (1.0f / pg8::YSCALE);
        GAS f32x4* op = (GAS f32x4*)(F.out + (size_t)m * DM) + lane; const GAS f32x4* xp = (const GAS f32x4*)(F.ka->in[0] + (size_t)m * DM) + lane; const GAS unsigned long long* dp = (const GAS unsigned long long*)(DELTA + (size_t)m * DM) + lane;
        const GAS unsigned* y0 = (const GAS unsigned*)(Y + (size_t)s0 * DM) + lane; const GAS unsigned* y1 = (const GAS unsigned*)(Y + (size_t)s1 * DM) + lane;
#pragma unroll
        for (int j = 0; j < 8; ++j) { f32x4 v = xp[64 * j] + bf4_to_f32(dp[64 * j]); const unsigned a = y0[64 * j], b = y1[64 * j];
            const f32x2c a0 = __builtin_amdgcn_cvt_pk_f32_fp8((int)a, false), a1 = __builtin_amdgcn_cvt_pk_f32_fp8((int)a, true), b0 = __builtin_amdgcn_cvt_pk_f32_fp8((int)b, false), b1 = __builtin_amdgcn_cvt_pk_f32_fp8((int)b, true);
            v.x += w0 * a0.x + w1 * b0.x; v.y += w0 * a0.y + w1 * b0.y; v.z += w0 * a1.x + w1 * b1.x; v.w += w0 * a1.y + w1 * b1.y;
            op[64 * j] = v; }
    }
}

__global__ void __launch_bounds__(NWAVES * 64, 2) mk_fwd(Args args) {
    extern __shared__ __attribute__((aligned(16))) unsigned char lds[];
    Frame F;
    F.lds = (LAS unsigned char*)lds;
    F.MISC = (volatile LAS unsigned*)(F.lds + MISC_OFF);
    F.wave = __builtin_amdgcn_readfirstlane((int)threadIdx.x >> 6);
    F.G = gridDim.x; { const int bx = blockIdx.x; F.vcu = (F.G % 8 == 0) ? (bx % 8) * (F.G / 8) + bx / 8 : bx; }
    F.ws = args.ws; F.ctl = (gu32*)(args.ws + WS_CTL); F.out = args.out; F.li = args.li;
    F.ka = &args;
    for (int u = (F.wave * 64 + mk_lane()); u < (LDS_BYTES - LDSCTL_OFF) / 4; u += NWAVES * 64) ((LAS unsigned*)(F.lds + LDSCTL_OFF))[u] = 0u;
    __syncthreads();
    XcdBarrier bar; bar.bar = (unsigned*)(F.ctl + CW_BAR) + args.li * XCD_BAR_WORDS; bar.x = 0; bar.st = nullptr; bar.w0 = 0;
    if (MK_N_LAUNCHES == 1) bar = xcd_barrier_post((unsigned*)(F.ctl + CW_BAR) + args.li * XCD_BAR_WORDS, F.MISC + 8, F.wave == 0 ? 1u : 0u);
    const int lo = args.ph_lo, hi = args.ph_hi;
#define IN(k) (lo <= (k) && (k) < hi)
#define SEAM(k) do { if (IN(k) && IN((k) + 1)) xcd_barrier(bar); } while (0)
    bf16* XN = (bf16*)(F.ws + WS_XN); bf16* PROJ = (bf16*)(F.ws + WS_PROJ); bf16* MIX = (bf16*)(F.ws + WS_MIX);

    const bool conv_wg = (F.G == 256) && (((int)blockIdx.x >> 3) & 3) == 3; const int conv_idx = ((int)blockIdx.x & 7) * 8 + ((int)blockIdx.x >> 5);
    if (IN(0)) { p0_prologue(F, ((args.li == 1) ? args.sub : 7) & ((F.G == 256) ? 5 : 7), F.vcu * NWAVES + F.wave, F.G * NWAVES); } SEAM(0);
    if (IN(1)) {
        if (conv_wg && !(MK_SPLIT_AT == 1 && args.li == 1)) { p0_moe_weights(F, conv_idx * NWAVES + F.wave, 64 * NWAVES); __syncthreads(); }
        pg8::EpiProj E{PROJ, (const float*)(F.ws + WS_GAIN), (LAS float*)(F.lds + XCH_OFF), 0.125f * LOG2E, 0.08838834764831845f * LOG2E, EPS};
        if (F.G == 256) {
            { pg8::Gemm g{XN, (const bf16*)(F.ws + WS_WIN), M, C_GA, DM, 0};
              pg8::TicketOrder S{(unsigned*)(F.ctl + CW_TQ) + 64 * ((int)blockIdx.x & 7) + 1024 * F.li, (int)blockIdx.x & 7, 8 * 20, (volatile LAS int*)(F.MISC + 20), F.wave, 1};
              pg8::gemm_phase<pg8::EpiProj, pg8::TicketOrder, true, true>(F.wave, F.lds + RING_OFF, g, S, E); }
            { pg8::Gemm g{(const bf16*)(F.ws + WS_XN8), (const bf16*)(F.ws + WS_WIN8), M, 6656, DM / 2, 0};
              pg8::TicketOrder S{(unsigned*)(F.ctl + CW_TQ) + 512 + 64 * ((int)blockIdx.x & 7) + 1024 * F.li, (int)blockIdx.x & 7, 8 * 26, (volatile LAS int*)(F.MISC + 22), F.wave, 0};
              pg8::EpiGateSig EG{(unsigned char*)(PROJ + pg8::PJ_G), 1.0f / (pg8::XSCALE * pg8::WSCALE), PROJ};
              pg8::gemm_phase<pg8::EpiGateSig, pg8::TicketOrder, true, true, false, true>(F.wave, F.lds + RING_OFF, g, S, EG); }
        } else {
            pg8::Gemm g{XN, (const bf16*)(F.ws + WS_WIN), M, C_GA, DM, 0}; pg8::SkipOrder S0; S0.base.init(M, 20 * 256, F.G, (int)blockIdx.x); pg8::gemm_phase<pg8::EpiProj, pg8::SkipOrder, true, true>(F.wave, F.lds + RING_OFF, g, S0, E);
            pg8::Gemm g2{(const bf16*)(F.ws + WS_XN8), (const bf16*)(F.ws + WS_WIN8), M, 6656, DM / 2, 0}; pg8::StaticOrder S1; S1.init(M, 6656, F.G, (int)blockIdx.x);
            pg8::EpiGateSig EG{(unsigned char*)(PROJ + pg8::PJ_G), 1.0f / (pg8::XSCALE * pg8::WSCALE), PROJ}; pg8::gemm_phase<pg8::EpiGateSig, pg8::StaticOrder, true, true, false, true>(F.wave, F.lds + RING_OFF, g2, S1, EG);
        }
    } SEAM(1);
    if (IN(2)) { p2_attention(F, (args.li == 1 && lo == 2) ? args.sub : 3); } SEAM(2);
    if (IN(3)) { p3_merge(F); } SEAM(3);
    if (IN(4)) {
        pg8::Gemm g{(const bf16*)(F.ws + WS_OA), (const bf16*)(F.ws + WS_WA), M, DM, 1536, 0}; pg8::MixOrder S; S.base.init(M, DM, F.G, (int)blockIdx.x);
        pg8::EpiMix E{MIX, DM, (const unsigned char*)(PROJ + pg8::PJ_G)};
        pg8::gemm_phase<pg8::EpiMix, pg8::MixOrder, true, true>(F.wave, F.lds + RING_OFF, g, S, E);
    }
    if (IN(4) && IN(6)) xcd_barrier(bar);
    if (IN(6)) {
        pg8::Gemm g{MIX, (const bf16*)(F.ws + WS_WO), M, DM, DM, 0}; pg8::StaticOrder S; S.init(M, DM, F.G, (int)blockIdx.x);
        pg8::EpiPlain E{(bf16*)(F.ws + WS_ODA), DM, 1.0f};
        pg8::gemm_phase<pg8::EpiPlain, pg8::StaticOrder, true, true>(F.wave, F.lds + RING_OFF, g, S, E);
    } SEAM(6);
    if (IN(7)) { p7_router(F); }
    if (IN(7) && (IN(8) || IN(9))) xcd_barrier(bar);
    LAS int* TE = (LAS int*)(F.lds + TILE_E_OFF); LAS int* PS = (LAS int*)(F.lds + XCH_OFF); LAS int* CN = (LAS int*)(F.lds + XCH_OFF + 256);
    if (hi > 8 && lo <= 11) build_tables(F, PS, CN, TE);
    if (IN(9)) {
        pg8::Gemm g{(const bf16*)(F.ws + WS_XS), (const bf16*)(F.ws + WS_WGU), M, 2048, DM / 2, (size_t)2048 * DM};
        pg8::GroupOrder S{TE[160], F.G, (int)blockIdx.x, TE, PS, CN, (const int*)(F.ws + WS_LIST), M};
        pg8::EpiSwiglu E{(unsigned char*)(F.ws + WS_HB), DFF, 1.0f / (pg8::XSCALE * pg8::WSCALE), (const float*)(F.ws + WS_RSL), PS, M};
        pg8::gemm_phase<pg8::EpiSwiglu, pg8::GroupOrder, true, true, true, true>(F.wave, F.lds + RING_OFF, g, S, E);
    } SEAM(9);
    if (IN(10)) {
        pg8::Gemm g{(const bf16*)(F.ws + WS_HB), (const bf16*)(F.ws + WS_WD), XS_ROWS, DM, DFF / 2, (size_t)DM * DFF};
        pg8::GroupOrder S{TE[160], F.G, (int)blockIdx.x, TE, PS, CN, (const int*)(F.ws + WS_LIST), M};
        pg8::EpiFp8 E{(unsigned char*)(F.ws + WS_Y8), DM, pg8::YSCALE / (pg8::HSCALE * pg8::WSCALE)};
        pg8::gemm_phase<pg8::EpiFp8, pg8::GroupOrder, true, true, false, true>(F.wave, F.lds + RING_OFF, g, S, E);
    } SEAM(10);
    if (IN(11)) { p11_combine(F); }
#undef IN
#undef SEAM
}

extern "C" void kernel_launch(void* const* d_in, const int* in_sizes, int n_in, void* d_out, int out_size, void* d_ws, size_t ws_size, hipStream_t stream) {
    static int grid = 0;
    if (grid == 0) {
        if (n_in != 18 || out_size != M * DM || ws_size < WS_END) { fprintf(stderr, "kernel_launch: unexpected problem shape or workspace (%d inputs, out %d, ws %zu < %zu)\n", n_in, out_size, ws_size, (size_t)WS_END); grid = -1; return; }
        int dev = 0, cus = 0, per_cu = 0;
        if (hipGetDevice(&dev) != hipSuccess || hipDeviceGetAttribute(&cus, hipDeviceAttributeMultiprocessorCount, dev) != hipSuccess) { grid = -1; return; }
        if (hipFuncSetAttribute((const void*)mk_fwd, hipFuncAttributeMaxDynamicSharedMemorySize, LDS_BYTES) != hipSuccess) { fprintf(stderr, "kernel_launch: hipFuncSetAttribute failed\n"); grid = -1; return; }
        if (hipOccupancyMaxActiveBlocksPerMultiprocessor(&per_cu, (const void*)mk_fwd, NWAVES * 64, LDS_BYTES) != hipSuccess || per_cu < 1) { fprintf(stderr, "kernel_launch: occupancy query says %d blocks per CU\n", per_cu); (void)hipGetLastError(); grid = -1; return; }
        grid = cus;
        if (grid != 256) fprintf(stderr, "kernel_launch: %d CUs (tuned for 256)\n", grid);
    }
    if (grid < 0) return;
    (void)hipMemsetAsync((char*)d_ws + WS_CTL, 0, CTL_ZERO_BYTES, stream);
    Args a{};
    for (int i = 0; i < 18; ++i) a.in[i] = (const float*)d_in[i];
    a.out = (float*)d_out; a.ws = (unsigned char*)d_ws;
    if (MK_N_LAUNCHES == 1) {
        if (MK_SPLIT_AT >= 0) {
            a.ph_lo = 0; a.ph_hi = MK_SPLIT_AT + 1 + (MK_SPLIT_AT == 4 ? 1 : 0); a.li = 0; a.sub = 3;
            hipLaunchKernelGGL(mk_fwd, dim3(grid), dim3(NWAVES * 64), LDS_BYTES, stream, a);
            a.ph_lo = MK_SPLIT_AT; a.ph_hi = N_PHASES; a.li = 1; a.sub = MK_REPEAT_SUB;
            hipLaunchKernelGGL(mk_fwd, dim3(grid), dim3(NWAVES * 64), LDS_BYTES, stream, a);
            return;
        }
        a.ph_lo = 0; a.ph_hi = N_PHASES; a.li = 0; a.sub = 3;
        hipLaunchKernelGGL(mk_fwd, dim3(grid), dim3(NWAVES * 64), LDS_BYTES, stream, a);
    } else {
        for (int p = 0; p < N_PHASES; ++p) {
            if (p == 5) continue;
            a.ph_lo = p; a.ph_hi = (p == 4) ? 6 : p + 1; a.li = 0; a.sub = 3;
            hipLaunchKernelGGL(mk_fwd, dim3(grid), dim3(NWAVES * 64), LDS_BYTES, stream, a);
        }
    }
}
```

```cpp
#include <hip/hip_runtime.h>
#include <cstdio>
#include <cstdint>
#ifndef MK_EPI2
#define MK_EPI2 0
#endif
#ifndef MK_DBG
#define MK_DBG 0
#endif
#ifndef MK_DBG_GEMM
#define MK_DBG_GEMM 0
#endif
__device__ __forceinline__ int mk_lane() { int l; asm volatile("v_mbcnt_lo_u32_b32 %0, -1, 0\n\tv_mbcnt_hi_u32_b32 %0, -1, %0" : "=v"(l)); return l; }
namespace pg8 {
#define PG8_LAS __attribute__((address_space(3)))
typedef unsigned short bf16_t;
typedef short bf16x8 __attribute__((ext_vector_type(8)));
typedef float f32x4 __attribute__((ext_vector_type(4)));
typedef unsigned u32x4 __attribute__((ext_vector_type(4)));
typedef int i32x8 __attribute__((ext_vector_type(8)));
constexpr int BM = 256, BK = 64, HALF = 128, HTB = HALF * BK * 2  , STAGE_BYTES = 8 * HTB, NXCD = 8, WGM = 8;

__host__ __device__ __forceinline__ int lds_byte(int r, int c) { const int st = (r >> 4) * 2 + (c >> 5), rr = r & 15, cc = c & 31, ob = rr * 64 + cc * 2; return st * 1024 + (ob ^ (((ob >> 9) & 1) << 5)); }
__host__ __device__ __forceinline__ void stage_rc(int b, int& R, int& C) { const int st = b / 1024, sb = b % 1024, swz = sb ^ (((sb >> 9) & 1) << 5); R = (st >> 1) * 16 + swz / 64; C = (st & 1) * 32 + (swz % 64) / 2; }
__host__ __device__ __forceinline__ int perm32(int rho) { const int n = rho >> 4, i = rho & 15; return 8 * (i >> 2) + 4 * n + (i & 3); }

struct Unit { int pm, pn, e, nt, kofs, keep; };
struct Gemm { const bf16_t* A; const bf16_t* Bt; int M, N, K; size_t estride; };

struct StaticOrder {
    int nM, nN, nwg, G, c;
    __host__ __device__ void init(int M, int N, int G_, int c_) { nM = M / BM; nN = N / BM; nwg = nM * nN; G = G_; c = c_; }
    __host__ __device__ bool next(int i, Unit& u) const {
        const long L = (long)i * G + c; if (L >= nwg) return false;
        int wgid = (int)L; { const int q = nwg / NXCD, r = nwg % NXCD, xcd = wgid % NXCD, off = wgid / NXCD; wgid = (xcd < r ? xcd * (q + 1) : r * (q + 1) + (xcd - r) * q) + off; }
        const int nig = WGM * nN, gid = wgid / nig, fm = gid * WGM, gsz = (nM - fm) < WGM ? (nM - fm) : WGM;
        u.pm = fm + ((wgid % nig) % gsz); u.pn = (wgid % nig) / gsz; u.e = 0; u.nt = 0; u.kofs = 0; u.keep = 0; return true;
    }
    __device__ __forceinline__ int arow(const Unit&, int R) const { return R; }
    __device__ __forceinline__ void a_ready(const Unit&) const {}
    __device__ __forceinline__ void done(const Unit&) const {}
};

typedef float f32x2_c __attribute__((ext_vector_type(2))); typedef __bf16 bf16x2_c __attribute__((ext_vector_type(2)));
__device__ __forceinline__ unsigned cvt_pk_bf16(float lo, float hi) { f32x2_c v = {lo, hi}; bf16x2_c b = __builtin_convertvector(v, bf16x2_c); return __builtin_bit_cast(unsigned, b); }
__device__ __forceinline__ float bf2f(unsigned short b) { return __uint_as_float((unsigned)b << 16); }
__device__ __forceinline__ void unpack8(const u32x4 w, float (&f)[8]) {
    f[0] = __uint_as_float(w.x << 16); f[1] = __uint_as_float(w.x & 0xffff0000u); f[2] = __uint_as_float(w.y << 16); f[3] = __uint_as_float(w.y & 0xffff0000u);
    f[4] = __uint_as_float(w.z << 16); f[5] = __uint_as_float(w.z & 0xffff0000u); f[6] = __uint_as_float(w.w << 16); f[7] = __uint_as_float(w.w & 0xffff0000u);
}
__device__ __forceinline__ u32x4 pack8(const f32x4 v0, const f32x4 v1) { u32x4 w; w.x = cvt_pk_bf16(v0[0], v0[1]); w.y = cvt_pk_bf16(v0[2], v0[3]); w.z = cvt_pk_bf16(v1[0], v1[1]); w.w = cvt_pk_bf16(v1[2], v1[3]); return w; }

constexpr size_t PJ_QA = 0, PJ_KA = (size_t)16384 * 1024, PJ_VA = (size_t)16384 * 2048, PJ_QL = (size_t)16384 * 3072, PJ_KL = (size_t)16384 * 4608, PJ_VL = (size_t)16384 * 6144, PJ_G = (size_t)16384 * 7680;
struct EpiProj {
    static constexpr bool PERM = true, AFTER_DRAIN = false, IDEM = true; static constexpr int MIDT = 0;
    bf16_t* O;
    const float* gains;
    PG8_LAS float* xch;
    float c2_da, c2_dl, eps;
    __device__ __forceinline__ void operator()(const f32x4 (&acc)[2][2][4][2], const Unit& u, int wr, int wc, int fr, int fq) const {
        constexpr int S = 8192;
        const int pn = u.pn;
        const int kind = (pn < 8) ? 1 : (pn < 12) ? 0 : (pn < 24) ? 2 : (pn < 30) ? 0 : 3;
        const int rowl0 = wr * 64 + fr;
        const int b = u.pm >> 5, t0 = (u.pm & 31) * BM + rowl0;
        size_t hb0; int hstep, pitch, dil = 1;
        if (pn < 8) {
            const int pq = pn & 3; pitch = 64; hstep = 2 * S * 64;
            hb0 = (pn < 4 ? PJ_QA : PJ_KA) + ((size_t)((b * 8 + 2 * pq) * 2 + (wc >> 1)) * S) * 64 + (wc & 1) * 32 + 8 * fq;
        } else if (pn < 12) {
            const int pq = pn - 8; pitch = 128; hstep = S * 128;
            hb0 = PJ_VA + ((size_t)(b * 8 + 2 * pq) * S) * 128 + wc * 32 + 8 * fq;
        } else if (pn < 30) {
            const int sec = (pn - 12) / 6, pq = (pn - 12) % 6; pitch = 128; hstep = S * 128; dil = (pq < 2) ? 1 : (pq < 4) ? 4 : 16;
            hb0 = (sec == 0 ? PJ_QL : sec == 1 ? PJ_KL : PJ_VL) + ((size_t)(b * 12 + 2 * pq) * S) * 128 + wc * 32 + 8 * fq;
        } else {
            pitch = 4096; hstep = HALF;
            hb0 = PJ_G + ((size_t)b * S) * 4096 + (pn - 30) * BM + wc * 32 + 8 * fq;
        }
        bf16_t* const hb = O + hb0;
        const int lsh = (dil == 1) ? 0 : (dil == 4) ? 2 : 4;
        if (kind == 1 || kind == 2) {
#pragma unroll
            for (int ai = 0; ai < 2; ++ai)
#pragma unroll
                for (int m = 0; m < 4; ++m)
#pragma unroll
                    for (int bj = 0; bj < 2; ++bj) {
                        const f32x4 a = acc[ai][bj][m][0], bq = acc[ai][bj][m][1];
                        float s = (a[0] * a[0] + a[1] * a[1]) + (a[2] * a[2] + a[3] * a[3]) + (bq[0] * bq[0] + bq[1] * bq[1]) + (bq[2] * bq[2] + bq[3] * bq[3]);
                        s += __shfl_xor(s, 16); s += __shfl_xor(s, 32);
                        if (fq == 0) xch[(ai * HALF + rowl0 + m * 16) * 8 + bj * 4 + wc] = s;
                    }
            asm volatile("s_waitcnt lgkmcnt(0)" ::: "memory"); __builtin_amdgcn_s_barrier(); asm volatile("" ::: "memory");
            const bool isq = (pn < 4) || (pn >= 12 && pn < 18);
            const int goff = (kind == 1) ? ((isq ? 0 : 64) + (wc & 1) * 32 + 8 * fq) : ((isq ? 128 : 256) + wc * 32 + 8 * fq);
            const float* gp = gains + goff;
            const f32x4 g0 = *(const f32x4*)gp, g1 = *(const f32x4*)(gp + 4);
            const float sc = isq ? (kind == 1 ? c2_da : c2_dl) : 1.0f;
            const float inv = (kind == 1) ? (1.0f / 64.0f) : (1.0f / 128.0f);
#pragma unroll
            for (int ai = 0; ai < 2; ++ai)
#pragma unroll
                for (int m = 0; m < 4; ++m) {
                    const PG8_LAS f32x4* xr = (const PG8_LAS f32x4*)(xch + (ai * HALF + rowl0 + m * 16) * 8);
                    const int t = t0 + ai * HALF + m * 16; const size_t ro = (size_t)(((t & (dil - 1)) * (S >> lsh)) + (t >> lsh)) * pitch;
#pragma unroll
                    for (int bj = 0; bj < 2; ++bj) {
                        const f32x4 tt = xr[bj];
                        const float tot = (kind == 1) ? ((wc < 2) ? (tt[0] + tt[1]) : (tt[2] + tt[3])) : ((tt[0] + tt[1]) + (tt[2] + tt[3]));
                        const float rs = __builtin_amdgcn_rsqf(tot * inv + eps) * sc;
                        const f32x4 v0 = acc[ai][bj][m][0] * rs * g0, v1 = acc[ai][bj][m][1] * rs * g1;
                        *(u32x4*)(hb + ro + (size_t)bj * hstep) = pack8(v0, v1);
                    }
                }
        } else {
#pragma unroll
            for (int ai = 0; ai < 2; ++ai)
#pragma unroll
                for (int m = 0; m < 4; ++m) {
                    const int t = t0 + ai * HALF + m * 16; const size_t ro = (size_t)(((t & (dil - 1)) * (S >> lsh)) + (t >> lsh)) * pitch;
#pragma unroll
                    for (int bj = 0; bj < 2; ++bj) {
                        f32x4 v0 = acc[ai][bj][m][0], v1 = acc[ai][bj][m][1];
                        if (kind == 3) {
#pragma unroll
                            for (int j = 0; j < 4; ++j) { v0[j] = __builtin_amdgcn_rcpf(1.0f + __builtin_amdgcn_exp2f(-1.4426950408889634f * v0[j])); v1[j] = __builtin_amdgcn_rcpf(1.0f + __builtin_amdgcn_exp2f(-1.4426950408889634f * v1[j])); }
                        }
                        *(u32x4*)(hb + ro + (size_t)bj * hstep) = pack8(v0, v1);
                    }
                }
        }
    }
};

struct EpiGateSig {
    static constexpr bool PERM = true, AFTER_DRAIN = false, IDEM = true; static constexpr int MIDT = 0;
    unsigned char* G; float ascale; bf16_t* O;
    __device__ __forceinline__ void operator()(const f32x4 (&acc)[2][2][4][2], const Unit& u, int wr, int wc, int fr, int fq) const {
        constexpr int S = 8192;
        const bool gate = u.pn < 16;
        const int pv = u.pn - 16, b = u.pm >> 5, t0 = (u.pm & 31) * BM + wr * 64 + fr;
        const bool da = pv < 4; const int pq = da ? pv : pv - 4, dil = (gate || da || pq < 2) ? 1 : (pq < 4) ? 4 : 16, lsh = (dil == 1) ? 0 : (dil == 4) ? 2 : 4;
        const size_t ubase = gate ? (size_t)(u.pm * BM) * 4096 + 2 * ((u.pn & 7) * BM) + ((u.pn >> 3) << 3) : 2 * (da ? PJ_VA + ((size_t)(b * 8 + 2 * pq) * S) * 128 : PJ_VL + ((size_t)(b * 12 + 2 * pq) * S) * 128);
        unsigned char* const base = (gate ? G : (unsigned char*)O) + ubase + (gate ? (unsigned)(wr * 64 + fr) * 4096u : 0u) + 2 * (wc * 32 + 8 * fq);
        const unsigned pitch = gate ? 4096u : 256u, bjs = gate ? (unsigned)(2 * HALF) : (unsigned)(S * 256);
        const float ns = gate ? -1.4426950408889634f * ascale : ascale;
        typedef unsigned u32x2 __attribute__((ext_vector_type(2)));
#pragma unroll
        for (int ai = 0; ai < 2; ++ai)
#pragma unroll
            for (int m = 0; m < 4; ++m) {
                const int t = gate ? ai * HALF + m * 16 : t0 + ai * HALF + m * 16; const unsigned ro = (unsigned)(((t & (dil - 1)) * (S >> lsh)) + (t >> lsh)) * pitch;
#pragma unroll
                for (int bj = 0; bj < 2; ++bj) {
                    f32x4 v0 = acc[ai][bj][m][0] * ns, v1 = acc[ai][bj][m][1] * ns;
                    if (gate) {
#pragma unroll
                        for (int j = 0; j < 4; ++j) { v0[j] = fmaxf(255.0f * __builtin_amdgcn_rcpf(1.0f + __builtin_amdgcn_exp2f(v0[j])), 1.0f); v1[j] = fmaxf(255.0f * __builtin_amdgcn_rcpf(1.0f + __builtin_amdgcn_exp2f(v1[j])), 1.0f); }
                        unsigned lo = 0, hi = 0;
                        lo = __builtin_amdgcn_cvt_pk_u8_f32(v0[0], 0, lo); lo = __builtin_amdgcn_cvt_pk_u8_f32(v0[1], 1, lo); lo = __builtin_amdgcn_cvt_pk_u8_f32(v0[2], 2, lo); lo = __builtin_amdgcn_cvt_pk_u8_f32(v0[3], 3, lo);
                        hi = __builtin_amdgcn_cvt_pk_u8_f32(v1[0], 0, hi); hi = __builtin_amdgcn_cvt_pk_u8_f32(v1[1], 1, hi); hi = __builtin_amdgcn_cvt_pk_u8_f32(v1[2], 2, hi); hi = __builtin_amdgcn_cvt_pk_u8_f32(v1[3], 3, hi);
                        *(u32x2*)(base + ro + bj * bjs) = (u32x2){lo, hi};
                    } else *(u32x4*)(base + ro + bj * bjs) = pack8(v0, v1);
                }
            }
    }
};

struct EpiMix {
    static constexpr bool PERM = true, AFTER_DRAIN = false, IDEM = false; static constexpr int MIDT = 0;
    bf16_t* MIX; int ldm; const unsigned char* G;
    __device__ __forceinline__ void operator()(f32x4 (&acc)[2][2][4][2], const Unit& u, int wr, int wc, int fr, int fq) const {
        const int row0 = u.pm * BM + wr * 64 + fr, col0 = u.pn * BM + wc * 32 + 8 * fq;
        const unsigned char* const gp = G + (size_t)row0 * 4096 + 2 * col0;
#define PG8_UB(w, k) ((float)(((w) >> (8 * (k))) & 0xffu))
        if (!u.keep) {
#pragma unroll
            for (int ai = 0; ai < 2; ++ai)
#pragma unroll
                for (int m = 0; m < 4; ++m) {
#pragma unroll
                    for (int bj = 0; bj < 2; ++bj) {
                        const u32x4 g = *(const u32x4*)(gp + (size_t)(ai * HALF + m * 16) * 4096 + 2 * bj * HALF);
#pragma unroll
                        for (int j = 0; j < 4; ++j) { acc[ai][bj][m][0][j] *= PG8_UB(g.x, j) * __builtin_amdgcn_rcpf(PG8_UB(g.z, j)); acc[ai][bj][m][1][j] *= PG8_UB(g.y, j) * __builtin_amdgcn_rcpf(PG8_UB(g.w, j)); }
                    }
                    if (m & 1) asm volatile("" ::: "memory");
                }
        } else {
#pragma unroll
            for (int ai = 0; ai < 2; ++ai)
#pragma unroll
                for (int m = 0; m < 4; ++m) {
                    const size_t r = (size_t)(row0 + ai * HALF + m * 16);
#pragma unroll
                    for (int bj = 0; bj < 2; ++bj) {
                        typedef unsigned u32x2 __attribute__((ext_vector_type(2)));
                        const u32x2 g = *(const u32x2*)(gp + (size_t)(ai * HALF + m * 16) * 4096 + 2 * bj * HALF + 8);
                        f32x4 v0 = acc[ai][bj][m][0], v1 = acc[ai][bj][m][1];
#pragma unroll
                        for (int j = 0; j < 4; ++j) { v0[j] *= PG8_UB(g.x, j) * (1.0f / 255.0f); v1[j] *= PG8_UB(g.y, j) * (1.0f / 255.0f); }
                        *(u32x4*)(MIX + r * ldm + col0 + bj * HALF) = pack8(v0, v1);
                    }
                }
        }
#undef PG8_UB
    }
};
struct MixOrder {
    StaticOrder base;
    __device__ __forceinline__ bool next(int i, Unit& u) const { if (!base.next(i >> 1, u)) return false; const int part = i & 1; u.nt = part ? 8 : 16; u.kofs = part ? 2048 : 0; u.keep = part; return true; }
    __device__ __forceinline__ int arow(const Unit&, int R) const { return R; }
    __device__ __forceinline__ void a_ready(const Unit&) const {}
    __device__ __forceinline__ void done(const Unit&) const {}
};

struct EpiRes {
    static constexpr bool PERM = false, AFTER_DRAIN = false, IDEM = true; static constexpr int MIDT = 0;
    const float* X; float* Out; int ldc;
    __device__ __forceinline__ void operator()(const f32x4 (&acc)[2][2][4][2], const Unit& u, int wr, int wc, int fr, int fq) const {
        const int row0 = u.pm * BM + wr * 64 + fr, col0 = u.pn * BM + wc * 32 + 4 * fq;
#pragma unroll
        for (int ai = 0; ai < 2; ++ai)
#pragma unroll
            for (int m = 0; m < 4; ++m) {
                const size_t off = (size_t)(row0 + ai * HALF + m * 16) * ldc + col0;
#pragma unroll
                for (int bj = 0; bj < 2; ++bj)
#pragma unroll
                    for (int n = 0; n < 2; ++n) { const f32x4 xv = *(const f32x4*)(X + off + bj * HALF + n * 16); *(f32x4*)(Out + off + bj * HALF + n * 16) = xv + acc[ai][bj][m][n]; }
            }
    }
};

constexpr float HSCALE = 4.0f, WSCALE = 64.0f, XSCALE = 8.0f;
__device__ __forceinline__ unsigned pk_fp8x4(float a, float b, float c, float d) {
    a = fminf(fmaxf(a, -448.f), 448.f); b = fminf(fmaxf(b, -448.f), 448.f); c = fminf(fmaxf(c, -448.f), 448.f); d = fminf(fmaxf(d, -448.f), 448.f);
    int p = __builtin_amdgcn_cvt_pk_fp8_f32(a, b, 0, false); p = __builtin_amdgcn_cvt_pk_fp8_f32(c, d, p, true); return (unsigned)p; }
__device__ __forceinline__ unsigned pk_fp8x4_nc(float a, float b, float c, float d) { int p = __builtin_amdgcn_cvt_pk_fp8_f32(a, b, 0, false); p = __builtin_amdgcn_cvt_pk_fp8_f32(c, d, p, true); return (unsigned)p; }
struct EpiSwiglu {
    static constexpr bool PERM = true, AFTER_DRAIN = false, IDEM = true; static constexpr int MIDT = 0;
    unsigned char* H; int ldh; float ascale;
    const float* rsl; const PG8_LAS int* ps; int lcap;
    __device__ __forceinline__ void operator()(const f32x4 (&acc)[2][2][4][2], const Unit& u, int wr, int wc, int fr, int fq) const {
        const int row0 = u.pm * BM + wr * 64 + fr, col0 = u.pn * HALF + wc * 32 + 8 * fq;
        const float* rb = rsl + (size_t)u.e * lcap + (row0 - ps[u.e]);
#pragma unroll
        for (int ai = 0; ai < 2; ++ai)
#pragma unroll
            for (int m = 0; m < 4; ++m) {
                float v[8]; const float rs = rb[ai * HALF + m * 16] * ascale;
#pragma unroll
                for (int n = 0; n < 2; ++n)
#pragma unroll
                    for (int j = 0; j < 4; ++j) { const float gt = acc[ai][0][m][n][j] * rs, up = acc[ai][1][m][n][j] * rs; v[4 * n + j] = gt * __builtin_amdgcn_rcpf(1.0f + __builtin_amdgcn_exp2f(-1.4426950408889634f * gt)) * up * HSCALE; }
                typedef unsigned u32x2 __attribute__((ext_vector_type(2)));
                *(u32x2*)(H + (size_t)(row0 + ai * HALF + m * 16) * ldh + col0) = (u32x2){pk_fp8x4_nc(v[0], v[1], v[2], v[3]), pk_fp8x4_nc(v[4], v[5], v[6], v[7])};
            }
    }
};

constexpr float YSCALE = 16.0f;
struct EpiFp8 {
    static constexpr bool PERM = true, AFTER_DRAIN = false, IDEM = true; static constexpr int MIDT = 0;
    unsigned char* O; int ldc; float scale;
    __device__ __forceinline__ void operator()(const f32x4 (&acc)[2][2][4][2], const Unit& u, int wr, int wc, int fr, int fq) const {
        const int row0 = u.pm * BM + wr * 64 + fr, col0 = u.pn * BM + wc * 32 + 8 * fq;
        typedef unsigned u32x2 __attribute__((ext_vector_type(2)));
#pragma unroll
        for (int ai = 0; ai < 2; ++ai)
#pragma unroll
            for (int m = 0; m < 4; ++m)
#pragma unroll
                for (int bj = 0; bj < 2; ++bj) { const f32x4 a = acc[ai][bj][m][0] * scale, b = acc[ai][bj][m][1] * scale;
                    *(u32x2*)(O + (size_t)(row0 + ai * HALF + m * 16) * ldc + col0 + bj * HALF) = (u32x2){pk_fp8x4_nc(a[0], a[1], a[2], a[3]), pk_fp8x4_nc(b[0], b[1], b[2], b[3])}; }
    }
};
struct EpiPlain {
    static constexpr bool PERM = true, AFTER_DRAIN = false, IDEM = true; static constexpr int MIDT = 0;
    bf16_t* O; int ldc; float scale;
    __device__ __forceinline__ void operator()(const f32x4 (&acc)[2][2][4][2], const Unit& u, int wr, int wc, int fr, int fq) const {
        const int row0 = u.pm * BM + wr * 64 + fr, col0 = u.pn * BM + wc * 32 + 8 * fq;
#pragma unroll
        for (int ai = 0; ai < 2; ++ai)
#pragma unroll
            for (int m = 0; m < 4; ++m)
#pragma unroll
                for (int bj = 0; bj < 2; ++bj) *(u32x4*)(O + (size_t)(row0 + ai * HALF + m * 16) * ldc + col0 + bj * HALF) = pack8(acc[ai][bj][m][0] * scale, acc[ai][bj][m][1] * scale);
    }
};

struct TicketOrder {
    unsigned* q; int xcd, per; volatile PG8_LAS int* tick; int wave; int skipv;
    __device__ __forceinline__ bool next(int i, Unit& u) const {
        const bool t0 = (wave == 0) && (mk_lane() == 0);
        if (i == 0) { if (t0) { tick[0] = (int)atomicAdd(q, 1u); tick[1] = (int)atomicAdd(q, 1u); } __syncthreads(); }
        else if (t0) tick[(i + 1) & 1] = (int)atomicAdd(q, 1u);
        const int tk = __builtin_amdgcn_readfirstlane(tick[i & 1]);
        if (tk >= per) return false;
        u.pm = 8 * xcd + (tk & 7); u.pn = tk >> 3; if (skipv && u.pn >= 8) u.pn += 4; u.e = 0; u.nt = 0; u.kofs = 0; u.keep = 0; return true;
    }
    __device__ __forceinline__ int arow(const Unit&, int R) const { return R; }
    __device__ __forceinline__ void a_ready(const Unit&) const {}
    __device__ __forceinline__ void done(const Unit&) const {}
};

struct SkipOrder { StaticOrder base;
    __device__ __forceinline__ bool next(int i, Unit& u) const { if (!base.next(i, u)) return false; if (u.pn >= 8) u.pn += 4; return true; }
    __device__ __forceinline__ int arow(const Unit&, int R) const { return R; }
    __device__ __forceinline__ void a_ready(const Unit&) const {}
    __device__ __forceinline__ void done(const Unit&) const {}
};
struct OffOrder { StaticOrder base; int off;
    __device__ __forceinline__ bool next(int i, Unit& u) const { if (!base.next(i, u)) return false; u.pn += off; return true; }
    __device__ __forceinline__ int arow(const Unit&, int R) const { return R; }
    __device__ __forceinline__ void a_ready(const Unit&) const {}
    __device__ __forceinline__ void done(const Unit&) const {}
};
struct GroupOrder {
    int nT, G, c; const PG8_LAS int* tile_e; const PG8_LAS int* ps; const PG8_LAS int* cn; const int* list; int lcap;
    __device__ __forceinline__ bool next(int i, Unit& u) const {
        const int L = i * G + c; if (L >= nT * 8) return false;
        const int wgid = (L & 7) * nT + (L >> 3);
        u.pm = wgid >> 3; u.pn = wgid & 7; u.e = __builtin_amdgcn_readfirstlane(tile_e[u.pm]); u.nt = 0; u.kofs = 0; u.keep = 0; return true;
    }
    __device__ __forceinline__ int arow(const Unit& u, int R) const { const int lr = u.pm * BM - ps[u.e] + R; return (lr < cn[u.e]) ? list[(size_t)u.e * lcap + lr] : 0; }
    __device__ __forceinline__ void a_ready(const Unit&) const {}
    __device__ __forceinline__ void done(const Unit&) const {}
};
template <class Epi, class Sched, bool ALIGN_EPI = false, bool SP2 = false, bool GATHER = false, bool MX = false>
__device__ __forceinline__ void gemm_phase(const int wv  , PG8_LAS unsigned char* lds, const Gemm g, const Sched& S, const Epi& E, unsigned* dbg_out = nullptr) {
    const int lane = mk_lane(), wid = wv, tid = wid * 64 + lane, wr = wid >> 2, wc = wid & 3, fr = lane & 15, fq = lane >> 4;
    const int K = g.K, nt_all = K / BK;
    unsigned voffA[2], voffB[2];
#pragma unroll
    for (int i = 0; i < 2; ++i) { int R, C; stage_rc(tid * 16 + i * 8192, R, C); const int Rb = Epi::PERM ? ((R & ~31) + perm32(R & 31)) : R;
        voffA[i] = (unsigned)(R * K + C) * 2u; voffB[i] = (unsigned)(Rb * K + C) * 2u; }
    static_assert(!GATHER || SP2, "GATHER needs the SP2 loop");
    unsigned vc0[2], vc1[2];
#define PG8_V(arr) (GATHER ? (arr) : voffA)
#define PG8_GOFF(dst0, dst1, uu) do { _Pragma("unroll") for (int i_ = 0; i_ < 2; ++i_) { int R_, C_; stage_rc(tid * 16 + i_ * 8192, R_, C_); \
        dst0[i_] = (unsigned)(S.arow(uu, R_) * K + C_) * 2u; dst1[i_] = (unsigned)(S.arow(uu, R_ + HALF) * K + C_) * 2u; } } while (0)
    const size_t kstep = (size_t)(BK * 2);
    const size_t hstep = (size_t)HALF * K * 2;
    const size_t tstep = 2 * hstep;
    const size_t hstepA = GATHER ? (size_t)0 : hstep;
    const unsigned ldsw = (unsigned)wid * 1024u; const unsigned lds0 = (unsigned)(uintptr_t)lds;
    const int aoff = lds_byte(wr * 64 + fr, fq * 8), boff = lds_byte(wc * 32 + fr, fq * 8);
#define PG8_SA(b, h) (((b) * 2 + (h)) * HTB)
#define PG8_SB(b, h) ((4 + (b) * 2 + (h)) * HTB)
#define PG8_STAGE(bufoff, gbase, voff) do { const char* sb_ = (const char*)(gbase);       \
        _Pragma("unroll") for (int _i = 0; _i < 2; ++_i) { unsigned keep_; const unsigned ld_ = lds0 + (unsigned)(bufoff) + ldsw + (unsigned)_i * 8192u; \
            asm volatile("s_mov_b32 %0, m0\n\ts_mov_b32 m0, %3\n\ts_nop 2\n\tglobal_load_lds_dwordx4 %1, %2\n\ts_mov_b32 m0, %0" : "=&s"(keep_) : "v"((voff)[_i]), "s"(sb_), "s"(ld_) : "memory"); } } while (0)
#define PG8_LDA(dst, b, h) do { unsigned ab_ = (unsigned)(PG8_SA(b, h) + aoff); asm volatile("" : "+v"(ab_));   \
        _Pragma("unroll") for (int m = 0; m < 4; ++m) _Pragma("unroll") for (int k = 0; k < 2; ++k) dst[m][k] = *(const PG8_LAS bf16x8*)(lds + ab_ + m * 2048 + k * 1024); } while (0)
#define PG8_LDB(dst, b, h) do { unsigned bb_ = (unsigned)(PG8_SB(b, h) + boff); asm volatile("" : "+v"(bb_)); \
        _Pragma("unroll") for (int n = 0; n < 2; ++n) _Pragma("unroll") for (int k = 0; k < 2; ++k) dst[n][k] = *(const PG8_LAS bf16x8*)(lds + bb_ + n * 2048 + k * 1024); } while (0)
#define PG8_CAT8(x, y) __builtin_bit_cast(i32x8, __builtin_shufflevector(x, y, 0, 1, 2, 3, 4, 5, 6, 7, 8, 9, 10, 11, 12, 13, 14, 15))
#define PG8_MMA(ai, bj, At, Bt) do { __builtin_amdgcn_s_setprio(1); _Pragma("unroll") for (int m = 0; m < 4; ++m) _Pragma("unroll") for (int n = 0; n < 2; ++n) { \
        if constexpr (MX) acc[ai][bj][m][n] = __builtin_amdgcn_mfma_scale_f32_16x16x128_f8f6f4(PG8_CAT8(Bt[n][0], Bt[n][1]), PG8_CAT8(At[m][0], At[m][1]), acc[ai][bj][m][n], 0, 0, 0, 0x7f7f7f7f, 0, 0x7f7f7f7f); \
        else { _Pragma("unroll") for (int k = 0; k < 2; ++k) acc[ai][bj][m][n] = __builtin_amdgcn_mfma_f32_16x16x32_bf16(Bt[n][k], At[m][k], acc[ai][bj][m][n], 0, 0, 0); } } __builtin_amdgcn_s_setprio(0); } while (0)
#define PG8_WAIT_V(n) asm volatile("s_waitcnt vmcnt(" #n ")" ::: "memory")
#define PG8_WAIT_L(n) asm volatile("s_waitcnt lgkmcnt(" #n ")" ::: "memory")
#define PG8_BAR __builtin_amdgcn_s_barrier()
#define PG8_SCHED __builtin_amdgcn_sched_barrier(0)
    Unit cur, nxt; int ui = 0;
    if (!S.next(0, cur)) return;
    f32x4 acc[2][2][4][2];
#pragma unroll
    for (int a = 0; a < 2; ++a)
#pragma unroll
        for (int b = 0; b < 2; ++b)
#pragma unroll
            for (int m = 0; m < 4; ++m)
#pragma unroll
                for (int n = 0; n < 2; ++n) acc[a][b][m][n] = (f32x4){0.f, 0.f, 0.f, 0.f};
    bf16x8 At[4][2], B0[2][2], B1[2][2];
    const char* cA = (const char*)g.A + (GATHER ? (size_t)0 : (size_t)cur.pm * tstep) + cur.kofs; const char* cB = (const char*)g.Bt + (size_t)cur.pn * tstep + (size_t)cur.e * g.estride + cur.kofs;
    S.a_ready(cur);
    if constexpr (GATHER) { PG8_GOFF(vc0, vc1, cur); } else {
#pragma unroll
        for (int i = 0; i < 2; ++i) { vc0[i] = voffA[i]; vc1[i] = voffA[i]; } }
    if constexpr (SP2) {
        PG8_STAGE(PG8_SB(0, 0), cB, voffB); PG8_STAGE(PG8_SB(0, 1), cB + hstep, voffB); PG8_STAGE(PG8_SA(0, 0), cA, PG8_V(vc0)); PG8_STAGE(PG8_SA(0, 1), cA + hstepA, PG8_V(vc1));
        if (wr == 1) PG8_BAR;
        PG8_WAIT_V(2); PG8_BAR;
        PG8_STAGE(PG8_SB(1, 0), cB + kstep, voffB); PG8_STAGE(PG8_SA(1, 0), cA + kstep, PG8_V(vc0)); PG8_STAGE(PG8_SB(1, 1), cB + hstep + kstep, voffB);
        PG8_WAIT_V(6); PG8_BAR;
    } else {
        PG8_STAGE(PG8_SB(0, 0), cB, voffB); PG8_STAGE(PG8_SA(0, 0), cA, voffA); PG8_STAGE(PG8_SB(0, 1), cB + hstep, voffB); PG8_STAGE(PG8_SA(0, 1), cA + hstep, voffA);
        if (wr == 1) PG8_BAR;
        PG8_WAIT_V(4); PG8_BAR;
        PG8_STAGE(PG8_SB(1, 0), cB + kstep, voffB); PG8_STAGE(PG8_SA(1, 0), cA + kstep, voffA); PG8_STAGE(PG8_SB(1, 1), cB + hstep + kstep, voffB);
        PG8_WAIT_V(6); PG8_BAR;
    }
    for (;;) {
        const bool has_next = S.next(ui + 1, nxt);
        const char* nA = (has_next && !GATHER) ? (const char*)g.A + (size_t)nxt.pm * tstep + nxt.kofs : (GATHER ? (const char*)g.A : cA);
        const char* nB = has_next ? (const char*)g.Bt + (size_t)nxt.pn * tstep + (size_t)nxt.e * g.estride + nxt.kofs : cB;
        const int nt = cur.nt > 0 ? cur.nt : nt_all;
#if MK_DBG
        const unsigned long long dbg_k0 = __builtin_amdgcn_s_memtime();
#endif
        for (int t = 0; t < nt; t += 2) {
            const bool last = (t == nt - 2);
            const char* a1 = cA + (size_t)(t + 1) * kstep;
            const char* a2 = last ? nA : cA + (size_t)(t + 2) * kstep; const char* b2 = last ? nB : cB + (size_t)(t + 2) * kstep;
            const char* a3 = a2 + kstep; const char* b3 = b2 + kstep;
            if (last && has_next) S.a_ready(nxt);
            if constexpr (SP2) {
            PG8_LDB(B0, 0, 0); PG8_LDB(B1, 0, 1); PG8_SCHED; PG8_LDA(At, 0, 0); PG8_STAGE(PG8_SA(1, 1), a1 + hstepA, PG8_V(vc1));
            if constexpr (GATHER) { if (last && has_next) { PG8_GOFF(vc0, vc1, nxt); } }
            PG8_WAIT_V(8); PG8_WAIT_L(0); PG8_BAR; PG8_MMA(0, 0, At, B0); PG8_MMA(0, 1, At, B1); PG8_BAR; PG8_SCHED;
            PG8_LDA(At, 0, 1); PG8_STAGE(PG8_SB(0, 0), b2, voffB); PG8_STAGE(PG8_SB(0, 1), b2 + hstep, voffB); PG8_STAGE(PG8_SA(0, 0), a2, PG8_V(vc0));
            PG8_WAIT_V(8); PG8_WAIT_L(0); PG8_BAR; PG8_MMA(1, 0, At, B0); PG8_MMA(1, 1, At, B1); PG8_BAR; PG8_SCHED;
            PG8_LDB(B0, 1, 0); PG8_LDB(B1, 1, 1); PG8_SCHED; PG8_LDA(At, 1, 0); PG8_STAGE(PG8_SA(0, 1), a2 + hstepA, PG8_V(vc1));
            PG8_WAIT_V(8); PG8_WAIT_L(0); PG8_BAR; PG8_MMA(0, 0, At, B0); PG8_MMA(0, 1, At, B1); PG8_BAR; PG8_SCHED;
            PG8_LDA(At, 1, 1); PG8_STAGE(PG8_SB(1, 0), b3, voffB); PG8_STAGE(PG8_SB(1, 1), b3 + hstep, voffB); PG8_STAGE(PG8_SA(1, 0), a3, PG8_V(vc0));
            PG8_WAIT_V(8); PG8_WAIT_L(0); PG8_BAR; PG8_MMA(1, 0, At, B0); PG8_MMA(1, 1, At, B1); PG8_BAR; PG8_SCHED;
            } else {
            PG8_LDB(B0, 0, 0); PG8_SCHED; PG8_LDA(At, 0, 0); PG8_STAGE(PG8_SA(1, 1), a1 + hstep, voffA);
            PG8_WAIT_L(8); PG8_BAR; PG8_WAIT_L(0); PG8_MMA(0, 0, At, B0); PG8_BAR; PG8_SCHED;
            PG8_LDB(B1, 0, 1); PG8_STAGE(PG8_SB(0, 0), b2, voffB);
            PG8_BAR; PG8_WAIT_L(0); PG8_MMA(0, 1, At, B1); PG8_BAR;
            PG8_LDA(At, 0, 1); PG8_STAGE(PG8_SA(0, 0), a2, voffA);
            PG8_BAR; PG8_WAIT_L(0); PG8_MMA(1, 0, At, B0); PG8_BAR; PG8_SCHED;
            PG8_STAGE(PG8_SB(0, 1), b2 + hstep, voffB);
            PG8_WAIT_V(6); PG8_BAR; PG8_MMA(1, 1, At, B1); PG8_BAR;
            PG8_LDB(B0, 1, 0); PG8_SCHED; PG8_LDA(At, 1, 0); PG8_STAGE(PG8_SA(0, 1), a2 + hstep, voffA);
            PG8_WAIT_L(8); PG8_BAR; PG8_WAIT_L(0); PG8_MMA(0, 0, At, B0); PG8_BAR; PG8_SCHED;
            PG8_LDB(B1, 1, 1); PG8_STAGE(PG8_SB(1, 0), b3, voffB);
            PG8_BAR; PG8_WAIT_L(0); PG8_MMA(0, 1, At, B1); PG8_BAR;
            PG8_LDA(At, 1, 1); PG8_STAGE(PG8_SA(1, 0), a3, voffA);
            PG8_BAR; PG8_WAIT_L(0); PG8_MMA(1, 0, At, B0); PG8_BAR; PG8_SCHED;
            PG8_STAGE(PG8_SB(1, 1), b3 + hstep, voffB);
            PG8_WAIT_V(6); PG8_BAR; PG8_MMA(1, 1, At, B1); PG8_BAR;
            }
        }
#if MK_DBG
        if (MK_DBG_GEMM && dbg_out != nullptr && ui == 2 && blockIdx.x == 0 && tid == 0) { const unsigned long long d = __builtin_amdgcn_s_memtime() - dbg_k0; dbg_out[7] = (unsigned)(d / (unsigned long long)nt); }
#endif
        if constexpr (ALIGN_EPI) { if (wr == 0) PG8_BAR; }
        int lane_e = mk_lane(); asm volatile("" : "+v"(lane_e));
        const int fr_e = lane_e & 15, fq_e = lane_e >> 4;
        if constexpr (!Epi::AFTER_DRAIN) { E(acc, cur, wr, wc, fr_e, fq_e); if (MK_EPI2 && Epi::IDEM) { asm volatile("" ::: "memory"); E(acc, cur, wr, wc, fr_e, fq_e); } S.done(cur); }
        if (!has_next) break;
        if (!nxt.keep) {
#pragma unroll
        for (int a = 0; a < 2; ++a)
#pragma unroll
            for (int b = 0; b < 2; ++b)
#pragma unroll
                for (int m = 0; m < 4; ++m)
#pragma unroll
                    for (int n = 0; n < 2; ++n) acc[a][b][m][n] = (f32x4){0.f, 0.f, 0.f, 0.f};
        }
        cur = nxt; cA = nA; cB = nB; ++ui;
        if constexpr (ALIGN_EPI) { if (wr == 1) PG8_BAR; }
    }
    PG8_WAIT_V(0);
    if constexpr (!ALIGN_EPI) { if (wr == 0) PG8_BAR; }
    PG8_BAR;
    if constexpr (Epi::AFTER_DRAIN) { E.fused(acc, cur, wr, wc, fr, fq, lds, wid, lane); S.done(cur); }
#undef PG8_SA
#undef PG8_SB
#undef PG8_STAGE
#undef PG8_LDA
#undef PG8_LDB
#undef PG8_MMA
#undef PG8_WAIT_V
#undef PG8_WAIT_L
#undef PG8_BAR
#undef PG8_SCHED
#undef PG8_GOFF
#undef PG8_V
}
}
#include <cmath>
#ifndef ATT_KDUP
#define ATT_KDUP 1
#endif
#ifndef ATT_HALF
#define ATT_HALF(w) ((w) >> 2)
#endif
#ifndef MK_DBG
#define MK_DBG 0
#endif
#ifndef MK_DBG_SEL
#define MK_DBG_SEL 0
#endif
#ifndef ATT_PRIO
#define ATT_PRIO 0
#endif
#ifndef ATT_SIMPLE
#define ATT_SIMPLE 1
#endif
namespace att {
typedef unsigned short bf16_t;
typedef short bf16x8 __attribute__((ext_vector_type(8)));
typedef short s16x4 __attribute__((ext_vector_type(4)));
typedef short v4i16_t __attribute__((ext_vector_type(4)));
typedef float f32x16 __attribute__((ext_vector_type(16)));
typedef unsigned u32x4 __attribute__((ext_vector_type(4)));
#define ATT_LAS __attribute__((address_space(3)))
constexpr int SLOT = 16384, RSLOT = 2 * SLOT  , ATT_LDS_BYTES = 4 * RSLOT;
__device__ __forceinline__ int crow(int r, int hi) { return (r & 3) + 8 * (r >> 2) + 4 * hi; }
__device__ __forceinline__ void glds16(const void* gsrc, unsigned lds_dst) { unsigned keep;
    asm volatile("s_mov_b32 %0, m0\n\ts_mov_b32 m0, %2\n\ts_nop 0\n\tglobal_load_lds_dwordx4 %1, off\n\ts_mov_b32 m0, %0" : "=&s"(keep) : "v"(gsrc), "s"(lds_dst) : "memory"); }
__device__ __forceinline__ const void* uniform_ptr(const void* p) { const unsigned long long v = (unsigned long long)p;
    return (const void*)(((unsigned long long)(unsigned)__builtin_amdgcn_readfirstlane((unsigned)(v >> 32)) << 32) | (unsigned long long)(unsigned)__builtin_amdgcn_readfirstlane((unsigned)v)); }
__device__ __forceinline__ void glds16s(const void* sbase, unsigned voff, unsigned lds_dst) { unsigned keep;
    asm volatile("s_mov_b32 %0, m0\n\ts_mov_b32 m0, %3\n\ts_nop 4\n\tglobal_load_lds_dwordx4 %1, %2\n\ts_mov_b32 m0, %0" : "=&s"(keep) : "v"(voff), "s"(sbase), "s"(lds_dst) : "memory"); }
typedef float f32x2_t __attribute__((ext_vector_type(2))); typedef __bf16 bf16x2_t __attribute__((ext_vector_type(2)));
__device__ __forceinline__ unsigned cvtpk(float lo, float hi) { f32x2_t v = {lo, hi}; bf16x2_t b = __builtin_convertvector(v, bf16x2_t); return __builtin_bit_cast(unsigned, b); }
__device__ __forceinline__ s16x4 vtr(ATT_LAS const char* p) { return __builtin_bit_cast(s16x4, __builtin_amdgcn_ds_read_tr16_b64_v4i16((ATT_LAS v4i16_t*)p)); }
__device__ __forceinline__ float swapsum(float m) { auto rr = __builtin_amdgcn_permlane32_swap(__float_as_uint(m), __float_as_uint(m), false, false); return __uint_as_float(rr[0]) + __uint_as_float(rr[1]); }

template <int DK>
__device__ __forceinline__ void attn_unit(const bf16_t* Qp, const bf16_t* Kp, const bf16_t* Vp, int i0, int t_lo, int t_hi, int win, int wskip, float slope2, float cref,
                                          bf16_t* Op, long ostride, float* lsep, long lstride, ATT_LAS unsigned char* lds, ATT_LAS float* wsbase, const int wv, unsigned* dbgp = nullptr) {
    constexpr int NKS = DK / 16;
    constexpr int NKW = DK / 64;
    const int lane = mk_lane(), r32 = lane & 31, hi = lane >> 5; const int wid = wv; const int tid = wid * 64 + lane;
    i0 = __builtin_amdgcn_readfirstlane(i0); t_lo = __builtin_amdgcn_readfirstlane(t_lo); t_hi = __builtin_amdgcn_readfirstlane(t_hi); win = __builtin_amdgcn_readfirstlane(win); wskip = __builtin_amdgcn_readfirstlane(wskip);
    const int half = ATT_HALF(wid);
    const int qrow = i0 + 32 * wid + r32, qmin_w = i0 + 32 * wid, qmax_w = qmin_w + 31;
    const unsigned lds0 = (unsigned)(uintptr_t)lds;
    ATT_LAS float* wsf = wsbase + wid * 64;
    const int NT = t_hi - t_lo;
    unsigned koff[NKW], voff[2];
#pragma unroll
    for (int i = 0; i < NKW; ++i) { const int p = wid + 8 * i;
        if (DK == 64) { const int r = 8 * p + (lane >> 3), pc = lane & 7; koff[i] = (unsigned)(r * 128 + ((pc ^ ((r >> 1) & 7)) << 4)); }
        else          { const int r = 4 * p + (lane >> 4), pc = lane & 15; koff[i] = (unsigned)(r * 256 + ((pc ^ (r & 15)) << 4)); } }
#pragma unroll
    for (int i = 0; i < 2; ++i) { const int p = wid + 8 * i, r = 4 * p + (lane >> 4), pc = lane & 15; voff[i] = (unsigned)(r * 256 + ((pc ^ (((r & 3) << 2) | ((r >> 2) & 3))) << 4)); }
    constexpr long ktile = 64L * DK, vtile = 64L * 128;
#define ATT_DMA(t, slot) do { \
        _Pragma("unroll") for (int d_ = 0; d_ < ATT_KDUP; ++d_) _Pragma("unroll") for (int i_ = 0; i_ < NKW; ++i_) glds16s(uniform_ptr(Kp + (long)(t) * ktile), koff[i_], (unsigned)__builtin_amdgcn_readfirstlane(lds0 + (slot) * RSLOT + (wid + 8 * i_) * 1024)); \
        _Pragma("unroll") for (int i_ = 0; i_ < 2; ++i_)   glds16s(uniform_ptr(Vp + (long)(t) * vtile), voff[i_], (unsigned)__builtin_amdgcn_readfirstlane(lds0 + (slot) * RSLOT + SLOT + (wid + 8 * i_) * 1024)); } while (0)
#define ATT_NEED(t) (!(64 * (t) > qmax_w || 64 * (t) + 63 < qmin_w - wskip))
    ATT_DMA(t_lo, 0);
    if (NT > 1) ATT_DMA(t_lo + 1, 1);
    bf16x8 qr[NKS];
#pragma unroll
    for (int d0 = 0; d0 < NKS; ++d0) qr[d0] = *reinterpret_cast<const bf16x8*>(Qp + (long)qrow * DK + d0 * 16 + hi * 8);
    float l_run = 0.f;
    f32x16 o[4];
#pragma unroll
    for (int d = 0; d < 4; ++d)
#pragma unroll
        for (int r = 0; r < 16; ++r) o[d][r] = 0.f;
    f32x16 p0, p1; bf16x8 pa[4];
#pragma unroll
    for (int r = 0; r < 16; ++r) { p0[r] = 0.f; p1[r] = 0.f; }
#pragma unroll
    for (int i = 0; i < 4; ++i) pa[i] = (bf16x8){0, 0, 0, 0, 0, 0, 0, 0};
    const int ksw = (DK == 64) ? ((r32 >> 1) & 7) : (r32 & 15);
    const unsigned kbx = (unsigned)(r32 * (DK * 2) + ((hi ^ (ksw & 1)) << 4) + ((ksw >> 1) << 5));
    const int vq = (lane & 15) >> 2, vpp = lane & 3, vblk = (lane >> 4) & 1;
    const unsigned vbx = (unsigned)(SLOT + 1024 * hi + 256 * vq + 8 * (vpp & 1) + 64 * vq + 16 * ((2 * vblk + (vpp >> 1)) ^ hi));
    ATT_LAS const char* const ldsc = (ATT_LAS const char*)lds;
    if (NT > 1) { if (NKW * ATT_KDUP == 1) asm volatile("s_waitcnt vmcnt(3)" ::: "memory"); else if (NKW * ATT_KDUP == 2) asm volatile("s_waitcnt vmcnt(4)" ::: "memory"); else asm volatile("s_waitcnt vmcnt(6)" ::: "memory"); } else asm volatile("s_waitcnt vmcnt(0)" ::: "memory");
    asm volatile("s_waitcnt lgkmcnt(0)\n\ts_barrier" ::: "memory");
#pragma unroll
    for (int d0 = 0; d0 < NKS; ++d0) asm volatile("" : "+v"(qr[d0]));
#if ATT_SIMPLE
#define ATT_QK(tr_) do { const int t_ = t_lo + (tr_); \
        const float tb = slope2 * (float)(64 * t_ + 4 * hi - qrow) - cref; \
        _Pragma("unroll") for (int r = 0; r < 16; ++r) { p0[r] = __builtin_fmaf(slope2, (float)((r & 3) + 8 * (r >> 2)), tb); p1[r] = __builtin_fmaf(slope2, (float)(32 + (r & 3) + 8 * (r >> 2)), tb); } \
        unsigned kb_ = kbx + ((tr_) & 3) * RSLOT; asm volatile("" : "+v"(kb_)); \
        _Pragma("unroll") for (int blk = 0; blk < NKS / 4; ++blk) { \
            unsigned ka[4]; \
            _Pragma("unroll") for (int j = 0; j < 4; ++j) ka[j] = kb_ ^ (unsigned)(32 * (4 * blk + j)); \
            bf16x8 kb0[4], kb1[4]; \
            _Pragma("unroll") for (int j = 0; j < 4; ++j) { ATT_LAS const char* kp = ldsc + ka[j]; kb0[j] = *(ATT_LAS const bf16x8*)kp; kb1[j] = *(ATT_LAS const bf16x8*)(kp + 32 * DK * 2); } \
            __builtin_amdgcn_sched_barrier(0); if (ATT_PRIO) __builtin_amdgcn_s_setprio(1); \
            _Pragma("unroll") for (int j = 0; j < 4; ++j) { p0 = __builtin_amdgcn_mfma_f32_32x32x16_bf16(kb0[j], qr[4 * blk + j], p0, 0, 0, 0); p1 = __builtin_amdgcn_mfma_f32_32x32x16_bf16(kb1[j], qr[4 * blk + j], p1, 0, 0, 0); } \
            if (ATT_PRIO) __builtin_amdgcn_s_setprio(0); __builtin_amdgcn_sched_barrier(0); } } while (0)
#define ATT_SM(tr_) do { const int t_ = t_lo + (tr_); \
        if (64 * t_ + 63 > qmin_w || 64 * t_ < qmax_w - win) {        \
            const int dq = qrow - 64 * t_ - 4 * hi; const unsigned uw = (unsigned)win; \
            _Pragma("unroll") for (int r = 0; r < 16; ++r) { const int c = (r & 3) + 8 * (r >> 2); \
                if ((unsigned)(dq - c) > uw) p0[r] = -INFINITY; if ((unsigned)(dq - c - 32) > uw) p1[r] = -INFINITY; } } \
        float sa = 0.f, sb = 0.f, sc = 0.f, sd = 0.f; \
        _Pragma("unroll") for (int r = 0; r < 16; r += 2) { p0[r] = __builtin_amdgcn_exp2f(p0[r]); p0[r + 1] = __builtin_amdgcn_exp2f(p0[r + 1]); p1[r] = __builtin_amdgcn_exp2f(p1[r]); p1[r + 1] = __builtin_amdgcn_exp2f(p1[r + 1]); \
            sa += p0[r]; sb += p0[r + 1]; sc += p1[r]; sd += p1[r + 1]; } \
        l_run += (sa + sb) + (sc + sd); \
        u32x4 w; \
        w.x = cvtpk(p0[0], p0[1]); w.y = cvtpk(p0[2], p0[3]); w.z = cvtpk(p0[4], p0[5]); w.w = cvtpk(p0[6], p0[7]); pa[0] = __builtin_bit_cast(bf16x8, w); \
        w.x = cvtpk(p0[8], p0[9]); w.y = cvtpk(p0[10], p0[11]); w.z = cvtpk(p0[12], p0[13]); w.w = cvtpk(p0[14], p0[15]); pa[1] = __builtin_bit_cast(bf16x8, w); \
        w.x = cvtpk(p1[0], p1[1]); w.y = cvtpk(p1[2], p1[3]); w.z = cvtpk(p1[4], p1[5]); w.w = cvtpk(p1[6], p1[7]); pa[2] = __builtin_bit_cast(bf16x8, w); \
        w.x = cvtpk(p1[8], p1[9]); w.y = cvtpk(p1[10], p1[11]); w.z = cvtpk(p1[12], p1[13]); w.w = cvtpk(p1[14], p1[15]); pa[3] = __builtin_bit_cast(bf16x8, w); } while (0)
#define ATT_PV(tr_) do { unsigned vb_ = vbx + ((tr_) & 3) * RSLOT; asm volatile("" : "+v"(vb_)); if (ATT_PRIO) __builtin_amdgcn_s_setprio(1); \
        s16x4 vl[16], vh[16]; \
        _Pragma("unroll") for (int i = 0; i < 16; ++i) { vl[i] = vtr(ldsc + (vb_ ^ (unsigned)(64 * (i >> 2))) + (i & 3) * 4096); vh[i] = vtr(ldsc + (vb_ ^ (unsigned)(64 * (i >> 2) + 32)) + (i & 3) * 4096 + 2048); } \
        _Pragma("unroll") for (int i = 0; i < 16; ++i) { \
            const bf16x8 vf = (bf16x8){vl[i][0], vl[i][1], vl[i][2], vl[i][3], vh[i][0], vh[i][1], vh[i][2], vh[i][3]}; \
            o[i >> 2] = __builtin_amdgcn_mfma_f32_32x32x16_bf16(pa[i & 3], vf, o[i >> 2], 0, 0, 0); } \
        __builtin_amdgcn_sched_group_barrier(0x100, 8, 0); \
        _Pragma("unroll") for (int i = 0; i < 12; ++i) { __builtin_amdgcn_sched_group_barrier(0x8, 1, 0); __builtin_amdgcn_sched_group_barrier(0x100, 2, 0); } \
        _Pragma("unroll") for (int i = 0; i < 4; ++i) __builtin_amdgcn_sched_group_barrier(0x8, 1, 0); if (ATT_PRIO) __builtin_amdgcn_s_setprio(0); } while (0)
#if ATT_SIMPLE == 3
    if (half) asm volatile("s_waitcnt lgkmcnt(0)\n\ts_barrier" ::: "memory");
    for (int tr = 0; tr <= NT; ++tr) {
        if (tr + 2 < NT) ATT_DMA(t_lo + tr + 2, (tr + 2) & 3);
        if (tr > 0 && ATT_NEED(t_lo + tr - 1)) { ATT_PV(tr - 1); }
        if (tr < NT && ATT_NEED(t_lo + tr)) { ATT_QK(tr); }
        if (tr + 2 < NT) { if (NKW == 1) asm volatile("s_waitcnt vmcnt(3)" ::: "memory"); else asm volatile("s_waitcnt vmcnt(4)" ::: "memory"); } else asm volatile("s_waitcnt vmcnt(0)" ::: "memory");
        asm volatile("s_waitcnt lgkmcnt(0)\n\ts_barrier" ::: "memory");
        if (tr == NT) break;
        if (ATT_NEED(t_lo + tr)) { ATT_SM(tr); }
        asm volatile("s_waitcnt lgkmcnt(0)\n\ts_barrier" ::: "memory");
    }
    if (!half) asm volatile("s_waitcnt lgkmcnt(0)\n\ts_barrier" ::: "memory");
#elif ATT_SIMPLE == 2
    for (int tr = 0; tr < NT; ++tr) {
        if (tr + 1 < NT) { if (NKW == 1) asm volatile("s_waitcnt vmcnt(3)" ::: "memory"); else asm volatile("s_waitcnt vmcnt(4)" ::: "memory"); } else asm volatile("s_waitcnt vmcnt(0)" ::: "memory");
        asm volatile("s_waitcnt lgkmcnt(0)\n\ts_barrier" ::: "memory");
        if (tr + 2 < NT) ATT_DMA(t_lo + tr + 2, (tr + 2) & 3);
        if (half == 0) {
            if (ATT_NEED(t_lo + tr)) { ATT_QK(tr); ATT_SM(tr); ATT_PV(tr); }
        } else {
            if (tr > 0 && ATT_NEED(t_lo + tr - 1)) { ATT_SM(tr - 1); ATT_PV(tr - 1); }
            if (ATT_NEED(t_lo + tr)) { ATT_QK(tr); }
        }
    }
    if (half != 0 && ATT_NEED(t_lo + NT - 1)) { ATT_SM(NT - 1); ATT_PV(NT - 1); }
#else
    for (int tp = 0; tp < NT; tp += 2) {
        asm volatile("s_waitcnt vmcnt(0)" ::: "memory");
        asm volatile("s_waitcnt lgkmcnt(0)\n\ts_barrier" ::: "memory");
        if (tp + 2 < NT) ATT_DMA(t_lo + tp + 2, (tp + 2) & 3);
        if (tp + 3 < NT) ATT_DMA(t_lo + tp + 3, (tp + 3) & 3);
#pragma unroll 1
        for (int sub = 0; sub < 2; ++sub) { const int tr = tp + sub; if (tr >= NT || !ATT_NEED(t_lo + tr)) continue; ATT_QK(tr); ATT_SM(tr); ATT_PV(tr); }
    }
#endif
#undef ATT_QK
#undef ATT_SM
#undef ATT_PV
    asm volatile("s_waitcnt vmcnt(0) lgkmcnt(0)\n\ts_barrier" ::: "memory");
#else
    const int nslots = 2 * NT + 2;
#if MK_DBG
    unsigned long long dbg_t0 = __builtin_amdgcn_s_memtime(), dbg_w = 0, dbg_a = 0, dbg_b = 0;
#endif
    for (int s = 0; s < nslots; ++s) {
        if ((s & 1) == 0) { const int tt = s >> 1; if (tt + 2 < NT) ATT_DMA(t_lo + tt + 2, (tt + 2) & 3); }
        const int k = s - half;
#if MK_DBG
        const unsigned long long dbg_pp = __builtin_amdgcn_s_memtime();
#endif
        if (k >= 0 && k <= 2 * NT) {
            const int tr = k >> 1, t = t_lo + tr;
            if ((k & 1) == 0) {
                const bool doqk = (tr < NT) && ATT_NEED(t), dopv = (tr >= 1) && ATT_NEED(t - 1);
                if (dopv) {
                    unsigned vb_ = vbx + ((tr - 1) & 3) * RSLOT; asm volatile("" : "+v"(vb_));
                    s16x4 vl[16], vh[16];
#pragma unroll
                    for (int i = 0; i < 16; ++i) { vl[i] = vtr(ldsc + (vb_ ^ (unsigned)(64 * (i >> 2))) + (i & 3) * 4096); vh[i] = vtr(ldsc + (vb_ ^ (unsigned)(64 * (i >> 2) + 32)) + (i & 3) * 4096 + 2048); }
#pragma unroll
                    for (int i = 0; i < 16; ++i) {
                        const bf16x8 vf = (bf16x8){vl[i][0], vl[i][1], vl[i][2], vl[i][3], vh[i][0], vh[i][1], vh[i][2], vh[i][3]};
                        o[i >> 2] = __builtin_amdgcn_mfma_f32_32x32x16_bf16(pa[i & 3], vf, o[i >> 2], 0, 0, 0); }
                    __builtin_amdgcn_sched_group_barrier(0x100, 8, 0);
#pragma unroll
                    for (int i = 0; i < 12; ++i) { __builtin_amdgcn_sched_group_barrier(0x8, 1, 0); __builtin_amdgcn_sched_group_barrier(0x100, 2, 0); }
#pragma unroll
                    for (int i = 0; i < 4; ++i) __builtin_amdgcn_sched_group_barrier(0x8, 1, 0);
                }
                __builtin_amdgcn_sched_barrier(0);
                if (doqk) {
                    const float tb = slope2 * (float)(64 * t + 4 * hi - qrow) - cref;
#pragma unroll
                    for (int r = 0; r < 16; ++r) { p0[r] = __builtin_fmaf(slope2, (float)((r & 3) + 8 * (r >> 2)), tb); p1[r] = __builtin_fmaf(slope2, (float)(32 + (r & 3) + 8 * (r >> 2)), tb); }
                    unsigned kb_ = kbx + (tr & 3) * RSLOT; asm volatile("" : "+v"(kb_));
#pragma unroll
                    for (int blk = 0; blk < NKS / 4; ++blk) {
                        unsigned ka[4];
#pragma unroll
                        for (int j = 0; j < 4; ++j) ka[j] = kb_ ^ (unsigned)(32 * (4 * blk + j));
                        bf16x8 kb0[4], kb1[4];
#pragma unroll
                        for (int j = 0; j < 4; ++j) { ATT_LAS const char* kp = ldsc + ka[j]; kb0[j] = *(ATT_LAS const bf16x8*)kp; kb1[j] = *(ATT_LAS const bf16x8*)(kp + 32 * DK * 2); }
                        __builtin_amdgcn_sched_barrier(0);
#pragma unroll
                        for (int j = 0; j < 4; ++j) { p0 = __builtin_amdgcn_mfma_f32_32x32x16_bf16(kb0[j], qr[4 * blk + j], p0, 0, 0, 0); p1 = __builtin_amdgcn_mfma_f32_32x32x16_bf16(kb1[j], qr[4 * blk + j], p1, 0, 0, 0); }
                        __builtin_amdgcn_sched_barrier(0);
                    }
                }
            } else if (tr < NT && ATT_NEED(t)) {
                if (64 * t + 63 > qmin_w || 64 * t < qmax_w - win) {
                    const int kb = 64 * t + 4 * hi, lo = qrow - win;
#pragma unroll
                    for (int r = 0; r < 16; ++r) { const int kv = kb + (r & 3) + 8 * (r >> 2);
                        if (kv > qrow || kv < lo) p0[r] = -INFINITY; if (kv + 32 > qrow || kv + 32 < lo) p1[r] = -INFINITY; }
                }
                float sa = 0.f, sb = 0.f, sc = 0.f, sd = 0.f;
#pragma unroll
                for (int r = 0; r < 16; r += 2) { p0[r] = __builtin_amdgcn_exp2f(p0[r]); p0[r + 1] = __builtin_amdgcn_exp2f(p0[r + 1]); p1[r] = __builtin_amdgcn_exp2f(p1[r]); p1[r + 1] = __builtin_amdgcn_exp2f(p1[r + 1]);
                    sa += p0[r]; sb += p0[r + 1]; sc += p1[r]; sd += p1[r + 1]; }
                l_run += (sa + sb) + (sc + sd);
                { u32x4 w;
                  w.x = cvtpk(p0[0], p0[1]); w.y = cvtpk(p0[2], p0[3]); w.z = cvtpk(p0[4], p0[5]); w.w = cvtpk(p0[6], p0[7]); pa[0] = __builtin_bit_cast(bf16x8, w);
                  w.x = cvtpk(p0[8], p0[9]); w.y = cvtpk(p0[10], p0[11]); w.z = cvtpk(p0[12], p0[13]); w.w = cvtpk(p0[14], p0[15]); pa[1] = __builtin_bit_cast(bf16x8, w);
                  w.x = cvtpk(p1[0], p1[1]); w.y = cvtpk(p1[2], p1[3]); w.z = cvtpk(p1[4], p1[5]); w.w = cvtpk(p1[6], p1[7]); pa[2] = __builtin_bit_cast(bf16x8, w);
                  w.x = cvtpk(p1[8], p1[9]); w.y = cvtpk(p1[10], p1[11]); w.z = cvtpk(p1[12], p1[13]); w.w = cvtpk(p1[14], p1[15]); pa[3] = __builtin_bit_cast(bf16x8, w); }
            }
        }
#if MK_DBG
        const unsigned long long dbg_t1 = __builtin_amdgcn_s_memtime();
        if (k >= 0 && k <= 2 * NT) { if ((k & 1) == 0) dbg_a += dbg_t1 - dbg_pp; else dbg_b += dbg_t1 - dbg_pp; }
#endif
        if (s & 1) { if ((s >> 1) + 2 < NT) { if (NKW * ATT_KDUP == 1) asm volatile("s_waitcnt vmcnt(3)" ::: "memory"); else if (NKW * ATT_KDUP == 2) asm volatile("s_waitcnt vmcnt(4)" ::: "memory"); else asm volatile("s_waitcnt vmcnt(6)" ::: "memory"); } else asm volatile("s_waitcnt vmcnt(0)" ::: "memory"); }
        asm volatile("s_waitcnt lgkmcnt(0)\n\ts_barrier" ::: "memory");
#if MK_DBG
        dbg_w += __builtin_amdgcn_s_memtime() - dbg_t1;
#endif
    }
#if MK_DBG
    if (dbgp != nullptr && tid == 0) { const unsigned long long tt = __builtin_amdgcn_s_memtime() - dbg_t0; dbgp[0] = (unsigned)(tt / (unsigned long long)nslots); dbgp[1] = (unsigned)(dbg_w / (unsigned long long)nslots); dbgp[2] = (unsigned)nslots; dbgp[3] = (unsigned)(dbg_a / (unsigned long long)(NT + 1)); dbgp[4] = (unsigned)(dbg_b / (unsigned long long)NT); }
#endif
#endif
#undef ATT_DMA
#undef ATT_NEED
    int lane_e = lane; asm volatile("" : "+v"(lane_e));
    const int r32e = lane_e & 31, hie = lane_e >> 5;
    const float l_tot = swapsum(l_run);
    if (hie == 0) wsf[32 + r32e] = l_tot;
    if (lsep != nullptr && hie == 0) lsep[(long)(i0 + 32 * wid + r32e) * lstride] = __builtin_amdgcn_logf(l_tot) + cref;
    {
        ATT_LAS unsigned short* stg = (ATT_LAS unsigned short*)(lds + wid * 8192);
#pragma unroll
        for (int r = 0; r < 16; ++r) { const int orow = crow(r, hie); const float rl = __builtin_amdgcn_rcpf(wsf[32 + orow]);
#pragma unroll
            for (int d0 = 0; d0 < 4; ++d0) stg[orow * 128 + d0 * 32 + r32e] = (unsigned short)(cvtpk(o[d0][r] * rl, 0.f) & 0xffffu); }
        asm volatile("s_waitcnt lgkmcnt(0)" ::: "memory");
        bf16_t* Ow = Op + (long)(i0 + 32 * wid) * ostride;
#pragma unroll
        for (int i = 0; i < 8; ++i) { const int row = i * 4 + (lane_e >> 4), ch = lane_e & 15; const u32x4 v = *(ATT_LAS const u32x4*)(stg + row * 128 + ch * 8); *(u32x4*)(Ow + (long)row * ostride + ch * 8) = v; }
    }
    asm volatile("s_waitcnt lgkmcnt(0)\n\ts_barrier" ::: "memory");
}
}
constexpr int NWAVES = 8;
constexpr int BATCH = 2, SEQ = 8192, DM = 2048, M = BATCH * SEQ;
constexpr int NIN = 11776;
#ifndef MK_NINP
#define MK_NINP 11776
#endif
constexpr int NINP = MK_NINP;
constexpr int C_DAQ = 0, C_DAK = 1024, C_DAV = 2048, C_DLQ = 3072, C_DLK = 4608, C_DLV = 6144, C_GA = 7680, C_GB = 9728;
constexpr int NE = 32, DFF = 1024, TK = 2 * M;
constexpr int XS_ROWS = TK + NE * 256;
constexpr float EPS = 1e-6f, LOG2E = 1.4426950408889634f;
constexpr float LAM_INIT = 0.2f;

#ifndef MK_N_LAUNCHES
#define MK_N_LAUNCHES 1
#endif
constexpr int N_PHASES = 12;
#ifndef MK_DBG_Q
#define MK_DBG_Q 250u
#endif
#ifndef MK_DBG_THR
#define MK_DBG_THR 0u
#endif
#ifndef MK_DBG_UNIT
#define MK_DBG_UNIT 0
#endif
#ifndef MK_SPLIT_AT
#define MK_SPLIT_AT (-1)
#endif
#ifndef MK_REPEAT_SUB
#define MK_REPEAT_SUB 3
#endif

constexpr size_t MiB = 1u << 20;
constexpr size_t WS_CTL = 0, CTL_ZERO_BYTES = 256 * 1024;
constexpr size_t WS_WR   = 1 * MiB;
constexpr size_t WS_GAIN = 1 * MiB + 512 * 1024;
constexpr size_t WS_ROUTE = 2 * MiB;
constexpr size_t WS_LSE  = 3 * MiB;
constexpr size_t WS_WIN  = 4 * MiB;
constexpr size_t WS_WIN8 = 36 * MiB;
constexpr size_t WS_XN8  = 672 * MiB;
constexpr size_t WS_WA   = 50 * MiB;
constexpr size_t WS_WB   = 54 * MiB;
constexpr size_t WS_WO   = 56 * MiB;
constexpr size_t WS_WGU  = 64 * MiB;
constexpr size_t WS_WD   = 320 * MiB;
constexpr size_t WS_XN   = 448 * MiB;
constexpr size_t WS_ODA  = 512 * MiB;
constexpr size_t WS_ODL  = 576 * MiB;
constexpr size_t WS_OA   = 624 * MiB;
constexpr size_t WS_OB   = 656 * MiB;
constexpr size_t WS_MIX  = 672 * MiB;
constexpr size_t WS_PROJ = 736 * MiB;
constexpr size_t WS_XS   = WS_PROJ;
constexpr size_t WS_Y8   = WS_PROJ + 240 * MiB;
constexpr size_t WS_HB   = WS_PROJ + 160 * MiB;
constexpr size_t WS_LIST = WS_PROJ + 376 * MiB;
constexpr size_t WS_RSL  = WS_LIST + 2 * MiB;
constexpr size_t WS_END  = WS_RSL + 2 * MiB;
static_assert((size_t)XS_ROWS * 2048 * 2 <= 160 * MiB && (size_t)XS_ROWS * 1024 * 2 <= 80 * MiB && (size_t)M * NINP * 2 <= 376 * MiB, "ws map");
constexpr int CW_TMO = 0, CW_CODE = 1;
constexpr int CW_BAR = 4096;
constexpr int CW_CNT = 16384, CW_FILL = 16384 + 64;
static_assert(true, "");
constexpr int CW_TQ = 24576;
constexpr int CW_DBG = 20480;
constexpr int CW_QUEUE = 20544;

constexpr int RING_OFF = 0, RING_BYTES = 131072;
constexpr int LDSCTL_OFF = RING_BYTES, MISC_OFF = LDSCTL_OFF + 320;
constexpr int TILE_E_OFF = LDSCTL_OFF + 1024;
constexpr int XCH_OFF = LDSCTL_OFF + 2048;
constexpr int LDS_BYTES = 147456;
static_assert(XCH_OFF + 8192 <= LDS_BYTES && att::ATT_LDS_BYTES <= RING_BYTES, "LDS map");

#define GAS __attribute__((address_space(1)))
#define LAS __attribute__((address_space(3)))
typedef unsigned short bf16;
typedef unsigned v4u __attribute__((ext_vector_type(4)));
typedef float f32x4 __attribute__((ext_vector_type(4)));
typedef short bf16x8 __attribute__((ext_vector_type(8)));
typedef GAS unsigned gu32;
typedef GAS unsigned long long gu64;
#define RLX_AGENT __ATOMIC_RELAXED, __HIP_MEMORY_SCOPE_AGENT
#define LDS_WAIT() asm volatile("s_waitcnt lgkmcnt(0)" ::: "memory")
#define VM_WAIT() asm volatile("s_waitcnt vmcnt(0)" ::: "memory")
__device__ __forceinline__ unsigned long long rt() { return __builtin_amdgcn_s_memrealtime(); }
__device__ __forceinline__ unsigned f2bf(float f) { unsigned u = __builtin_bit_cast(unsigned, f); return (u + 0x7fffu + ((u >> 16) & 1u)) >> 16; }
__device__ __forceinline__ unsigned pk2(float lo, float hi) { return f2bf(lo) | (f2bf(hi) << 16); }

#define XB_TMO      128
#define XB_XCNT(j)  (256  + 64 * (j))
#define XB_XSUB(j)  (1280 + 64 * (j))
#define XB_XGEN(j)  (2304 + 64 * (j))
#define XB_TOP      3328
#define XB_TOPGEN   3392
#define XCD_BAR_WORDS 3456
#define XB_SPIN_CAP (1u << 18)

__device__ __forceinline__ unsigned xb_ld(unsigned* p)              { return __hip_atomic_load(p, __ATOMIC_RELAXED, __HIP_MEMORY_SCOPE_AGENT); }
__device__ __forceinline__ unsigned xb_add(unsigned* p, unsigned v) { return __hip_atomic_fetch_add(p, v, __ATOMIC_RELAXED, __HIP_MEMORY_SCOPE_AGENT); }
__device__ __forceinline__ unsigned xb_xcc_id() { return (unsigned)__builtin_amdgcn_s_getreg((3 << 11) | 20) & 0xFu; }
#define XB_SPIN(cond, bar) do { unsigned _sp = 0; while (cond) { __builtin_amdgcn_s_sleep(1); \
    if ((++_sp & 255u) == 0u) { if (xb_ld(&(bar)[XB_TMO])) break; if (_sp > XB_SPIN_CAP) { atomicAdd(&(bar)[XB_TMO], 1u); break; } } } } while (0)

struct XcdBarrier {
    unsigned* bar; unsigned x; unsigned w0;
    volatile LAS unsigned* st;
};

__device__ __forceinline__ XcdBarrier xcd_barrier_post(unsigned* bar, volatile LAS unsigned* st, unsigned w0) {
    XcdBarrier b; b.bar = bar; b.x = xb_xcc_id(); b.st = st; b.w0 = w0;
    if (w0 && mk_lane() == 0) (void)xb_add(&bar[XB_XCNT(b.x)], 1u);
    return b;
}
__device__ __forceinline__ void xcd_barrier_complete(unsigned* bar, unsigned x, unsigned& nloc, unsigned& nx) {
    const unsigned G = gridDim.x * gridDim.y * gridDim.z;
    unsigned sum, cnt, mine, sp = 0u;
    for (;;) {
        sum = 0u; cnt = 0u; mine = 0u;
#pragma unroll
        for (unsigned j = 0; j < 16; ++j) { const unsigned c = xb_ld(&bar[XB_XCNT(j)]); sum += c; cnt += (c > 0u) ? 1u : 0u; mine = (j == x) ? c : mine; }
        if (sum == G) break;
        __builtin_amdgcn_s_sleep(1);
        if ((++sp & 255u) == 0u) { if (xb_ld(&bar[XB_TMO])) break; if (sp > XB_SPIN_CAP) { atomicAdd(&bar[XB_TMO], 1u); break; } }
    }
    nloc = mine > 0u ? mine : 1u; nx = cnt > 0u ? cnt : 1u;
}

__device__ __forceinline__ void xcd_barrier(const XcdBarrier& b) {
    asm volatile("s_waitcnt vmcnt(0)" ::: "memory");
    __syncthreads();
    if (b.w0 && mk_lane() == 0) {
        unsigned* bar = b.bar;
        __builtin_amdgcn_s_waitcnt(0);
        unsigned nloc = b.st[0], nx = b.st[1];
        if (nloc == 0u) { xcd_barrier_complete(bar, b.x, nloc, nx); b.st[0] = nloc; b.st[1] = nx; }
        const unsigned old = xb_add(&bar[XB_XSUB(b.x)], 1u);
        const unsigned gen = old / nloc;
        if (old + 1u == (gen + 1u) * nloc) {
            __builtin_amdgcn_fence(__ATOMIC_RELEASE, "agent");
            asm volatile("s_waitcnt vmcnt(0)" ::: "memory");
            const unsigned og = xb_add(&bar[XB_TOP], 1u);
            const unsigned tg = og / nx;
            if (og + 1u == (tg + 1u) * nx) xb_add(&bar[XB_TOPGEN], 1u);
            else XB_SPIN(xb_ld(&bar[XB_TOPGEN]) == tg, bar);
            __builtin_amdgcn_fence(__ATOMIC_ACQUIRE, "agent");
            xb_add(&bar[XB_XGEN(b.x)], 1u);
            asm volatile("s_waitcnt vmcnt(0)" ::: "memory");
        } else {
            XB_SPIN(xb_ld(&bar[XB_XGEN(b.x)]) == gen, bar);
            __builtin_amdgcn_fence(__ATOMIC_ACQUIRE, "agent");
            asm volatile("s_waitcnt vmcnt(0)" ::: "memory");
        }
    }
    __syncthreads();
}
struct Args { const float* in[18]; float* out; unsigned char* ws; int ph_lo, ph_hi, li, sub; };
struct Frame {
    const Args* ka;
    LAS unsigned char* lds;
    volatile LAS unsigned* MISC;
    gu32* ctl;
    int wave;
    int vcu, G, li;
    unsigned char* ws;
    float* out;
};
__device__ __forceinline__ float wave_sum(float v) {
#pragma unroll
    for (int o = 1; o < 64; o <<= 1) v += __shfl_xor(v, o);
    return v;
}
__device__ __forceinline__ void p0_transpose_item(const float* W, int K, int N, bf16* WT, int k0, int n0, int dst_row0, LAS unsigned char* scr, int lane, int kdst = -1) {
    if (kdst < 0) kdst = k0;
    const int q = lane >> 4, m = lane & 15;
    const GAS f32x4* src = (const GAS f32x4*)(W + (size_t)(k0 + 2 * q) * N + n0) + m;
    f32x4 v[16];
#pragma unroll
    for (int i = 0; i < 16; ++i) v[i] = src[((size_t)(8 * (i >> 1) + (i & 1)) * N) >> 2];
#pragma unroll
    for (int j = 0; j < 8; ++j) {
#pragma unroll
        for (int c = 0; c < 4; ++c) {
            const int n = 4 * m + c, col = (4 * j + q) ^ ((m & 7) << 2);
            *(LAS unsigned*)(scr + n * 128 + col * 4) = pg8::cvt_pk_bf16(v[2 * j][c], v[2 * j + 1][c]);
        }
    }
    LDS_WAIT(); asm volatile("" ::: "memory");
    const int ch = lane & 7;
#pragma unroll
    for (int i = 0; i < 8; ++i) { const int n = 8 * i + (lane >> 3);
        const v4u o = *(const LAS v4u*)(scr + n * 128 + ((ch ^ ((n >> 2) & 7)) << 4));
        *(GAS v4u*)(WT + (size_t)(dst_row0 + n) * K + kdst + 8 * ch) = o; }
    LDS_WAIT(); asm volatile("" ::: "memory");
}
__device__ __forceinline__ void p0_item_load(const float* W, int N, int k0, int n0, int lane, f32x4 (&v)[16]) {
    const int q = lane >> 4, m = lane & 15;
    const GAS f32x4* src = (const GAS f32x4*)(W + (size_t)(k0 + 2 * q) * N + n0) + m;
#pragma unroll
    for (int i = 0; i < 16; ++i) v[i] = src[((size_t)(8 * (i >> 1) + (i & 1)) * N) >> 2];
}
__device__ __forceinline__ void p0_item_store(const f32x4 (&v)[16], int K, bf16* WT, int k0, int dst_row0, LAS unsigned char* scr, int lane) {
    const int q = lane >> 4, m = lane & 15;
#pragma unroll
    for (int j = 0; j < 8; ++j) {
#pragma unroll
        for (int c = 0; c < 4; ++c) {
            const int n = 4 * m + c, col = (4 * j + q) ^ ((m & 7) << 2);
            *(LAS unsigned*)(scr + n * 128 + col * 4) = pg8::cvt_pk_bf16(v[2 * j][c], v[2 * j + 1][c]);
        }
    }
    LDS_WAIT(); asm volatile("" ::: "memory");
    const int ch = lane & 7;
#pragma unroll
    for (int i = 0; i < 8; ++i) { const int n = 8 * i + (lane >> 3);
        const v4u o = *(const LAS v4u*)(scr + n * 128 + ((ch ^ ((n >> 2) & 7)) << 4));
        *(GAS v4u*)(WT + (size_t)(dst_row0 + n) * K + k0 + 8 * ch) = o; }
    LDS_WAIT(); asm volatile("" ::: "memory");
}
__device__ __forceinline__ void p0_item_store_fp8(const f32x4 (&v)[16], int K, unsigned char* WT, int k0, int dst_row0, LAS unsigned char* scr, int lane) {
    const int q = lane >> 4, m = lane & 15;
#pragma unroll
    for (int j = 0; j < 8; ++j) {
#pragma unroll
        for (int c = 0; c < 4; ++c) {
            const int n = 4 * m + c, kb = 8 * j + 2 * q;
            const int p = __builtin_amdgcn_cvt_pk_fp8_f32(v[2 * j][c] * pg8::WSCALE, v[2 * j + 1][c] * pg8::WSCALE, 0, false);
            *(LAS unsigned short*)(scr + n * 64 + ((((kb >> 4) ^ (m & 3)) << 4) | (kb & 15))) = (unsigned short)p;
        }
    }
    LDS_WAIT(); asm volatile("" ::: "memory");
    const int ch = lane & 3;
#pragma unroll
    for (int i = 0; i < 4; ++i) { const int n = 16 * i + (lane >> 2);
        const v4u o = *(const LAS v4u*)(scr + n * 64 + ((ch ^ ((n >> 2) & 3)) << 4));
        *(GAS v4u*)(WT + (size_t)(dst_row0 + n) * K + k0 + 16 * ch) = o; }
    LDS_WAIT(); asm volatile("" ::: "memory");
}
struct MoeItem { const float* W; bf16* WT; int K, N, k0, n0, drow, f8; };
__device__ __forceinline__ MoeItem moe_item(Frame& F, int r) {
    constexpr int I_GU1 = (DM / 64) * (2048 / 64), I_GU = NE * I_GU1, I_D1 = (DFF / 64) * (DM / 64);
    MoeItem it;
    if (r < I_GU) { const int e = r / I_GU1, q = r % I_GU1, nblk = 2048 / 64, kb = q / nblk, nb = q % nblk, n0 = 64 * nb, j = n0 & 1023, up = n0 >> 10;
        it.W = F.ka->in[16] + (size_t)e * DM * 2048; it.WT = (bf16*)(F.ws + WS_WGU + (size_t)e * 2048 * DM); it.K = DM; it.N = 2048; it.k0 = 64 * kb; it.n0 = n0; it.drow = 256 * (j >> 7) + 128 * up + (j & 127); it.f8 = 1; }
    else { r -= I_GU; const int e = r / I_D1, q = r % I_D1, nblk = DM / 64, kb = q / nblk, nb = q % nblk;
        it.W = F.ka->in[17] + (size_t)e * DFF * DM; it.WT = (bf16*)(F.ws + WS_WD + (size_t)e * DM * DFF); it.K = DFF; it.N = DM; it.k0 = 64 * kb; it.n0 = 64 * nb; it.drow = 64 * nb; it.f8 = 1; }
    return it;
}
__device__ __forceinline__ void p0_moe_weights(Frame& F, int gw, int NGW) {
    constexpr int NIT = NE * ((DM / 64) * (2048 / 64) + (DFF / 64) * (DM / 64));
    LAS unsigned char* scr = F.lds + RING_OFF + F.wave * 8192;
    f32x4 va[16], vb[16];
    int r = gw;
    if (r < NIT) { const MoeItem a = moe_item(F, r); p0_item_load(a.W, a.N, a.k0, a.n0, mk_lane(), va); }
    for (; r < NIT; r += 2 * NGW) {
        const MoeItem a = moe_item(F, r);
        const bool hb = r + NGW < NIT; MoeItem b = a;
        if (hb) { b = moe_item(F, r + NGW); p0_item_load(b.W, b.N, b.k0, b.n0, mk_lane(), vb); }
        if (a.f8) p0_item_store_fp8(va, a.K, (unsigned char*)a.WT, a.k0, a.drow, scr, mk_lane()); else p0_item_store(va, a.K, a.WT, a.k0, a.drow, scr, mk_lane());
        if (r + 2 * NGW < NIT) { const MoeItem c = moe_item(F, r + 2 * NGW); p0_item_load(c.W, c.N, c.k0, c.n0, mk_lane(), va); }
        if (hb) { if (b.f8) p0_item_store_fp8(vb, b.K, (unsigned char*)b.WT, b.k0, b.drow, scr, mk_lane()); else p0_item_store(vb, b.K, b.WT, b.k0, b.drow, scr, mk_lane()); }
    }
}
__device__ __forceinline__ void p0_prologue(Frame& F, int which, int gw, int NGW) {
    LAS unsigned char* scr = F.lds + RING_OFF + F.wave * 8192;
    constexpr int I_IN = (DM / 64) * (NIN / 64), I_A = (1024 / 64) * (DM / 64), I_B = (512 / 64) * (DM / 64), I_O = (DM / 64) * (DM / 64);
    constexpr int I_GU1 = (DM / 64) * (2048 / 64), I_GU = NE * I_GU1, I_D1 = (DFF / 64) * (DM / 64), I_D = NE * I_D1;
    constexpr int NITEMS = I_IN + I_A + I_B + I_O + I_GU + I_D;
    bf16* WIN = (bf16*)(F.ws + WS_WIN); bf16* WA = (bf16*)(F.ws + WS_WA); bf16* WB = (bf16*)(F.ws + WS_WB); bf16* WO = (bf16*)(F.ws + WS_WO); bf16* WGU = (bf16*)(F.ws + WS_WGU); bf16* WD = (bf16*)(F.ws + WS_WD);
    for (int it = gw; it < NITEMS; it += NGW) {
        int r = it;
        if (!(which & 1) && r < I_IN + I_A + I_B + I_O) continue;
        if (!(which & 2) && r >= I_IN + I_A + I_B + I_O) break;
        if (r < I_IN) { const int nblk = NIN / 64, kb = r / nblk, nb = r % nblk;
            const int n0 = 64 * nb, r8 = (n0 >= C_GA) ? n0 - C_GA : (n0 >= C_DAV && n0 < C_DLQ) ? 4096 + (n0 - C_DAV) : (n0 >= C_DLV) ? 5120 + (n0 - C_DLV) : -1;
            if (r8 < 0) p0_transpose_item(F.ka->in[2], DM, NIN, WIN, 64 * kb, n0, n0, scr, mk_lane());
            else { f32x4 v[16]; p0_item_load(F.ka->in[2], NIN, 64 * kb, n0, mk_lane(), v); p0_item_store_fp8(v, DM, (unsigned char*)(F.ws + WS_WIN8), 64 * kb, r8, scr, mk_lane()); }
            continue; } r -= I_IN;
        if (r < I_A)  { const int nblk = DM / 64, kb = r / nblk, nb = r % nblk; p0_transpose_item(F.ka->in[10], 1536, DM, WA, 64 * kb, 64 * nb, 64 * nb, scr, mk_lane()); continue; } r -= I_A;
        if (r < I_B)  { const int nblk = DM / 64, kb = r / nblk, nb = r % nblk; p0_transpose_item(F.ka->in[11], 1536, DM, WA, 64 * kb, 64 * nb, 64 * nb, scr, mk_lane(), 1024 + 64 * kb); continue; } r -= I_B;
        if (r < I_O)  { const int nblk = DM / 64, kb = r / nblk, nb = r % nblk; p0_transpose_item(F.ka->in[12], DM, DM, WO, 64 * kb, 64 * nb, 64 * nb, scr, mk_lane()); continue; } r -= I_O;
        if (r < I_GU) { const int e = r / I_GU1, q = r % I_GU1, nblk = 2048 / 64, kb = q / nblk, nb = q % nblk, n0 = 64 * nb, j = n0 & 1023, up = n0 >> 10;
                        p0_transpose_item(F.ka->in[16] + (size_t)e * DM * 2048, DM, 2048, WGU + (size_t)e * 2048 * DM, 64 * kb, n0, 256 * (j >> 7) + 128 * up + (j & 127), scr, mk_lane()); continue; } r -= I_GU;
        { const int e = r / I_D1, q = r % I_D1, nblk = DM / 64, kb = q / nblk, nb = q % nblk;
          p0_transpose_item(F.ka->in[17] + (size_t)e * DFF * DM, DFF, DM, WD + (size_t)e * DM * DFF, 64 * kb, 64 * nb, 64 * nb, scr, mk_lane()); }
    }
    bf16* XN = (bf16*)(F.ws + WS_XN);
    if (which & 4) {
        f32x4 g[8];
#pragma unroll
        for (int j = 0; j < 8; ++j) g[j] = *((const GAS f32x4*)F.ka->in[1] + mk_lane() + 64 * j);
        for (int m = gw; m < M; m += 2 * NGW) {
            const int m2 = (m + NGW < M) ? m + NGW : m;
            const GAS f32x4* xr = (const GAS f32x4*)(F.ka->in[0] + (size_t)m * DM) + mk_lane(); const GAS f32x4* xr2 = (const GAS f32x4*)(F.ka->in[0] + (size_t)m2 * DM) + mk_lane();
            f32x4 v[8], w[8]; float s = 0.f, s2 = 0.f;
#pragma unroll
            for (int j = 0; j < 8; ++j) { v[j] = xr[64 * j]; w[j] = xr2[64 * j]; }
#pragma unroll
            for (int j = 0; j < 8; ++j) { s += (v[j].x * v[j].x + v[j].y * v[j].y) + (v[j].z * v[j].z + v[j].w * v[j].w); s2 += (w[j].x * w[j].x + w[j].y * w[j].y) + (w[j].z * w[j].z + w[j].w * w[j].w); }
            const float rstd = 1.0f / sqrtf(wave_sum(s) * (1.f / DM) + EPS), rstd2 = 1.0f / sqrtf(wave_sum(s2) * (1.f / DM) + EPS);
            GAS unsigned long long* o8 = (GAS unsigned long long*)(XN + (size_t)m * DM) + mk_lane(); GAS unsigned long long* o82 = (GAS unsigned long long*)(XN + (size_t)m2 * DM) + mk_lane();
            GAS unsigned* q8 = (GAS unsigned*)((unsigned char*)(F.ws + WS_XN8) + (size_t)m * DM) + mk_lane(); GAS unsigned* q82 = (GAS unsigned*)((unsigned char*)(F.ws + WS_XN8) + (size_t)m2 * DM) + mk_lane();
#pragma unroll
            for (int j = 0; j < 8; ++j) { const f32x4 t = v[j] * rstd * g[j]; o8[64 * j] = (unsigned long long)pk2(t.x, t.y) | ((unsigned long long)pk2(t.z, t.w) << 32); q8[64 * j] = pg8::pk_fp8x4(t.x * pg8::XSCALE, t.y * pg8::XSCALE, t.z * pg8::XSCALE, t.w * pg8::XSCALE);
                                          const f32x4 t2 = w[j] * rstd2 * g[j]; o82[64 * j] = (unsigned long long)pk2(t2.x, t2.y) | ((unsigned long long)pk2(t2.z, t2.w) << 32); q82[64 * j] = pg8::pk_fp8x4(t2.x * pg8::XSCALE, t2.y * pg8::XSCALE, t2.z * pg8::XSCALE, t2.w * pg8::XSCALE); }
        }
    }
    if ((which & 4) && F.vcu == 0 && (F.wave * 64 + mk_lane()) < 384) { float* GN = (float*)(F.ws + WS_GAIN); const int t = (F.wave * 64 + mk_lane()); GN[t] = (t < 64) ? F.ka->in[3][t] : (t < 128) ? F.ka->in[4][t - 64] : (t < 256) ? F.ka->in[8][t - 128] : F.ka->in[9][t - 256]; }
    if (which & 4) { float* WR = (float*)(F.ws + WS_WR);
      for (int i = (F.vcu * NWAVES * 64) + (F.wave * 64 + mk_lane()); i < DM * 48; i += F.G * NWAVES * 64) { const int k = i / 48, c = i % 48; const float gn = F.ka->in[13][k];
          WR[i] = (c < 32) ? F.ka->in[15][k * 32 + c] * gn : (c < 36) ? F.ka->in[14][k * 4 + (c - 32)] * gn : 0.f; } }
}
__device__ __forceinline__ void p2_attention(Frame& F, int which) {
    const bf16* PROJ = (const bf16*)(F.ws + WS_PROJ);
    bf16* ODA = (bf16*)(F.ws + WS_ODA); bf16* ODL = (bf16*)(F.ws + WS_ODL); float* LSE = (float*)(F.ws + WS_LSE);
    float gq = fabsf(F.ka->in[3][mk_lane()]), gk = fabsf(F.ka->in[4][mk_lane()]);
#pragma unroll
    for (int o = 1; o < 64; o <<= 1) { gq = fmaxf(gq, __shfl_xor(gq, o)); gk = fmaxf(gk, __shfl_xor(gk, o)); }
    const float Bq = 8.0f * gq * gk * 1.02f;
    float g1 = fmaxf(fabsf(F.ka->in[8][mk_lane()]), fabsf(F.ka->in[8][64 + mk_lane()])), g2 = fmaxf(fabsf(F.ka->in[9][mk_lane()]), fabsf(F.ka->in[9][64 + mk_lane()]));
#pragma unroll
    for (int o = 1; o < 64; o <<= 1) { g1 = fmaxf(g1, __shfl_xor(g1, o)); g2 = fmaxf(g2, __shfl_xor(g2, o)); }
    const float Bl = 11.313708f * g1 * g2 * 1.02f;
    volatile LAS int* QW = (volatile LAS int*)(F.MISC + 16);
    for (;;) {
        if ((F.wave * 64 + mk_lane()) == 0) QW[0] = (int)atomicAdd((unsigned*)(F.ctl + CW_QUEUE) + 64 * F.li, 1u);
        __syncthreads();
        const int u = __builtin_amdgcn_readfirstlane(QW[0]);
        if (u >= 1024 + 768) break;
        if (u < 1024) {
            const int h = 7 - (u >> 7), rem = u & 127, b = rem >> 6, mp = (rem >> 5) & 1, qb = 31 - (rem & 31);
            const float slope = exp2f(-(float)(h + 1));
            const float Df = (2.0f * Bq + logf(1.0f / slope) + 30.0f) / slope;
            const int Dk = (Df < 1.0e6f) ? (int)Df + 1 : (1 << 20);
            int t_lo = (256 * qb - Dk) >> 6; if (t_lo < 0) t_lo = 0;
            if (which & 1)
            att::attn_unit<64>(PROJ + pg8::PJ_QA + (size_t)((b * 8 + h) * 2 + mp) * SEQ * 64, PROJ + pg8::PJ_KA + (size_t)((b * 8 + h) * 2 + mp) * SEQ * 64, PROJ + pg8::PJ_VA + (size_t)(b * 8 + h) * SEQ * 128,
                               256 * qb, t_lo, 4 * (qb + 1), 1 << 30, Dk, slope * LOG2E, Bq * LOG2E - 20.0f,
                               ODA + (size_t)mp * M * 1024 + (size_t)b * SEQ * 1024 + h * 128, 1024L, nullptr, 0L, F.lds + RING_OFF, (LAS float*)(F.lds + XCH_OFF), F.wave, (u == MK_DBG_UNIT) ? (unsigned*)(F.ctl + CW_DBG) : nullptr);
        } else {
            const int v = u - 1024, b = v / 384, rem = v % 384, g = rem / 128, rem2 = rem % 128, h = rem2 / 32, j = rem2 % 32;
            const int d = (g == 0) ? 1 : (g == 1) ? 4 : 16, nblk = 32 / d, r = j / nblk, iblk = j % nblk, hh = g * 4 + h;
            const size_t hoff = ((size_t)(b * 12 + hh) * SEQ + (size_t)r * (SEQ / d)) * 128;
            const float slope2 = exp2f(-8.0f * (float)(hh + 1) / 12.0f) * (float)d * LOG2E;
            if (which & 2)
            att::attn_unit<128>(PROJ + pg8::PJ_QL + hoff, PROJ + pg8::PJ_KL + hoff, PROJ + pg8::PJ_VL + hoff, 256 * iblk, (4 * iblk - 2 < 0) ? 0 : 4 * iblk - 2, 4 * iblk + 4, 128, 128, slope2, Bl * LOG2E - 20.0f,
                                ODL + (size_t)g * M * 512 + ((size_t)b * SEQ + r) * 512 + h * 128, 512L * d, LSE + (size_t)g * M * 4 + ((size_t)b * SEQ + r) * 4 + h, 4L * d, F.lds + RING_OFF, (LAS float*)(F.lds + XCH_OFF), F.wave);
        }
        __syncthreads();
    }
}
__device__ __forceinline__ void p3_merge(Frame& F) {
    const int gw = F.vcu * NWAVES + F.wave, NGW = F.G * NWAVES, lane = mk_lane();
    const bf16* ODA = (const bf16*)(F.ws + WS_ODA); const bf16* ODL = (const bf16*)(F.ws + WS_ODL); const float* LSE = (const float*)(F.ws + WS_LSE);
    bf16* OA = (bf16*)(F.ws + WS_OA); bf16* OB = (bf16*)(F.ws + WS_OB);
    const float s0 = wave_sum(F.ka->in[5][lane] * F.ka->in[6][lane]), s1 = wave_sum(F.ka->in[5][64 + lane] * F.ka->in[6][64 + lane]);
    const float lam = expf(s0) - expf(s1) + LAM_INIT;
    float sg[16];
#pragma unroll
    for (int j = 0; j < 16; ++j) sg[j] = F.ka->in[7][(lane & 7) * 16 + j] * (1.0f - LAM_INIT);
    for (int m = gw; m < M; m += NGW) {
        {
            const v4u* p0 = (const v4u*)(ODA + (size_t)m * 1024 + lane * 16); const v4u* p1 = (const v4u*)(ODA + (size_t)M * 1024 + (size_t)m * 1024 + lane * 16);
            float a[16], b[16]; pg8::unpack8(p0[0], *(float(*)[8])&a[0]); pg8::unpack8(p0[1], *(float(*)[8])&a[8]); pg8::unpack8(p1[0], *(float(*)[8])&b[0]); pg8::unpack8(p1[1], *(float(*)[8])&b[8]);
            float ss = 0.f;
#pragma unroll
            for (int j = 0; j < 16; ++j) { a[j] = a[j] - lam * b[j]; ss += a[j] * a[j]; }
            ss += __shfl_xor(ss, 1); ss += __shfl_xor(ss, 2); ss += __shfl_xor(ss, 4);
            const float rstd = 1.0f / sqrtf(ss * (1.f / 128.f) + EPS);
            v4u o0, o1;
            o0.x = pk2(a[0] * rstd * sg[0], a[1] * rstd * sg[1]); o0.y = pk2(a[2] * rstd * sg[2], a[3] * rstd * sg[3]); o0.z = pk2(a[4] * rstd * sg[4], a[5] * rstd * sg[5]); o0.w = pk2(a[6] * rstd * sg[6], a[7] * rstd * sg[7]);
            o1.x = pk2(a[8] * rstd * sg[8], a[9] * rstd * sg[9]); o1.y = pk2(a[10] * rstd * sg[10], a[11] * rstd * sg[11]); o1.z = pk2(a[12] * rstd * sg[12], a[13] * rstd * sg[13]); o1.w = pk2(a[14] * rstd * sg[14], a[15] * rstd * sg[15]);
            v4u* q = (v4u*)(OA + (size_t)m * 1536 + lane * 16); q[0] = o0; q[1] = o1;
        }
        {
            const int h = lane >> 4;
            const float l0 = LSE[(size_t)m * 4 + h], l1 = LSE[(size_t)M * 4 + (size_t)m * 4 + h], l2 = LSE[(size_t)2 * M * 4 + (size_t)m * 4 + h];
            const float mx = fmaxf(l0, fmaxf(l1, l2)); float w0 = exp2f(l0 - mx), w1 = exp2f(l1 - mx), w2 = exp2f(l2 - mx); const float inv = 1.0f / (w0 + w1 + w2); w0 *= inv; w1 *= inv; w2 *= inv;
            float a[8], b[8], c[8];
            pg8::unpack8(*(const v4u*)(ODL + (size_t)m * 512 + lane * 8), a); pg8::unpack8(*(const v4u*)(ODL + (size_t)M * 512 + (size_t)m * 512 + lane * 8), b); pg8::unpack8(*(const v4u*)(ODL + (size_t)2 * M * 512 + (size_t)m * 512 + lane * 8), c);
            v4u o;
            o.x = pk2(w0 * a[0] + w1 * b[0] + w2 * c[0], w0 * a[1] + w1 * b[1] + w2 * c[1]); o.y = pk2(w0 * a[2] + w1 * b[2] + w2 * c[2], w0 * a[3] + w1 * b[3] + w2 * c[3]);
            o.z = pk2(w0 * a[4] + w1 * b[4] + w2 * c[4], w0 * a[5] + w1 * b[5] + w2 * c[5]); o.w = pk2(w0 * a[6] + w1 * b[6] + w2 * c[6], w0 * a[7] + w1 * b[7] + w2 * c[7]);
            *(v4u*)(OA + (size_t)m * 1536 + 1024 + lane * 8) = o;
        }
    }
}
__device__ __forceinline__ f32x4 bf4_to_f32(unsigned long long a) {
    f32x4 r; r.x = __uint_as_float((unsigned)a << 16); r.y = __uint_as_float((unsigned)a & 0xffff0000u); r.z = __uint_as_float((unsigned)(a >> 32) << 16); r.w = __uint_as_float((unsigned)(a >> 32) & 0xffff0000u); return r; }
__device__ __forceinline__ void p7_router(Frame& F) {
    typedef float f32x4v __attribute__((ext_vector_type(4)));
    LAS float* LG = (LAS float*)(F.lds);
    LAS float* SS = (LAS float*)(F.lds + 98304);
    LAS float* RS = (LAS float*)(F.lds + 25088);
    const float* WR = (const float*)(F.ws + WS_WR);
    int* EIDX = (int*)(F.ws + WS_ROUTE); float* EW = (float*)(F.ws + WS_ROUTE + 131072); int* POS = (int*)(F.ws + WS_ROUTE + 262144); int* LIST = (int*)(F.ws + WS_LIST); float* RSL = (float*)(F.ws + WS_RSL);
    unsigned char* XQ = (unsigned char*)(F.ws + WS_XS);
    bf16* XN2 = (bf16*)(F.ws + WS_XN); const bf16* DELTA = (const bf16*)(F.ws + WS_ODA);
    const int lane = mk_lane(), wave = F.wave, i = lane & 15, kq = lane >> 4;
    for (int it = F.vcu; it < M / 64; it += F.G) {
        const int row0 = 64 * it;
        const size_t eo = (size_t)(row0 + i) * DM + 256 * wave + 16 * kq;
        const float* xr = F.ka->in[0] + eo;
        const bf16* dr = DELTA + eo;
        const float* gp = F.ka->in[13] + 256 * wave + 16 * kq;
        unsigned char* xq = XQ + eo;
        const float* wr = WR + (size_t)(256 * wave + 16 * kq) * 48 + i;
        f32x4v a[4][3]; float ssq[4];
#pragma unroll
        for (int g4 = 0; g4 < 4; ++g4) { ssq[g4] = 0.f;
#pragma unroll
            for (int j = 0; j < 3; ++j) a[g4][j] = (f32x4v){0.f, 0.f, 0.f, 0.f}; }
        float wv[4][4][3]; f32x4 gv[4]; f32x4 xc[4]; unsigned long long dc[4];
#pragma unroll
        for (int tt = 0; tt < 4; ++tt) { xc[tt] = *(const f32x4*)(xr + 4 * tt); dc[tt] = *(const unsigned long long*)(dr + 4 * tt); gv[tt] = *(const f32x4*)(gp + 4 * tt);
#pragma unroll
            for (int c = 0; c < 4; ++c) { const float* w = wr + (size_t)(4 * tt + c) * 48; wv[tt][c][0] = w[0]; wv[tt][c][1] = w[16]; wv[tt][c][2] = w[32]; } }
#pragma unroll 1
        for (int T = 0; T < 4; ++T) {
            const int Tn = (T < 3) ? T + 1 : 3;
#pragma unroll
            for (int g4 = 0; g4 < 4; ++g4) {
                f32x4 xn[4]; unsigned long long dn[4];
                { const size_t no = (g4 < 3) ? (size_t)(16 * (g4 + 1)) * DM + 64 * T : (size_t)64 * Tn;
#pragma unroll
                  for (int tt = 0; tt < 4; ++tt) { xn[tt] = *(const f32x4*)(xr + no + 4 * tt); dn[tt] = *(const unsigned long long*)(dr + no + 4 * tt); } }
                v4u q;
#pragma unroll
                for (int tt = 0; tt < 4; ++tt) {
                    const f32x4 xv = xc[tt] + bf4_to_f32(dc[tt]); const f32x4 gs = gv[tt] * pg8::XSCALE;
                    ssq[g4] += (xv.x * xv.x + xv.y * xv.y) + (xv.z * xv.z + xv.w * xv.w);
                    q[tt] = pg8::pk_fp8x4(xv.x * gs.x, xv.y * gs.y, xv.z * gs.z, xv.w * gs.w);
#pragma unroll
                    for (int c = 0; c < 4; ++c) { const float xa = xv[c];
                        a[g4][0] = __builtin_amdgcn_mfma_f32_16x16x4f32(xa, wv[tt][c][0], a[g4][0], 0, 0, 0); a[g4][1] = __builtin_amdgcn_mfma_f32_16x16x4f32(xa, wv[tt][c][1], a[g4][1], 0, 0, 0); a[g4][2] = __builtin_amdgcn_mfma_f32_16x16x4f32(xa, wv[tt][c][2], a[g4][2], 0, 0, 0); }
                    if (g4 == 3) {
                        gv[tt] = *(const f32x4*)(gp + 64 * Tn + 4 * tt);
#pragma unroll
                        for (int c = 0; c < 4; ++c) { const float* w = wr + (size_t)(64 * Tn + 4 * tt + c) * 48; wv[tt][c][0] = w[0]; wv[tt][c][1] = w[16]; wv[tt][c][2] = w[32]; }
                    }
                }
                *(v4u*)(xq + (size_t)(16 * g4) * DM + 64 * T) = q;
#pragma unroll
                for (int tt = 0; tt < 4; ++tt) { xc[tt] = xn[tt]; dc[tt] = dn[tt]; }
            }
        }
#pragma unroll
        for (int g4 = 0; g4 < 4; ++g4) { float s = ssq[g4]; s += __shfl_xor(s, 16); s += __shfl_xor(s, 32);
#pragma unroll
            for (int reg = 0; reg < 4; ++reg) { LAS float* p = LG + (wave * 64 + 16 * g4 + 4 * kq + reg) * 48 + i; p[0] = a[g4][0][reg]; p[16] = a[g4][1][reg]; p[32] = a[g4][2][reg]; }
            if (kq == 0) SS[wave * 64 + 16 * g4 + i] = s; }
        __syncthreads();
        if ((F.wave * 64 + mk_lane()) < 64) {
            const int r = (F.wave * 64 + mk_lane());
            float sst = 0.f;
#pragma unroll
            for (int w8 = 0; w8 < 8; ++w8) sst += SS[w8 * 64 + r];
            const float rstd = 1.0f / sqrtf(sst * (1.f / DM) + EPS);
            const LAS float* l0 = LG + r * 48;
#define P7_L(c) (((l0[(c)] + l0[64 * 48 + (c)]) + (l0[2 * 64 * 48 + (c)] + l0[3 * 64 * 48 + (c)])) + ((l0[4 * 64 * 48 + (c)] + l0[5 * 64 * 48 + (c)]) + (l0[6 * 64 * 48 + (c)] + l0[7 * 64 * 48 + (c)])))
            float gl[4];
#pragma unroll
            for (int j = 0; j < 4; ++j) gl[j] = P7_L(32 + j) * rstd;
            int g = 0; float gmax = gl[0];
#pragma unroll
            for (int j = 1; j < 4; ++j) if (gl[j] > gmax) { gmax = gl[j]; g = j; }
            float gs = 0.f;
#pragma unroll
            for (int j = 0; j < 4; ++j) gs += expf(gl[j] - gmax);
            const float gw = 1.0f / gs;
            float t0 = -INFINITY, t1 = -INFINITY; int i0 = 0, i1 = 0;
#pragma unroll
            for (int j = 0; j < 8; ++j) { const float v = P7_L(8 * g + j) * rstd;
                if (v > t0) { t1 = t0; i1 = i0; t0 = v; i0 = j; } else if (v > t1) { t1 = v; i1 = j; } }
            const float e1 = expf(t1 - t0), w0 = gw / (1.0f + e1), w1 = gw * e1 / (1.0f + e1);
            const int e0i = 8 * g + i0, e1i = 8 * g + i1, row = row0 + r;
            EIDX[2 * row] = e0i; EIDX[2 * row + 1] = e1i; EW[2 * row] = w0; EW[2 * row + 1] = w1;
            if (!(MK_SPLIT_AT == 7 && F.li == 1)) {
                const int p0 = (int)atomicAdd((unsigned*)(F.ctl + CW_CNT) + e0i, 1u), p1 = (int)atomicAdd((unsigned*)(F.ctl + CW_CNT) + e1i, 1u);
                LIST[(size_t)e0i * M + p0] = row; LIST[(size_t)e1i * M + p1] = row; POS[2 * row] = p0; POS[2 * row + 1] = p1;
                RSL[(size_t)e0i * M + p0] = rstd; RSL[(size_t)e1i * M + p1] = rstd;
            }
        }
        __syncthreads();
        __syncthreads();
    }
#undef P7_L
}
__device__ __forceinline__ void build_tables(Frame& F, LAS int* PS, LAS int* CN, LAS int* TE) {
    if ((F.wave * 64 + mk_lane()) == 0) {
        int acc = 0, t = 0;
        for (int e = 0; e < NE; ++e) { PS[e] = acc; const int c = (int)__hip_atomic_load(F.ctl + CW_CNT + e, RLX_AGENT); CN[e] = c; const int nt = (c + 255) >> 8; for (int k = 0; k < nt; ++k) TE[t++] = e; acc += nt << 8; }
        PS[NE] = acc; TE[160] = t;
    }
    __syncthreads();
}
__device__ __forceinline__ void p11_combine(Frame& F) {
    const int gw = F.vcu * NWAVES + F.wave, NGW = F.G * NWAVES, lane = mk_lane();
    const float* EW = (const float*)(F.ws + WS_ROUTE + 131072); const int* POS = (const int*)(F.ws + WS_ROUTE + 262144); const int* EIDX = (const int*)(F.ws + WS_ROUTE);
    const LAS int* PS = (const LAS int*)(F.lds + XCH_OFF);
    const unsigned char* Y = (const unsigned char*)(F.ws + WS_Y8); const bf16* DELTA = (const bf16*)(F.ws + WS_ODA);
    typedef float f32x2c __attribute__((ext_vector_type(2)));
    for (int m = gw; m < M; m += NGW) {
        const int s0 = PS[EIDX[2 * m]] + POS[2 * m], s1 = PS[EIDX[2 * m + 1]] + POS[2 * m + 1]; const float w0 = EW[2 * m] * (1.0f / pg8::YSCALE), w1 = EW[2 * m + 1] * (1.0f / pg8::YSCALE);
        GAS f32x4* op = (GAS f32x4*)(F.out + (size_t)m * DM) + lane; const GAS f32x4* xp = (const GAS f32x4*)(F.ka->in[0] + (size_t)m * DM) + lane; const GAS unsigned long long* dp = (const GAS unsigned long long*)(DELTA + (size_t)m * DM) + lane;
        const GAS unsigned* y0 = (const GAS unsigned*)(Y + (size_t)s0 * DM) + lane; const GAS unsigned* y1 = (const GAS unsigned*)(Y + (size_t)s1 * DM) + lane;
#pragma unroll
        for (int j = 0; j < 8; ++j) { f32x4 v = xp[64 * j] + bf4_to_f32(dp[64 * j]); const unsigned a = y0[64 * j], b = y1[64 * j];
            const f32x2c a0 = __builtin_amdgcn_cvt_pk_f32_fp8((int)a, false), a1 = __builtin_amdgcn_cvt_pk_f32_fp8((int)a, true), b0 = __builtin_amdgcn_cvt_pk_f32_fp8((int)b, false), b1 = __builtin_amdgcn_cvt_pk_f32_fp8((int)b, true);
            v.x += w0 * a0.x + w1 * b0.x; v.y += w0 * a0.y + w1 * b0.y; v.z += w0 * a1.x + w1 * b1.x; v.w += w0 * a1.y + w1 * b1.y;
            op[64 * j] = v; }
    }
}

__global__ void __launch_bounds__(NWAVES * 64, 2) mk_fwd(Args args) {
    extern __shared__ __attribute__((aligned(16))) unsigned char lds[];
    Frame F;
    F.lds = (LAS unsigned char*)lds;
    F.MISC = (volatile LAS unsigned*)(F.lds + MISC_OFF);
    F.wave = __builtin_amdgcn_readfirstlane((int)threadIdx.x >> 6);
    F.G = gridDim.x; { const int bx = blockIdx.x; F.vcu = (F.G % 8 == 0) ? (bx % 8) * (F.G / 8) + bx / 8 : bx; }
    F.ws = args.ws; F.ctl = (gu32*)(args.ws + WS_CTL); F.out = args.out; F.li = args.li;
    F.ka = &args;
    for (int u = (F.wave * 64 + mk_lane()); u < (LDS_BYTES - LDSCTL_OFF) / 4; u += NWAVES * 64) ((LAS unsigned*)(F.lds + LDSCTL_OFF))[u] = 0u;
    __syncthreads();
    XcdBarrier bar; bar.bar = (unsigned*)(F.ctl + CW_BAR) + args.li * XCD_BAR_WORDS; bar.x = 0; bar.st = nullptr; bar.w0 = 0;
    if (MK_N_LAUNCHES == 1) bar = xcd_barrier_post((unsigned*)(F.ctl + CW_BAR) + args.li * XCD_BAR_WORDS, F.MISC + 8, F.wave == 0 ? 1u : 0u);
    const int lo = args.ph_lo, hi = args.ph_hi;
#define IN(k) (lo <= (k) && (k) < hi)
#define SEAM(k) do { if (IN(k) && IN((k) + 1)) xcd_barrier(bar); } while (0)
    bf16* XN = (bf16*)(F.ws + WS_XN); bf16* PROJ = (bf16*)(F.ws + WS_PROJ); bf16* MIX = (bf16*)(F.ws + WS_MIX);

    #ifndef MK_NCONV
#define MK_NCONV 80
#endif
    const bool conv_wg = (F.G == 256) && ((int)blockIdx.x >> 3) >= 32 - MK_NCONV / 8; const int conv_idx = ((int)blockIdx.x & 7) * (MK_NCONV / 8) + (((int)blockIdx.x >> 3) - (32 - MK_NCONV / 8));
    if (IN(0)) { p0_prologue(F, ((args.li == 1) ? args.sub : 7) & ((F.G == 256) ? 5 : 7), F.vcu * NWAVES + F.wave, F.G * NWAVES); } SEAM(0);
    if (IN(1)) {
        if (conv_wg && !(MK_SPLIT_AT == 1 && args.li == 1)) { p0_moe_weights(F, conv_idx * NWAVES + F.wave, MK_NCONV * NWAVES); __syncthreads(); }
        pg8::EpiProj E{PROJ, (const float*)(F.ws + WS_GAIN), (LAS float*)(F.lds + XCH_OFF), 0.125f * LOG2E, 0.08838834764831845f * LOG2E, EPS};
        if (F.G == 256) {
            { pg8::Gemm g{XN, (const bf16*)(F.ws + WS_WIN), M, C_GA, DM, 0};
              pg8::TicketOrder S{(unsigned*)(F.ctl + CW_TQ) + 64 * ((int)blockIdx.x & 7) + 1024 * F.li, (int)blockIdx.x & 7, 8 * 20, (volatile LAS int*)(F.MISC + 20), F.wave, 1};
              pg8::gemm_phase<pg8::EpiProj, pg8::TicketOrder, true, true>(F.wave, F.lds + RING_OFF, g, S, E); }
            { pg8::Gemm g{(const bf16*)(F.ws + WS_XN8), (const bf16*)(F.ws + WS_WIN8), M, 6656, DM / 2, 0};
              pg8::TicketOrder S{(unsigned*)(F.ctl + CW_TQ) + 512 + 64 * ((int)blockIdx.x & 7) + 1024 * F.li, (int)blockIdx.x & 7, 8 * 26, (volatile LAS int*)(F.MISC + 22), F.wave, 0};
              pg8::EpiGateSig EG{(unsigned char*)(PROJ + pg8::PJ_G), 1.0f / (pg8::XSCALE * pg8::WSCALE), PROJ};
              pg8::gemm_phase<pg8::EpiGateSig, pg8::TicketOrder, true, true, false, true>(F.wave, F.lds + RING_OFF, g, S, EG); }
        } else {
            pg8::Gemm g{XN, (const bf16*)(F.ws + WS_WIN), M, C_GA, DM, 0}; pg8::SkipOrder S0; S0.base.init(M, 20 * 256, F.G, (int)blockIdx.x); pg8::gemm_phase<pg8::EpiProj, pg8::SkipOrder, true, true>(F.wave, F.lds + RING_OFF, g, S0, E);
            pg8::Gemm g2{(const bf16*)(F.ws + WS_XN8), (const bf16*)(F.ws + WS_WIN8), M, 6656, DM / 2, 0}; pg8::StaticOrder S1; S1.init(M, 6656, F.G, (int)blockIdx.x);
            pg8::EpiGateSig EG{(unsigned char*)(PROJ + pg8::PJ_G), 1.0f / (pg8::XSCALE * pg8::WSCALE), PROJ}; pg8::gemm_phase<pg8::EpiGateSig, pg8::StaticOrder, true, true, false, true>(F.wave, F.lds + RING_OFF, g2, S1, EG);
        }
    } SEAM(1);
    if (IN(2)) { p2_attention(F, (args.li == 1 && lo == 2) ? args.sub : 3); } SEAM(2);
    if (IN(3)) { p3_merge(F); } SEAM(3);
    if (IN(4)) {
        pg8::Gemm g{(const bf16*)(F.ws + WS_OA), (const bf16*)(F.ws + WS_WA), M, DM, 1536, 0}; pg8::MixOrder S; S.base.init(M, DM, F.G, (int)blockIdx.x);
        pg8::EpiMix E{MIX, DM, (const unsigned char*)(PROJ + pg8::PJ_G)};
        pg8::gemm_phase<pg8::EpiMix, pg8::MixOrder, true, true>(F.wave, F.lds + RING_OFF, g, S, E);
    }
    if (IN(4) && IN(6)) xcd_barrier(bar);
    if (IN(6)) {
        pg8::Gemm g{MIX, (const bf16*)(F.ws + WS_WO), M, DM, DM, 0}; pg8::StaticOrder S; S.init(M, DM, F.G, (int)blockIdx.x);
        pg8::EpiPlain E{(bf16*)(F.ws + WS_ODA), DM, 1.0f};
        pg8::gemm_phase<pg8::EpiPlain, pg8::StaticOrder, true, true>(F.wave, F.lds + RING_OFF, g, S, E);
    } SEAM(6);
    if (IN(7)) { p7_router(F); }
    if (IN(7) && (IN(8) || IN(9))) xcd_barrier(bar);
    LAS int* TE = (LAS int*)(F.lds + TILE_E_OFF); LAS int* PS = (LAS int*)(F.lds + XCH_OFF); LAS int* CN = (LAS int*)(F.lds + XCH_OFF + 256);
    if (hi > 8 && lo <= 11) build_tables(F, PS, CN, TE);
    if (IN(9)) {
        pg8::Gemm g{(const bf16*)(F.ws + WS_XS), (const bf16*)(F.ws + WS_WGU), M, 2048, DM / 2, (size_t)2048 * DM};
        pg8::GroupOrder S{TE[160], F.G, (int)blockIdx.x, TE, PS, CN, (const int*)(F.ws + WS_LIST), M};
        pg8::EpiSwiglu E{(unsigned char*)(F.ws + WS_HB), DFF, 1.0f / (pg8::XSCALE * pg8::WSCALE), (const float*)(F.ws + WS_RSL), PS, M};
        pg8::gemm_phase<pg8::EpiSwiglu, pg8::GroupOrder, true, true, true, true>(F.wave, F.lds + RING_OFF, g, S, E);
    } SEAM(9);
    if (IN(10)) {
        pg8::Gemm g{(const bf16*)(F.ws + WS_HB), (const bf16*)(F.ws + WS_WD), XS_ROWS, DM, DFF / 2, (size_t)DM * DFF};
        pg8::GroupOrder S{TE[160], F.G, (int)blockIdx.x, TE, PS, CN, (const int*)(F.ws + WS_LIST), M};
        pg8::EpiFp8 E{(unsigned char*)(F.ws + WS_Y8), DM, pg8::YSCALE / (pg8::HSCALE * pg8::WSCALE)};
        pg8::gemm_phase<pg8::EpiFp8, pg8::GroupOrder, true, true, false, true>(F.wave, F.lds + RING_OFF, g, S, E);
    } SEAM(10);
    if (IN(11)) { p11_combine(F); }
#undef IN
#undef SEAM
}

extern "C" void kernel_launch(void* const* d_in, const int* in_sizes, int n_in, void* d_out, int out_size, void* d_ws, size_t ws_size, hipStream_t stream) {
    static int grid = 0;
    if (grid == 0) {
        if (n_in != 18 || out_size != M * DM || ws_size < WS_END) { fprintf(stderr, "kernel_launch: unexpected problem shape or workspace (%d inputs, out %d, ws %zu < %zu)\n", n_in, out_size, ws_size, (size_t)WS_END); grid = -1; return; }
        int dev = 0, cus = 0, per_cu = 0;
        if (hipGetDevice(&dev) != hipSuccess || hipDeviceGetAttribute(&cus, hipDeviceAttributeMultiprocessorCount, dev) != hipSuccess) { grid = -1; return; }
        if (hipFuncSetAttribute((const void*)mk_fwd, hipFuncAttributeMaxDynamicSharedMemorySize, LDS_BYTES) != hipSuccess) { fprintf(stderr, "kernel_launch: hipFuncSetAttribute failed\n"); grid = -1; return; }
        if (hipOccupancyMaxActiveBlocksPerMultiprocessor(&per_cu, (const void*)mk_fwd, NWAVES * 64, LDS_BYTES) != hipSuccess || per_cu < 1) { fprintf(stderr, "kernel_launch: occupancy query says %d blocks per CU\n", per_cu); (void)hipGetLastError(); grid = -1; return; }
        grid = cus;
        if (grid != 256) fprintf(stderr, "kernel_launch: %d CUs (tuned for 256)\n", grid);
    }
    if (grid < 0) return;
    (void)hipMemsetAsync((char*)d_ws + WS_CTL, 0, CTL_ZERO_BYTES, stream);
    Args a{};
    for (int i = 0; i < 18; ++i) a.in[i] = (const float*)d_in[i];
    a.out = (float*)d_out; a.ws = (unsigned char*)d_ws;
    if (MK_N_LAUNCHES == 1) {
        if (MK_SPLIT_AT >= 0) {
            a.ph_lo = 0; a.ph_hi = MK_SPLIT_AT + 1 + (MK_SPLIT_AT == 4 ? 1 : 0); a.li = 0; a.sub = 3;
            hipLaunchKernelGGL(mk_fwd, dim3(grid), dim3(NWAVES * 64), LDS_BYTES, stream, a);
            a.ph_lo = MK_SPLIT_AT; a.ph_hi = N_PHASES; a.li = 1; a.sub = MK_REPEAT_SUB;
            hipLaunchKernelGGL(mk_fwd, dim3(grid), dim3(NWAVES * 64), LDS_BYTES, stream, a);
            return;
        }
        a.ph_lo = 0; a.ph_hi = N_PHASES; a.li = 0; a.sub = 3;
        hipLaunchKernelGGL(mk_fwd, dim3(grid), dim3(NWAVES * 64), LDS_BYTES, stream, a);
    } else {
        for (int p = 0; p < N_PHASES; ++p) {
            if (p == 5) continue;
            a.ph_lo = p; a.ph_hi = (p == 4) ? 6 : p + 1; a.li = 0; a.sub = 3;
            hipLaunchKernelGGL(mk_fwd, dim3(grid), dim3(NWAVES * 64), LDS_BYTES, stream, a);
        }
    }
}
```

```cpp
#include <hip/hip_runtime.h>
#include <cstdio>
#include <cstdint>
#ifndef MK_EPI2
#define MK_EPI2 0
#endif
#ifndef MK_DBG
#define MK_DBG 0
#endif
#ifndef MK_DBG_GEMM
#define MK_DBG_GEMM 0
#endif
__device__ __forceinline__ int mk_lane() { int l; asm volatile("v_mbcnt_lo_u32_b32 %0, -1, 0\n\tv_mbcnt_hi_u32_b32 %0, -1, %0" : "=v"(l)); return l; }
namespace pg8 {
#define PG8_LAS __attribute__((address_space(3)))
typedef unsigned short bf16_t;
typedef short bf16x8 __attribute__((ext_vector_type(8)));
typedef float f32x4 __attribute__((ext_vector_type(4)));
typedef unsigned u32x4 __attribute__((ext_vector_type(4)));
typedef int i32x8 __attribute__((ext_vector_type(8)));
constexpr int BM = 256, BK = 64, HALF = 128, HTB = HALF * BK * 2  , STAGE_BYTES = 8 * HTB, NXCD = 8, WGM = 8;

__host__ __device__ __forceinline__ int lds_byte(int r, int c) { const int st = (r >> 4) * 2 + (c >> 5), rr = r & 15, cc = c & 31, ob = rr * 64 + cc * 2; return st * 1024 + (ob ^ (((ob >> 9) & 1) << 5)); }
__host__ __device__ __forceinline__ void stage_rc(int b, int& R, int& C) { const int st = b / 1024, sb = b % 1024, swz = sb ^ (((sb >> 9) & 1) << 5); R = (st >> 1) * 16 + swz / 64; C = (st & 1) * 32 + (swz % 64) / 2; }
__host__ __device__ __forceinline__ int perm32(int rho) { const int n = rho >> 4, i = rho & 15; return 8 * (i >> 2) + 4 * n + (i & 3); }

struct Unit { int pm, pn, e, nt, kofs, keep; };
struct Gemm { const bf16_t* A; const bf16_t* Bt; int M, N, K; size_t estride; };

struct StaticOrder {
    int nM, nN, nwg, G, c;
    __host__ __device__ void init(int M, int N, int G_, int c_) { nM = M / BM; nN = N / BM; nwg = nM * nN; G = G_; c = c_; }
    __host__ __device__ bool next(int i, Unit& u) const {
        const long L = (long)i * G + c; if (L >= nwg) return false;
        int wgid = (int)L; { const int q = nwg / NXCD, r = nwg % NXCD, xcd = wgid % NXCD, off = wgid / NXCD; wgid = (xcd < r ? xcd * (q + 1) : r * (q + 1) + (xcd - r) * q) + off; }
        const int nig = WGM * nN, gid = wgid / nig, fm = gid * WGM, gsz = (nM - fm) < WGM ? (nM - fm) : WGM;
        u.pm = fm + ((wgid % nig) % gsz); u.pn = (wgid % nig) / gsz; u.e = 0; u.nt = 0; u.kofs = 0; u.keep = 0; return true;
    }
    __device__ __forceinline__ int arow(const Unit&, int R) const { return R; }
    __device__ __forceinline__ void a_ready(const Unit&) const {}
    __device__ __forceinline__ void done(const Unit&) const {}
};

typedef float f32x2_c __attribute__((ext_vector_type(2))); typedef __bf16 bf16x2_c __attribute__((ext_vector_type(2)));
__device__ __forceinline__ unsigned cvt_pk_bf16(float lo, float hi) { f32x2_c v = {lo, hi}; bf16x2_c b = __builtin_convertvector(v, bf16x2_c); return __builtin_bit_cast(unsigned, b); }
__device__ __forceinline__ float bf2f(unsigned short b) { return __uint_as_float((unsigned)b << 16); }
__device__ __forceinline__ void unpack8(const u32x4 w, float (&f)[8]) {
    f[0] = __uint_as_float(w.x << 16); f[1] = __uint_as_float(w.x & 0xffff0000u); f[2] = __uint_as_float(w.y << 16); f[3] = __uint_as_float(w.y & 0xffff0000u);
    f[4] = __uint_as_float(w.z << 16); f[5] = __uint_as_float(w.z & 0xffff0000u); f[6] = __uint_as_float(w.w << 16); f[7] = __uint_as_float(w.w & 0xffff0000u);
}
__device__ __forceinline__ u32x4 pack8(const f32x4 v0, const f32x4 v1) { u32x4 w; w.x = cvt_pk_bf16(v0[0], v0[1]); w.y = cvt_pk_bf16(v0[2], v0[3]); w.z = cvt_pk_bf16(v1[0], v1[1]); w.w = cvt_pk_bf16(v1[2], v1[3]); return w; }

constexpr size_t PJ_QA = 0, PJ_KA = (size_t)16384 * 1024, PJ_VA = (size_t)16384 * 2048, PJ_QL = (size_t)16384 * 3072, PJ_KL = (size_t)16384 * 4608, PJ_VL = (size_t)16384 * 6144, PJ_G = (size_t)16384 * 7680;
struct EpiProj {
    static constexpr bool PERM = true, AFTER_DRAIN = false, IDEM = true; static constexpr int MIDT = 0;
    bf16_t* O;
    const float* gains;
    PG8_LAS float* xch;
    float c2_da, c2_dl, eps;
    __device__ __forceinline__ void operator()(const f32x4 (&acc)[2][2][4][2], const Unit& u, int wr, int wc, int fr, int fq) const {
        constexpr int S = 8192;
        const int pn = u.pn;
        const int kind = (pn < 8) ? 1 : (pn < 12) ? 0 : (pn < 24) ? 2 : (pn < 30) ? 0 : 3;
        const int rowl0 = wr * 64 + fr;
        const int b = u.pm >> 5, t0 = (u.pm & 31) * BM + rowl0;
        size_t hb0; int hstep, pitch, dil = 1;
        if (pn < 8) {
            const int pq = pn & 3; pitch = 64; hstep = 2 * S * 64;
            hb0 = (pn < 4 ? PJ_QA : PJ_KA) + ((size_t)((b * 8 + 2 * pq) * 2 + (wc >> 1)) * S) * 64 + (wc & 1) * 32 + 8 * fq;
        } else if (pn < 12) {
            const int pq = pn - 8; pitch = 128; hstep = S * 128;
            hb0 = PJ_VA + ((size_t)(b * 8 + 2 * pq) * S) * 128 + wc * 32 + 8 * fq;
        } else if (pn < 30) {
            const int sec = (pn - 12) / 6, pq = (pn - 12) % 6; pitch = 128; hstep = S * 128; dil = (pq < 2) ? 1 : (pq < 4) ? 4 : 16;
            hb0 = (sec == 0 ? PJ_QL : sec == 1 ? PJ_KL : PJ_VL) + ((size_t)(b * 12 + 2 * pq) * S) * 128 + wc * 32 + 8 * fq;
        } else {
            pitch = 4096; hstep = HALF;
            hb0 = PJ_G + ((size_t)b * S) * 4096 + (pn - 30) * BM + wc * 32 + 8 * fq;
        }
        bf16_t* const hb = O + hb0;
        const int lsh = (dil == 1) ? 0 : (dil == 4) ? 2 : 4;
        if (kind == 1 || kind == 2) {
#pragma unroll
            for (int ai = 0; ai < 2; ++ai)
#pragma unroll
                for (int m = 0; m < 4; ++m)
#pragma unroll
                    for (int bj = 0; bj < 2; ++bj) {
                        const f32x4 a = acc[ai][bj][m][0], bq = acc[ai][bj][m][1];
                        float s = (a[0] * a[0] + a[1] * a[1]) + (a[2] * a[2] + a[3] * a[3]) + (bq[0] * bq[0] + bq[1] * bq[1]) + (bq[2] * bq[2] + bq[3] * bq[3]);
                        s += __shfl_xor(s, 16); s += __shfl_xor(s, 32);
                        if (fq == 0) xch[(ai * HALF + rowl0 + m * 16) * 8 + bj * 4 + wc] = s;
                    }
            asm volatile("s_waitcnt lgkmcnt(0)" ::: "memory"); __builtin_amdgcn_s_barrier(); asm volatile("" ::: "memory");
            const bool isq = (pn < 4) || (pn >= 12 && pn < 18);
            const int goff = (kind == 1) ? ((isq ? 0 : 64) + (wc & 1) * 32 + 8 * fq) : ((isq ? 128 : 256) + wc * 32 + 8 * fq);
            const float* gp = gains + goff;
            const f32x4 g0 = *(const f32x4*)gp, g1 = *(const f32x4*)(gp + 4);
            const float sc = isq ? (kind == 1 ? c2_da : c2_dl) : 1.0f;
            const float inv = (kind == 1) ? (1.0f / 64.0f) : (1.0f / 128.0f);
#pragma unroll
            for (int ai = 0; ai < 2; ++ai)
#pragma unroll
                for (int m = 0; m < 4; ++m) {
                    const PG8_LAS f32x4* xr = (const PG8_LAS f32x4*)(xch + (ai * HALF + rowl0 + m * 16) * 8);
                    const int t = t0 + ai * HALF + m * 16; const size_t ro = (size_t)(((t & (dil - 1)) * (S >> lsh)) + (t >> lsh)) * pitch;
#pragma unroll
                    for (int bj = 0; bj < 2; ++bj) {
                        const f32x4 tt = xr[bj];
                        const float tot = (kind == 1) ? ((wc < 2) ? (tt[0] + tt[1]) : (tt[2] + tt[3])) : ((tt[0] + tt[1]) + (tt[2] + tt[3]));
                        const float rs = __builtin_amdgcn_rsqf(tot * inv + eps) * sc;
                        const f32x4 v0 = acc[ai][bj][m][0] * rs * g0, v1 = acc[ai][bj][m][1] * rs * g1;
                        *(u32x4*)(hb + ro + (size_t)bj * hstep) = pack8(v0, v1);
                    }
                }
        } else {
#pragma unroll
            for (int ai = 0; ai < 2; ++ai)
#pragma unroll
                for (int m = 0; m < 4; ++m) {
                    const int t = t0 + ai * HALF + m * 16; const size_t ro = (size_t)(((t & (dil - 1)) * (S >> lsh)) + (t >> lsh)) * pitch;
#pragma unroll
                    for (int bj = 0; bj < 2; ++bj) {
                        f32x4 v0 = acc[ai][bj][m][0], v1 = acc[ai][bj][m][1];
                        if (kind == 3) {
#pragma unroll
                            for (int j = 0; j < 4; ++j) { v0[j] = __builtin_amdgcn_rcpf(1.0f + __builtin_amdgcn_exp2f(-1.4426950408889634f * v0[j])); v1[j] = __builtin_amdgcn_rcpf(1.0f + __builtin_amdgcn_exp2f(-1.4426950408889634f * v1[j])); }
                        }
                        *(u32x4*)(hb + ro + (size_t)bj * hstep) = pack8(v0, v1);
                    }
                }
        }
    }
};

struct EpiGateSig {
    static constexpr bool PERM = true, AFTER_DRAIN = false, IDEM = true; static constexpr int MIDT = 0;
    unsigned char* G; float ascale; bf16_t* O;
    __device__ __forceinline__ void operator()(const f32x4 (&acc)[2][2][4][2], const Unit& u, int wr, int wc, int fr, int fq) const {
        constexpr int S = 8192;
        const bool gate = u.pn < 16;
        const int pv = u.pn - 16, b = u.pm >> 5, t0 = (u.pm & 31) * BM + wr * 64 + fr;
        const bool da = pv < 4; const int pq = da ? pv : pv - 4, dil = (gate || da || pq < 2) ? 1 : (pq < 4) ? 4 : 16, lsh = (dil == 1) ? 0 : (dil == 4) ? 2 : 4;
        const size_t ubase = gate ? (size_t)(u.pm * BM) * 4096 + 2 * ((u.pn & 7) * BM) + ((u.pn >> 3) << 3) : 2 * (da ? PJ_VA + ((size_t)(b * 8 + 2 * pq) * S) * 128 : PJ_VL + ((size_t)(b * 12 + 2 * pq) * S) * 128);
        unsigned char* const base = (gate ? G : (unsigned char*)O) + ubase + (gate ? (unsigned)(wr * 64 + fr) * 4096u : 0u) + 2 * (wc * 32 + 8 * fq);
        const unsigned pitch = gate ? 4096u : 256u, bjs = gate ? (unsigned)(2 * HALF) : (unsigned)(S * 256);
        const float ns = gate ? -1.4426950408889634f * ascale : ascale;
        typedef unsigned u32x2 __attribute__((ext_vector_type(2)));
#pragma unroll
        for (int ai = 0; ai < 2; ++ai)
#pragma unroll
            for (int m = 0; m < 4; ++m) {
                const int t = gate ? ai * HALF + m * 16 : t0 + ai * HALF + m * 16; const unsigned ro = (unsigned)(((t & (dil - 1)) * (S >> lsh)) + (t >> lsh)) * pitch;
#pragma unroll
                for (int bj = 0; bj < 2; ++bj) {
                    f32x4 v0 = acc[ai][bj][m][0] * ns, v1 = acc[ai][bj][m][1] * ns;
                    if (gate) {
#pragma unroll
                        for (int j = 0; j < 4; ++j) { v0[j] = fmaxf(255.0f * __builtin_amdgcn_rcpf(1.0f + __builtin_amdgcn_exp2f(v0[j])), 1.0f); v1[j] = fmaxf(255.0f * __builtin_amdgcn_rcpf(1.0f + __builtin_amdgcn_exp2f(v1[j])), 1.0f); }
                        unsigned lo = 0, hi = 0;
                        lo = __builtin_amdgcn_cvt_pk_u8_f32(v0[0], 0, lo); lo = __builtin_amdgcn_cvt_pk_u8_f32(v0[1], 1, lo); lo = __builtin_amdgcn_cvt_pk_u8_f32(v0[2], 2, lo); lo = __builtin_amdgcn_cvt_pk_u8_f32(v0[3], 3, lo);
                        hi = __builtin_amdgcn_cvt_pk_u8_f32(v1[0], 0, hi); hi = __builtin_amdgcn_cvt_pk_u8_f32(v1[1], 1, hi); hi = __builtin_amdgcn_cvt_pk_u8_f32(v1[2], 2, hi); hi = __builtin_amdgcn_cvt_pk_u8_f32(v1[3], 3, hi);
                        *(u32x2*)(base + ro + bj * bjs) = (u32x2){lo, hi};
                    } else *(u32x4*)(base + ro + bj * bjs) = pack8(v0, v1);
                }
            }
    }
};

struct EpiMix {
    static constexpr bool PERM = true, AFTER_DRAIN = false, IDEM = false; static constexpr int MIDT = 0;
    bf16_t* MIX; int ldm; const unsigned char* G;
    __device__ __forceinline__ void operator()(f32x4 (&acc)[2][2][4][2], const Unit& u, int wr, int wc, int fr, int fq) const {
        const int row0 = u.pm * BM + wr * 64 + fr, col0 = u.pn * BM + wc * 32 + 8 * fq;
        const unsigned char* const gp = G + (size_t)row0 * 4096 + 2 * col0;
#define PG8_UB(w, k) ((float)(((w) >> (8 * (k))) & 0xffu))
        if (!u.keep) {
#pragma unroll
            for (int ai = 0; ai < 2; ++ai)
#pragma unroll
                for (int m = 0; m < 4; ++m) {
#pragma unroll
                    for (int bj = 0; bj < 2; ++bj) {
                        const u32x4 g = *(const u32x4*)(gp + (size_t)(ai * HALF + m * 16) * 4096 + 2 * bj * HALF);
#pragma unroll
                        for (int j = 0; j < 4; ++j) { acc[ai][bj][m][0][j] *= PG8_UB(g.x, j) * __builtin_amdgcn_rcpf(PG8_UB(g.z, j)); acc[ai][bj][m][1][j] *= PG8_UB(g.y, j) * __builtin_amdgcn_rcpf(PG8_UB(g.w, j)); }
                    }
                    if (m & 1) asm volatile("" ::: "memory");
                }
        } else {
#pragma unroll
            for (int ai = 0; ai < 2; ++ai)
#pragma unroll
                for (int m = 0; m < 4; ++m) {
                    const size_t r = (size_t)(row0 + ai * HALF + m * 16);
#pragma unroll
                    for (int bj = 0; bj < 2; ++bj) {
                        typedef unsigned u32x2 __attribute__((ext_vector_type(2)));
                        const u32x2 g = *(const u32x2*)(gp + (size_t)(ai * HALF + m * 16) * 4096 + 2 * bj * HALF + 8);
                        f32x4 v0 = acc[ai][bj][m][0], v1 = acc[ai][bj][m][1];
#pragma unroll
                        for (int j = 0; j < 4; ++j) { v0[j] *= PG8_UB(g.x, j) * (1.0f / 255.0f); v1[j] *= PG8_UB(g.y, j) * (1.0f / 255.0f); }
                        *(u32x4*)(MIX + r * ldm + col0 + bj * HALF) = pack8(v0, v1);
                    }
                }
        }
#undef PG8_UB
    }
};
struct MixOrder {
    StaticOrder base;
    __device__ __forceinline__ bool next(int i, Unit& u) const { if (!base.next(i >> 1, u)) return false; const int part = i & 1; u.nt = part ? 8 : 16; u.kofs = part ? 2048 : 0; u.keep = part; return true; }
    __device__ __forceinline__ int arow(const Unit&, int R) const { return R; }
    __device__ __forceinline__ void a_ready(const Unit&) const {}
    __device__ __forceinline__ void done(const Unit&) const {}
};

struct EpiRes {
    static constexpr bool PERM = false, AFTER_DRAIN = false, IDEM = true; static constexpr int MIDT = 0;
    const float* X; float* Out; int ldc;
    __device__ __forceinline__ void operator()(const f32x4 (&acc)[2][2][4][2], const Unit& u, int wr, int wc, int fr, int fq) const {
        const int row0 = u.pm * BM + wr * 64 + fr, col0 = u.pn * BM + wc * 32 + 4 * fq;
#pragma unroll
        for (int ai = 0; ai < 2; ++ai)
#pragma unroll
            for (int m = 0; m < 4; ++m) {
                const size_t off = (size_t)(row0 + ai * HALF + m * 16) * ldc + col0;
#pragma unroll
                for (int bj = 0; bj < 2; ++bj)
#pragma unroll
                    for (int n = 0; n < 2; ++n) { const f32x4 xv = *(const f32x4*)(X + off + bj * HALF + n * 16); *(f32x4*)(Out + off + bj * HALF + n * 16) = xv + acc[ai][bj][m][n]; }
            }
    }
};

constexpr float HSCALE = 4.0f, WSCALE = 64.0f, XSCALE = 8.0f;
__device__ __forceinline__ unsigned pk_fp8x4(float a, float b, float c, float d) {
    a = fminf(fmaxf(a, -448.f), 448.f); b = fminf(fmaxf(b, -448.f), 448.f); c = fminf(fmaxf(c, -448.f), 448.f); d = fminf(fmaxf(d, -448.f), 448.f);
    int p = __builtin_amdgcn_cvt_pk_fp8_f32(a, b, 0, false); p = __builtin_amdgcn_cvt_pk_fp8_f32(c, d, p, true); return (unsigned)p; }
__device__ __forceinline__ unsigned pk_fp8x4_nc(float a, float b, float c, float d) { int p = __builtin_amdgcn_cvt_pk_fp8_f32(a, b, 0, false); p = __builtin_amdgcn_cvt_pk_fp8_f32(c, d, p, true); return (unsigned)p; }
struct EpiSwiglu {
    static constexpr bool PERM = true, AFTER_DRAIN = false, IDEM = true; static constexpr int MIDT = 0;
    unsigned char* H; int ldh; float ascale;
    const float* rsl; const PG8_LAS int* ps; int lcap;
    __device__ __forceinline__ void operator()(const f32x4 (&acc)[2][2][4][2], const Unit& u, int wr, int wc, int fr, int fq) const {
        const int row0 = u.pm * BM + wr * 64 + fr, col0 = u.pn * HALF + wc * 32 + 8 * fq;
        const float* rb = rsl + (size_t)u.e * lcap + (row0 - ps[u.e]);
#pragma unroll
        for (int ai = 0; ai < 2; ++ai)
#pragma unroll
            for (int m = 0; m < 4; ++m) {
                float v[8]; const float rs = rb[ai * HALF + m * 16] * ascale;
#pragma unroll
                for (int n = 0; n < 2; ++n)
#pragma unroll
                    for (int j = 0; j < 4; ++j) { const float gt = acc[ai][0][m][n][j] * rs, up = acc[ai][1][m][n][j] * rs; v[4 * n + j] = gt * __builtin_amdgcn_rcpf(1.0f + __builtin_amdgcn_exp2f(-1.4426950408889634f * gt)) * up * HSCALE; }
                typedef unsigned u32x2 __attribute__((ext_vector_type(2)));
                *(u32x2*)(H + (size_t)(row0 + ai * HALF + m * 16) * ldh + col0) = (u32x2){pk_fp8x4_nc(v[0], v[1], v[2], v[3]), pk_fp8x4_nc(v[4], v[5], v[6], v[7])};
            }
    }
};

constexpr float YSCALE = 16.0f;
struct EpiFp8 {
    static constexpr bool PERM = true, AFTER_DRAIN = false, IDEM = true; static constexpr int MIDT = 0;
    unsigned char* O; int ldc; float scale;
    __device__ __forceinline__ void operator()(const f32x4 (&acc)[2][2][4][2], const Unit& u, int wr, int wc, int fr, int fq) const {
        const int row0 = u.pm * BM + wr * 64 + fr, col0 = u.pn * BM + wc * 32 + 8 * fq;
        typedef unsigned u32x2 __attribute__((ext_vector_type(2)));
#pragma unroll
        for (int ai = 0; ai < 2; ++ai)
#pragma unroll
            for (int m = 0; m < 4; ++m)
#pragma unroll
                for (int bj = 0; bj < 2; ++bj) { const f32x4 a = acc[ai][bj][m][0] * scale, b = acc[ai][bj][m][1] * scale;
                    *(u32x2*)(O + (size_t)(row0 + ai * HALF + m * 16) * ldc + col0 + bj * HALF) = (u32x2){pk_fp8x4_nc(a[0], a[1], a[2], a[3]), pk_fp8x4_nc(b[0], b[1], b[2], b[3])}; }
    }
};
struct EpiPlain {
    static constexpr bool PERM = true, AFTER_DRAIN = false, IDEM = true; static constexpr int MIDT = 0;
    bf16_t* O; int ldc; float scale;
    __device__ __forceinline__ void operator()(const f32x4 (&acc)[2][2][4][2], const Unit& u, int wr, int wc, int fr, int fq) const {
        const int row0 = u.pm * BM + wr * 64 + fr, col0 = u.pn * BM + wc * 32 + 8 * fq;
#pragma unroll
        for (int ai = 0; ai < 2; ++ai)
#pragma unroll
            for (int m = 0; m < 4; ++m)
#pragma unroll
                for (int bj = 0; bj < 2; ++bj) *(u32x4*)(O + (size_t)(row0 + ai * HALF + m * 16) * ldc + col0 + bj * HALF) = pack8(acc[ai][bj][m][0] * scale, acc[ai][bj][m][1] * scale);
    }
};

struct TicketOrder {
    unsigned* q; int xcd, per; volatile PG8_LAS int* tick; int wave; int skipv;
    __device__ __forceinline__ bool next(int i, Unit& u) const {
        const bool t0 = (wave == 0) && (mk_lane() == 0);
        if (i == 0) { if (t0) { tick[0] = (int)atomicAdd(q, 1u); tick[1] = (int)atomicAdd(q, 1u); } __syncthreads(); }
        else if (t0) tick[(i + 1) & 1] = (int)atomicAdd(q, 1u);
        const int tk = __builtin_amdgcn_readfirstlane(tick[i & 1]);
        if (tk >= per) return false;
        u.pm = 8 * xcd + (tk & 7); u.pn = tk >> 3; if (skipv && u.pn >= 8) u.pn += 4; u.e = 0; u.nt = 0; u.kofs = 0; u.keep = 0; return true;
    }
    __device__ __forceinline__ int arow(const Unit&, int R) const { return R; }
    __device__ __forceinline__ void a_ready(const Unit&) const {}
    __device__ __forceinline__ void done(const Unit&) const {}
};

struct SkipOrder { StaticOrder base;
    __device__ __forceinline__ bool next(int i, Unit& u) const { if (!base.next(i, u)) return false; if (u.pn >= 8) u.pn += 4; return true; }
    __device__ __forceinline__ int arow(const Unit&, int R) const { return R; }
    __device__ __forceinline__ void a_ready(const Unit&) const {}
    __device__ __forceinline__ void done(const Unit&) const {}
};
struct OffOrder { StaticOrder base; int off;
    __device__ __forceinline__ bool next(int i, Unit& u) const { if (!base.next(i, u)) return false; u.pn += off; return true; }
    __device__ __forceinline__ int arow(const Unit&, int R) const { return R; }
    __device__ __forceinline__ void a_ready(const Unit&) const {}
    __device__ __forceinline__ void done(const Unit&) const {}
};
struct GroupOrder {
    int nT, G, c; const PG8_LAS int* tile_e; const PG8_LAS int* ps; const PG8_LAS int* cn; const int* list; int lcap;
    __device__ __forceinline__ bool next(int i, Unit& u) const {
        const int L = i * G + c; if (L >= nT * 8) return false;
        const int wgid = (L & 7) * nT + (L >> 3);
        u.pm = wgid >> 3; u.pn = wgid & 7; u.e = __builtin_amdgcn_readfirstlane(tile_e[u.pm]); u.nt = 0; u.kofs = 0; u.keep = 0; return true;
    }
    __device__ __forceinline__ int arow(const Unit& u, int R) const { const int lr = u.pm * BM - ps[u.e] + R; return (lr < cn[u.e]) ? list[(size_t)u.e * lcap + lr] : 0; }
    __device__ __forceinline__ void a_ready(const Unit&) const {}
    __device__ __forceinline__ void done(const Unit&) const {}
};
template <class Epi, class Sched, bool ALIGN_EPI = false, bool SP2 = false, bool GATHER = false, bool MX = false>
__device__ __forceinline__ void gemm_phase(const int wv  , PG8_LAS unsigned char* lds, const Gemm g, const Sched& S, const Epi& E, unsigned* dbg_out = nullptr) {
    const int lane = mk_lane(), wid = wv, tid = wid * 64 + lane, wr = wid >> 2, wc = wid & 3, fr = lane & 15, fq = lane >> 4;
    const int K = g.K, nt_all = K / BK;
    unsigned voffA[2], voffB[2];
#pragma unroll
    for (int i = 0; i < 2; ++i) { int R, C; stage_rc(tid * 16 + i * 8192, R, C); const int Rb = Epi::PERM ? ((R & ~31) + perm32(R & 31)) : R;
        voffA[i] = (unsigned)(R * K + C) * 2u; voffB[i] = (unsigned)(Rb * K + C) * 2u; }
    static_assert(!GATHER || SP2, "GATHER needs the SP2 loop");
    unsigned vc0[2], vc1[2];
#define PG8_V(arr) (GATHER ? (arr) : voffA)
#define PG8_GOFF(dst0, dst1, uu) do { _Pragma("unroll") for (int i_ = 0; i_ < 2; ++i_) { int R_, C_; stage_rc(tid * 16 + i_ * 8192, R_, C_); \
        dst0[i_] = (unsigned)(S.arow(uu, R_) * K + C_) * 2u; dst1[i_] = (unsigned)(S.arow(uu, R_ + HALF) * K + C_) * 2u; } } while (0)
    const size_t kstep = (size_t)(BK * 2);
    const size_t hstep = (size_t)HALF * K * 2;
    const size_t tstep = 2 * hstep;
    const size_t hstepA = GATHER ? (size_t)0 : hstep;
    const unsigned ldsw = (unsigned)wid * 1024u; const unsigned lds0 = (unsigned)(uintptr_t)lds;
    const int aoff = lds_byte(wr * 64 + fr, fq * 8), boff = lds_byte(wc * 32 + fr, fq * 8);
#define PG8_SA(b, h) (((b) * 2 + (h)) * HTB)
#define PG8_SB(b, h) ((4 + (b) * 2 + (h)) * HTB)
#define PG8_STAGE(bufoff, gbase, voff) do { const char* sb_ = (const char*)(gbase);       \
        _Pragma("unroll") for (int _i = 0; _i < 2; ++_i) { unsigned keep_; const unsigned ld_ = lds0 + (unsigned)(bufoff) + ldsw + (unsigned)_i * 8192u; \
            asm volatile("s_mov_b32 %0, m0\n\ts_mov_b32 m0, %3\n\ts_nop 2\n\tglobal_load_lds_dwordx4 %1, %2\n\ts_mov_b32 m0, %0" : "=&s"(keep_) : "v"((voff)[_i]), "s"(sb_), "s"(ld_) : "memory"); } } while (0)
#define PG8_LDA(dst, b, h) do { unsigned ab_ = (unsigned)(PG8_SA(b, h) + aoff); asm volatile("" : "+v"(ab_));   \
        _Pragma("unroll") for (int m = 0; m < 4; ++m) _Pragma("unroll") for (int k = 0; k < 2; ++k) dst[m][k] = *(const PG8_LAS bf16x8*)(lds + ab_ + m * 2048 + k * 1024); } while (0)
#define PG8_LDB(dst, b, h) do { unsigned bb_ = (unsigned)(PG8_SB(b, h) + boff); asm volatile("" : "+v"(bb_)); \
        _Pragma("unroll") for (int n = 0; n < 2; ++n) _Pragma("unroll") for (int k = 0; k < 2; ++k) dst[n][k] = *(const PG8_LAS bf16x8*)(lds + bb_ + n * 2048 + k * 1024); } while (0)
#define PG8_CAT8(x, y) __builtin_bit_cast(i32x8, __builtin_shufflevector(x, y, 0, 1, 2, 3, 4, 5, 6, 7, 8, 9, 10, 11, 12, 13, 14, 15))
#define PG8_MMA(ai, bj, At, Bt) do { __builtin_amdgcn_s_setprio(1); _Pragma("unroll") for (int m = 0; m < 4; ++m) _Pragma("unroll") for (int n = 0; n < 2; ++n) { \
        if constexpr (MX) acc[ai][bj][m][n] = __builtin_amdgcn_mfma_scale_f32_16x16x128_f8f6f4(PG8_CAT8(Bt[n][0], Bt[n][1]), PG8_CAT8(At[m][0], At[m][1]), acc[ai][bj][m][n], 0, 0, 0, 0x7f7f7f7f, 0, 0x7f7f7f7f); \
        else { _Pragma("unroll") for (int k = 0; k < 2; ++k) acc[ai][bj][m][n] = __builtin_amdgcn_mfma_f32_16x16x32_bf16(Bt[n][k], At[m][k], acc[ai][bj][m][n], 0, 0, 0); } } __builtin_amdgcn_s_setprio(0); } while (0)
#define PG8_WAIT_V(n) asm volatile("s_waitcnt vmcnt(" #n ")" ::: "memory")
#define PG8_WAIT_L(n) asm volatile("s_waitcnt lgkmcnt(" #n ")" ::: "memory")
#define PG8_BAR __builtin_amdgcn_s_barrier()
#define PG8_SCHED __builtin_amdgcn_sched_barrier(0)
    Unit cur, nxt; int ui = 0;
    if (!S.next(0, cur)) return;
    f32x4 acc[2][2][4][2];
#pragma unroll
    for (int a = 0; a < 2; ++a)
#pragma unroll
        for (int b = 0; b < 2; ++b)
#pragma unroll
            for (int m = 0; m < 4; ++m)
#pragma unroll
                for (int n = 0; n < 2; ++n) acc[a][b][m][n] = (f32x4){0.f, 0.f, 0.f, 0.f};
    bf16x8 At[4][2], B0[2][2], B1[2][2];
    const char* cA = (const char*)g.A + (GATHER ? (size_t)0 : (size_t)cur.pm * tstep) + cur.kofs; const char* cB = (const char*)g.Bt + (size_t)cur.pn * tstep + (size_t)cur.e * g.estride + cur.kofs;
    S.a_ready(cur);
    if constexpr (GATHER) { PG8_GOFF(vc0, vc1, cur); } else {
#pragma unroll
        for (int i = 0; i < 2; ++i) { vc0[i] = voffA[i]; vc1[i] = voffA[i]; } }
    if constexpr (SP2) {
        PG8_STAGE(PG8_SB(0, 0), cB, voffB); PG8_STAGE(PG8_SB(0, 1), cB + hstep, voffB); PG8_STAGE(PG8_SA(0, 0), cA, PG8_V(vc0)); PG8_STAGE(PG8_SA(0, 1), cA + hstepA, PG8_V(vc1));
        if (wr == 1) PG8_BAR;
        PG8_WAIT_V(2); PG8_BAR;
        PG8_STAGE(PG8_SB(1, 0), cB + kstep, voffB); PG8_STAGE(PG8_SA(1, 0), cA + kstep, PG8_V(vc0)); PG8_STAGE(PG8_SB(1, 1), cB + hstep + kstep, voffB);
        PG8_WAIT_V(6); PG8_BAR;
    } else {
        PG8_STAGE(PG8_SB(0, 0), cB, voffB); PG8_STAGE(PG8_SA(0, 0), cA, voffA); PG8_STAGE(PG8_SB(0, 1), cB + hstep, voffB); PG8_STAGE(PG8_SA(0, 1), cA + hstep, voffA);
        if (wr == 1) PG8_BAR;
        PG8_WAIT_V(4); PG8_BAR;
        PG8_STAGE(PG8_SB(1, 0), cB + kstep, voffB); PG8_STAGE(PG8_SA(1, 0), cA + kstep, voffA); PG8_STAGE(PG8_SB(1, 1), cB + hstep + kstep, voffB);
        PG8_WAIT_V(6); PG8_BAR;
    }
    for (;;) {
        const bool has_next = S.next(ui + 1, nxt);
        const char* nA = (has_next && !GATHER) ? (const char*)g.A + (size_t)nxt.pm * tstep + nxt.kofs : (GATHER ? (const char*)g.A : cA);
        const char* nB = has_next ? (const char*)g.Bt + (size_t)nxt.pn * tstep + (size_t)nxt.e * g.estride + nxt.kofs : cB;
        const int nt = cur.nt > 0 ? cur.nt : nt_all;
#if MK_DBG
        const unsigned long long dbg_k0 = __builtin_amdgcn_s_memtime();
#endif
        for (int t = 0; t < nt; t += 2) {
            const bool last = (t == nt - 2);
            const char* a1 = cA + (size_t)(t + 1) * kstep;
            const char* a2 = last ? nA : cA + (size_t)(t + 2) * kstep; const char* b2 = last ? nB : cB + (size_t)(t + 2) * kstep;
            const char* a3 = a2 + kstep; const char* b3 = b2 + kstep;
            if (last && has_next) S.a_ready(nxt);
            if constexpr (SP2) {
            PG8_LDB(B0, 0, 0); PG8_LDB(B1, 0, 1); PG8_SCHED; PG8_LDA(At, 0, 0); PG8_STAGE(PG8_SA(1, 1), a1 + hstepA, PG8_V(vc1));
            if constexpr (GATHER) { if (last && has_next) { PG8_GOFF(vc0, vc1, nxt); } }
            PG8_WAIT_V(8); PG8_WAIT_L(0); PG8_BAR; PG8_MMA(0, 0, At, B0); PG8_MMA(0, 1, At, B1); PG8_BAR; PG8_SCHED;
            PG8_LDA(At, 0, 1); PG8_STAGE(PG8_SB(0, 0), b2, voffB); PG8_STAGE(PG8_SB(0, 1), b2 + hstep, voffB); PG8_STAGE(PG8_SA(0, 0), a2, PG8_V(vc0));
            PG8_WAIT_V(8); PG8_WAIT_L(0); PG8_BAR; PG8_MMA(1, 0, At, B0); PG8_MMA(1, 1, At, B1); PG8_BAR; PG8_SCHED;
            PG8_LDB(B0, 1, 0); PG8_LDB(B1, 1, 1); PG8_SCHED; PG8_LDA(At, 1, 0); PG8_STAGE(PG8_SA(0, 1), a2 + hstepA, PG8_V(vc1));
            PG8_WAIT_V(8); PG8_WAIT_L(0); PG8_BAR; PG8_MMA(0, 0, At, B0); PG8_MMA(0, 1, At, B1); PG8_BAR; PG8_SCHED;
            PG8_LDA(At, 1, 1); PG8_STAGE(PG8_SB(1, 0), b3, voffB); PG8_STAGE(PG8_SB(1, 1), b3 + hstep, voffB); PG8_STAGE(PG8_SA(1, 0), a3, PG8_V(vc0));
            PG8_WAIT_V(8); PG8_WAIT_L(0); PG8_BAR; PG8_MMA(1, 0, At, B0); PG8_MMA(1, 1, At, B1); PG8_BAR; PG8_SCHED;
            } else {
            PG8_LDB(B0, 0, 0); PG8_SCHED; PG8_LDA(At, 0, 0); PG8_STAGE(PG8_SA(1, 1), a1 + hstep, voffA);
            PG8_WAIT_L(8); PG8_BAR; PG8_WAIT_L(0); PG8_MMA(0, 0, At, B0); PG8_BAR; PG8_SCHED;
            PG8_LDB(B1, 0, 1); PG8_STAGE(PG8_SB(0, 0), b2, voffB);
            PG8_BAR; PG8_WAIT_L(0); PG8_MMA(0, 1, At, B1); PG8_BAR;
            PG8_LDA(At, 0, 1); PG8_STAGE(PG8_SA(0, 0), a2, voffA);
            PG8_BAR; PG8_WAIT_L(0); PG8_MMA(1, 0, At, B0); PG8_BAR; PG8_SCHED;
            PG8_STAGE(PG8_SB(0, 1), b2 + hstep, voffB);
            PG8_WAIT_V(6); PG8_BAR; PG8_MMA(1, 1, At, B1); PG8_BAR;
            PG8_LDB(B0, 1, 0); PG8_SCHED; PG8_LDA(At, 1, 0); PG8_STAGE(PG8_SA(0, 1), a2 + hstep, voffA);
            PG8_WAIT_L(8); PG8_BAR; PG8_WAIT_L(0); PG8_MMA(0, 0, At, B0); PG8_BAR; PG8_SCHED;
            PG8_LDB(B1, 1, 1); PG8_STAGE(PG8_SB(1, 0), b3, voffB);
            PG8_BAR; PG8_WAIT_L(0); PG8_MMA(0, 1, At, B1); PG8_BAR;
            PG8_LDA(At, 1, 1); PG8_STAGE(PG8_SA(1, 0), a3, voffA);
            PG8_BAR; PG8_WAIT_L(0); PG8_MMA(1, 0, At, B0); PG8_BAR; PG8_SCHED;
            PG8_STAGE(PG8_SB(1, 1), b3 + hstep, voffB);
            PG8_WAIT_V(6); PG8_BAR; PG8_MMA(1, 1, At, B1); PG8_BAR;
            }
        }
#if MK_DBG
        if (MK_DBG_GEMM && dbg_out != nullptr && ui == 2 && blockIdx.x == 0 && tid == 0) { const unsigned long long d = __builtin_amdgcn_s_memtime() - dbg_k0; dbg_out[7] = (unsigned)(d / (unsigned long long)nt); }
#endif
        if constexpr (ALIGN_EPI) { if (wr == 0) PG8_BAR; }
        int lane_e = mk_lane(); asm volatile("" : "+v"(lane_e));
        const int fr_e = lane_e & 15, fq_e = lane_e >> 4;
        if constexpr (!Epi::AFTER_DRAIN) { E(acc, cur, wr, wc, fr_e, fq_e); if (MK_EPI2 && Epi::IDEM) { asm volatile("" ::: "memory"); E(acc, cur, wr, wc, fr_e, fq_e); } S.done(cur); }
        if (!has_next) break;
        if (!nxt.keep) {
#pragma unroll
        for (int a = 0; a < 2; ++a)
#pragma unroll
            for (int b = 0; b < 2; ++b)
#pragma unroll
                for (int m = 0; m < 4; ++m)
#pragma unroll
                    for (int n = 0; n < 2; ++n) acc[a][b][m][n] = (f32x4){0.f, 0.f, 0.f, 0.f};
        }
        cur = nxt; cA = nA; cB = nB; ++ui;
        if constexpr (ALIGN_EPI) { if (wr == 1) PG8_BAR; }
    }
    PG8_WAIT_V(0);
    if constexpr (!ALIGN_EPI) { if (wr == 0) PG8_BAR; }
    PG8_BAR;
    if constexpr (Epi::AFTER_DRAIN) { E.fused(acc, cur, wr, wc, fr, fq, lds, wid, lane); S.done(cur); }
#undef PG8_SA
#undef PG8_SB
#undef PG8_STAGE
#undef PG8_LDA
#undef PG8_LDB
#undef PG8_MMA
#undef PG8_WAIT_V
#undef PG8_WAIT_L
#undef PG8_BAR
#undef PG8_SCHED
#undef PG8_GOFF
#undef PG8_V
}
}
#include <cmath>
#ifndef ATT_KDUP
#define ATT_KDUP 1
#endif
#ifndef ATT_HALF
#define ATT_HALF(w) ((w) >> 2)
#endif
#ifndef MK_DBG
#define MK_DBG 0
#endif
#ifndef MK_DBG_SEL
#define MK_DBG_SEL 0
#endif
#ifndef ATT_PRIO
#define ATT_PRIO 0
#endif
#ifndef ATT_SIMPLE
#define ATT_SIMPLE 1
#endif
namespace att {
typedef unsigned short bf16_t;
typedef short bf16x8 __attribute__((ext_vector_type(8)));
typedef short s16x4 __attribute__((ext_vector_type(4)));
typedef short v4i16_t __attribute__((ext_vector_type(4)));
typedef float f32x16 __attribute__((ext_vector_type(16)));
typedef unsigned u32x4 __attribute__((ext_vector_type(4)));
#define ATT_LAS __attribute__((address_space(3)))
constexpr int SLOT = 16384, RSLOT = 2 * SLOT  , ATT_LDS_BYTES = 4 * RSLOT;
__device__ __forceinline__ int crow(int r, int hi) { return (r & 3) + 8 * (r >> 2) + 4 * hi; }
__device__ __forceinline__ void glds16(const void* gsrc, unsigned lds_dst) { unsigned keep;
    asm volatile("s_mov_b32 %0, m0\n\ts_mov_b32 m0, %2\n\ts_nop 0\n\tglobal_load_lds_dwordx4 %1, off\n\ts_mov_b32 m0, %0" : "=&s"(keep) : "v"(gsrc), "s"(lds_dst) : "memory"); }
__device__ __forceinline__ const void* uniform_ptr(const void* p) { const unsigned long long v = (unsigned long long)p;
    return (const void*)(((unsigned long long)(unsigned)__builtin_amdgcn_readfirstlane((unsigned)(v >> 32)) << 32) | (unsigned long long)(unsigned)__builtin_amdgcn_readfirstlane((unsigned)v)); }
__device__ __forceinline__ void glds16s(const void* sbase, unsigned voff, unsigned lds_dst) { unsigned keep;
    asm volatile("s_mov_b32 %0, m0\n\ts_mov_b32 m0, %3\n\ts_nop 4\n\tglobal_load_lds_dwordx4 %1, %2\n\ts_mov_b32 m0, %0" : "=&s"(keep) : "v"(voff), "s"(sbase), "s"(lds_dst) : "memory"); }
typedef float f32x2_t __attribute__((ext_vector_type(2))); typedef __bf16 bf16x2_t __attribute__((ext_vector_type(2)));
__device__ __forceinline__ unsigned cvtpk(float lo, float hi) { f32x2_t v = {lo, hi}; bf16x2_t b = __builtin_convertvector(v, bf16x2_t); return __builtin_bit_cast(unsigned, b); }
__device__ __forceinline__ s16x4 vtr(ATT_LAS const char* p) { return __builtin_bit_cast(s16x4, __builtin_amdgcn_ds_read_tr16_b64_v4i16((ATT_LAS v4i16_t*)p)); }
__device__ __forceinline__ float swapsum(float m) { auto rr = __builtin_amdgcn_permlane32_swap(__float_as_uint(m), __float_as_uint(m), false, false); return __uint_as_float(rr[0]) + __uint_as_float(rr[1]); }

#define ATT_SL(x) ((((x)) & 3) ^ 2)
template <int DK, bool TWO>
__device__ __forceinline__ void att_issue_first(const bf16_t* Kp, const bf16_t* Vp, long mapstride, int t_lo, int NT, unsigned lds0, int wid, int lane) {
    constexpr int NKW = TWO ? 2 : DK / 64; constexpr long ktile = 64L * DK, vtile = 64L * 128;
#pragma unroll
    for (int tt = 0; tt < 2; ++tt) { if (tt >= NT) break;
#pragma unroll
        for (int i = 0; i < NKW; ++i) { const int p = TWO ? wid : wid + 8 * i; unsigned ko;
            if (DK == 64) { const int r = 8 * p + (lane >> 3), pc = lane & 7; ko = (unsigned)(r * 128 + ((pc ^ ((r >> 1) & 7)) << 4)); }
            else          { const int r = 4 * p + (lane >> 4), pc = lane & 15; ko = (unsigned)(r * 256 + ((pc ^ (r & 15)) << 4)); }
            glds16s(uniform_ptr(Kp + (long)(t_lo + tt) * ktile + (TWO ? (long)i * mapstride : 0L)), ko, (unsigned)__builtin_amdgcn_readfirstlane(lds0 + ATT_SL(tt) * RSLOT + (wid + 8 * i) * 1024)); }
#pragma unroll
        for (int i = 0; i < 2; ++i) { const int p = wid + 8 * i, r = 4 * p + (lane >> 4), pc = lane & 15; const unsigned vo = (unsigned)(r * 256 + ((pc ^ (((r & 3) << 2) | ((r >> 2) & 3))) << 4));
            glds16s(uniform_ptr(Vp + (long)(t_lo + tt) * vtile), vo, (unsigned)__builtin_amdgcn_readfirstlane(lds0 + ATT_SL(tt) * RSLOT + SLOT + (wid + 8 * i) * 1024)); }
    }
}
struct NoNext { __device__ __forceinline__ int operator()(int) const { return 0; } };
template <int DK, bool TWO = false, class NF = NoNext>
__device__ __forceinline__ void attn_unit(const bf16_t* Qp, const bf16_t* Kp, const bf16_t* Vp, int i0, int t_lo, int t_hi, int win, int wskip, float slope2, float cref,
                                          bf16_t* Op, long ostride, float* lsep, long lstride, ATT_LAS unsigned char* lds, ATT_LAS float* wsbase, const int wv, unsigned* dbgp = nullptr,
                                          long mapstride = 0, float lam = 0.f, const float* sgain = nullptr, float sgscale = 1.f, float eps = 0.f,
                                          float* sp_mine = nullptr, const float* sp_other = nullptr, unsigned* sp_cnt = nullptr, unsigned* qhead = nullptr, volatile ATT_LAS int* qslot = nullptr, bool pre = false, const NF& nf = NF()) {
    static_assert(!TWO || DK == 64, "TWO: differential attention, key dim 64");
    constexpr int NKS = DK / 16;
    constexpr int NKW = TWO ? 2 : DK / 64;
    const int lane = mk_lane(), r32 = lane & 31, hi = lane >> 5; const int wid = wv; const int tid = wid * 64 + lane;
    i0 = __builtin_amdgcn_readfirstlane(i0); t_lo = __builtin_amdgcn_readfirstlane(t_lo); t_hi = __builtin_amdgcn_readfirstlane(t_hi); win = __builtin_amdgcn_readfirstlane(win); wskip = __builtin_amdgcn_readfirstlane(wskip);
    const int half = ATT_HALF(wid);
    const int mp = TWO ? (wid >> 2) : 0, wq = TWO ? (wid & 3) : wid;
    const int qrow = i0 + 32 * wq + r32, qmin_w = i0 + 32 * wq, qmax_w = qmin_w + 31;
    const unsigned lds0 = (unsigned)(uintptr_t)lds;
    ATT_LAS float* wsf = wsbase + wid * 64;
    const int NT = t_hi - t_lo;
    unsigned koff[NKW], voff[2];
#pragma unroll
    for (int i = 0; i < NKW; ++i) { const int p = TWO ? wid : wid + 8 * i;
        if (DK == 64) { const int r = 8 * p + (lane >> 3), pc = lane & 7; koff[i] = (unsigned)(r * 128 + ((pc ^ ((r >> 1) & 7)) << 4)); }
        else          { const int r = 4 * p + (lane >> 4), pc = lane & 15; koff[i] = (unsigned)(r * 256 + ((pc ^ (r & 15)) << 4)); } }
#pragma unroll
    for (int i = 0; i < 2; ++i) { const int p = wid + 8 * i, r = 4 * p + (lane >> 4), pc = lane & 15; voff[i] = (unsigned)(r * 256 + ((pc ^ (((r & 3) << 2) | ((r >> 2) & 3))) << 4)); }
    constexpr long ktile = 64L * DK, vtile = 64L * 128;
#define ATT_DMA(t, slot) do { \
        _Pragma("unroll") for (int d_ = 0; d_ < ATT_KDUP; ++d_) _Pragma("unroll") for (int i_ = 0; i_ < NKW; ++i_) glds16s(uniform_ptr(Kp + (long)(t) * ktile + (TWO ? (long)i_ * mapstride : 0L)), koff[i_], (unsigned)__builtin_amdgcn_readfirstlane(lds0 + (slot) * RSLOT + (wid + 8 * i_) * 1024)); \
        _Pragma("unroll") for (int i_ = 0; i_ < 2; ++i_)   glds16s(uniform_ptr(Vp + (long)(t) * vtile), voff[i_], (unsigned)__builtin_amdgcn_readfirstlane(lds0 + (slot) * RSLOT + SLOT + (wid + 8 * i_) * 1024)); } while (0)
#define ATT_NEED(t) (!(64 * (t) > qmax_w || 64 * (t) + 63 < qmin_w - wskip))
    if (!pre) { ATT_DMA(t_lo, ATT_SL(0)); if (NT > 1) ATT_DMA(t_lo + 1, ATT_SL(1)); }
    bf16x8 qr[NKS];
#pragma unroll
    for (int d0 = 0; d0 < NKS; ++d0) qr[d0] = *reinterpret_cast<const bf16x8*>(Qp + (TWO ? (long)mp * mapstride : 0L) + (long)qrow * DK + d0 * 16 + hi * 8);
    float l_run = 0.f;
    f32x16 o[4];
#pragma unroll
    for (int d = 0; d < 4; ++d)
#pragma unroll
        for (int r = 0; r < 16; ++r) o[d][r] = 0.f;
    f32x16 p0, p1; bf16x8 pa[4];
#pragma unroll
    for (int r = 0; r < 16; ++r) { p0[r] = 0.f; p1[r] = 0.f; }
#pragma unroll
    for (int i = 0; i < 4; ++i) pa[i] = (bf16x8){0, 0, 0, 0, 0, 0, 0, 0};
    const int ksw = (DK == 64) ? ((r32 >> 1) & 7) : (r32 & 15);
    const unsigned kbx = (unsigned)(r32 * (DK * 2) + ((hi ^ (ksw & 1)) << 4) + ((ksw >> 1) << 5)) + (TWO ? (unsigned)mp * 8192u : 0u);
    const int vq = (lane & 15) >> 2, vpp = lane & 3, vblk = (lane >> 4) & 1;
    const unsigned vbx = (unsigned)(SLOT + 1024 * hi + 256 * vq + 8 * (vpp & 1) + 64 * vq + 16 * ((2 * vblk + (vpp >> 1)) ^ hi));
    ATT_LAS const char* const ldsc = (ATT_LAS const char*)lds;
    if (pre) asm volatile("s_waitcnt vmcnt(0)" ::: "memory"); else
    if (NT > 1) { if (NKW * ATT_KDUP == 1) asm volatile("s_waitcnt vmcnt(3)" ::: "memory"); else if (NKW * ATT_KDUP == 2) asm volatile("s_waitcnt vmcnt(4)" ::: "memory"); else asm volatile("s_waitcnt vmcnt(6)" ::: "memory"); } else asm volatile("s_waitcnt vmcnt(0)" ::: "memory");
    asm volatile("s_waitcnt lgkmcnt(0)\n\ts_barrier" ::: "memory");
#pragma unroll
    for (int d0 = 0; d0 < NKS; ++d0) asm volatile("" : "+v"(qr[d0]));
#if ATT_SIMPLE
#define ATT_QK(tr_) do { const int t_ = t_lo + (tr_); \
        const float tb = slope2 * (float)(64 * t_ + 4 * hi - qrow) - cref; \
        _Pragma("unroll") for (int r = 0; r < 16; ++r) { p0[r] = __builtin_fmaf(slope2, (float)((r & 3) + 8 * (r >> 2)), tb); p1[r] = __builtin_fmaf(slope2, (float)(32 + (r & 3) + 8 * (r >> 2)), tb); } \
        unsigned kb_ = kbx + ATT_SL(tr_) * RSLOT; asm volatile("" : "+v"(kb_)); \
        _Pragma("unroll") for (int blk = 0; blk < NKS / 4; ++blk) { \
            unsigned ka[4]; \
            _Pragma("unroll") for (int j = 0; j < 4; ++j) ka[j] = kb_ ^ (unsigned)(32 * (4 * blk + j)); \
            bf16x8 kb0[4], kb1[4]; \
            _Pragma("unroll") for (int j = 0; j < 4; ++j) { ATT_LAS const char* kp = ldsc + ka[j]; kb0[j] = *(ATT_LAS const bf16x8*)kp; kb1[j] = *(ATT_LAS const bf16x8*)(kp + 32 * DK * 2); } \
            __builtin_amdgcn_sched_barrier(0); if (ATT_PRIO) __builtin_amdgcn_s_setprio(1); \
            _Pragma("unroll") for (int j = 0; j < 4; ++j) { p0 = __builtin_amdgcn_mfma_f32_32x32x16_bf16(kb0[j], qr[4 * blk + j], p0, 0, 0, 0); p1 = __builtin_amdgcn_mfma_f32_32x32x16_bf16(kb1[j], qr[4 * blk + j], p1, 0, 0, 0); } \
            if (ATT_PRIO) __builtin_amdgcn_s_setprio(0); __builtin_amdgcn_sched_barrier(0); } } while (0)
#define ATT_SM(tr_) do { const int t_ = t_lo + (tr_); \
        if (64 * t_ + 63 > qmin_w || 64 * t_ < qmax_w - win) {        \
            const int dq = qrow - 64 * t_ - 4 * hi; const unsigned uw = (unsigned)win; \
            _Pragma("unroll") for (int r = 0; r < 16; ++r) { const int c = (r & 3) + 8 * (r >> 2); \
                if ((unsigned)(dq - c) > uw) p0[r] = -INFINITY; if ((unsigned)(dq - c - 32) > uw) p1[r] = -INFINITY; } } \
        float sa = 0.f, sb = 0.f, sc = 0.f, sd = 0.f; \
        _Pragma("unroll") for (int r = 0; r < 16; r += 2) { p0[r] = __builtin_amdgcn_exp2f(p0[r]); p0[r + 1] = __builtin_amdgcn_exp2f(p0[r + 1]); p1[r] = __builtin_amdgcn_exp2f(p1[r]); p1[r + 1] = __builtin_amdgcn_exp2f(p1[r + 1]); \
            sa += p0[r]; sb += p0[r + 1]; sc += p1[r]; sd += p1[r + 1]; } \
        l_run += (sa + sb) + (sc + sd); \
        u32x4 w; \
        w.x = cvtpk(p0[0], p0[1]); w.y = cvtpk(p0[2], p0[3]); w.z = cvtpk(p0[4], p0[5]); w.w = cvtpk(p0[6], p0[7]); pa[0] = __builtin_bit_cast(bf16x8, w); \
        w.x = cvtpk(p0[8], p0[9]); w.y = cvtpk(p0[10], p0[11]); w.z = cvtpk(p0[12], p0[13]); w.w = cvtpk(p0[14], p0[15]); pa[1] = __builtin_bit_cast(bf16x8, w); \
        w.x = cvtpk(p1[0], p1[1]); w.y = cvtpk(p1[2], p1[3]); w.z = cvtpk(p1[4], p1[5]); w.w = cvtpk(p1[6], p1[7]); pa[2] = __builtin_bit_cast(bf16x8, w); \
        w.x = cvtpk(p1[8], p1[9]); w.y = cvtpk(p1[10], p1[11]); w.z = cvtpk(p1[12], p1[13]); w.w = cvtpk(p1[14], p1[15]); pa[3] = __builtin_bit_cast(bf16x8, w); } while (0)
#define ATT_PV(tr_) do { unsigned vb_ = vbx + ATT_SL(tr_) * RSLOT; asm volatile("" : "+v"(vb_)); if (ATT_PRIO) __builtin_amdgcn_s_setprio(1); \
        s16x4 vl[16], vh[16]; \
        _Pragma("unroll") for (int i = 0; i < 16; ++i) { vl[i] = vtr(ldsc + (vb_ ^ (unsigned)(64 * (i >> 2))) + (i & 3) * 4096); vh[i] = vtr(ldsc + (vb_ ^ (unsigned)(64 * (i >> 2) + 32)) + (i & 3) * 4096 + 2048); } \
        _Pragma("unroll") for (int i = 0; i < 16; ++i) { \
            const bf16x8 vf = (bf16x8){vl[i][0], vl[i][1], vl[i][2], vl[i][3], vh[i][0], vh[i][1], vh[i][2], vh[i][3]}; \
            o[i >> 2] = __builtin_amdgcn_mfma_f32_32x32x16_bf16(pa[i & 3], vf, o[i >> 2], 0, 0, 0); } \
        __builtin_amdgcn_sched_group_barrier(0x100, 8, 0); \
        _Pragma("unroll") for (int i = 0; i < 12; ++i) { __builtin_amdgcn_sched_group_barrier(0x8, 1, 0); __builtin_amdgcn_sched_group_barrier(0x100, 2, 0); } \
        _Pragma("unroll") for (int i = 0; i < 4; ++i) __builtin_amdgcn_sched_group_barrier(0x8, 1, 0); if (ATT_PRIO) __builtin_amdgcn_s_setprio(0); } while (0)
#if ATT_SIMPLE == 3
    if (half) asm volatile("s_waitcnt lgkmcnt(0)\n\ts_barrier" ::: "memory");
    for (int tr = 0; tr <= NT; ++tr) {
        if (tr + 2 < NT) ATT_DMA(t_lo + tr + 2, (tr + 2) & 3);
        if (tr > 0 && ATT_NEED(t_lo + tr - 1)) { ATT_PV(tr - 1); }
        if (tr < NT && ATT_NEED(t_lo + tr)) { ATT_QK(tr); }
        if (tr + 2 < NT) { if (NKW == 1) asm volatile("s_waitcnt vmcnt(3)" ::: "memory"); else asm volatile("s_waitcnt vmcnt(4)" ::: "memory"); } else asm volatile("s_waitcnt vmcnt(0)" ::: "memory");
        asm volatile("s_waitcnt lgkmcnt(0)\n\ts_barrier" ::: "memory");
        if (tr == NT) break;
        if (ATT_NEED(t_lo + tr)) { ATT_SM(tr); }
        asm volatile("s_waitcnt lgkmcnt(0)\n\ts_barrier" ::: "memory");
    }
    if (!half) asm volatile("s_waitcnt lgkmcnt(0)\n\ts_barrier" ::: "memory");
#elif ATT_SIMPLE == 2
    for (int tr = 0; tr < NT; ++tr) {
        if (tr + 1 < NT) { if (NKW == 1) asm volatile("s_waitcnt vmcnt(3)" ::: "memory"); else asm volatile("s_waitcnt vmcnt(4)" ::: "memory"); } else asm volatile("s_waitcnt vmcnt(0)" ::: "memory");
        asm volatile("s_waitcnt lgkmcnt(0)\n\ts_barrier" ::: "memory");
        if (tr + 2 < NT) ATT_DMA(t_lo + tr + 2, (tr + 2) & 3);
        if (half == 0) {
            if (ATT_NEED(t_lo + tr)) { ATT_QK(tr); ATT_SM(tr); ATT_PV(tr); }
        } else {
            if (tr > 0 && ATT_NEED(t_lo + tr - 1)) { ATT_SM(tr - 1); ATT_PV(tr - 1); }
            if (ATT_NEED(t_lo + tr)) { ATT_QK(tr); }
        }
    }
    if (half != 0 && ATT_NEED(t_lo + NT - 1)) { ATT_SM(NT - 1); ATT_PV(NT - 1); }
#else
    for (int tp = 0; tp < NT; tp += 2) {
        asm volatile("s_waitcnt vmcnt(0)" ::: "memory");
        asm volatile("s_waitcnt lgkmcnt(0)\n\ts_barrier" ::: "memory");
        if (tp + 2 < NT) ATT_DMA(t_lo + tp + 2, ATT_SL(tp + 2));
        if (tp + 3 < NT) ATT_DMA(t_lo + tp + 3, ATT_SL(tp + 3));
#pragma unroll 1
        for (int sub = 0; sub < 2; ++sub) { const int tr = tp + sub; if (tr >= NT || !ATT_NEED(t_lo + tr)) continue; ATT_QK(tr); ATT_SM(tr); ATT_PV(tr); }
    }
#endif
#undef ATT_QK
#undef ATT_SM
#undef ATT_PV
    asm volatile("s_waitcnt vmcnt(0) lgkmcnt(0)\n\ts_barrier" ::: "memory");
#else
    const int nslots = 2 * NT + 2;
#if MK_DBG
    unsigned long long dbg_t0 = __builtin_amdgcn_s_memtime(), dbg_w = 0, dbg_a = 0, dbg_b = 0;
#endif
    for (int s = 0; s < nslots; ++s) {
        if ((s & 1) == 0) { const int tt = s >> 1; if (tt + 2 < NT) ATT_DMA(t_lo + tt + 2, (tt + 2) & 3); }
        const int k = s - half;
#if MK_DBG
        const unsigned long long dbg_pp = __builtin_amdgcn_s_memtime();
#endif
        if (k >= 0 && k <= 2 * NT) {
            const int tr = k >> 1, t = t_lo + tr;
            if ((k & 1) == 0) {
                const bool doqk = (tr < NT) && ATT_NEED(t), dopv = (tr >= 1) && ATT_NEED(t - 1);
                if (dopv) {
                    unsigned vb_ = vbx + ((tr - 1) & 3) * RSLOT; asm volatile("" : "+v"(vb_));
                    s16x4 vl[16], vh[16];
#pragma unroll
                    for (int i = 0; i < 16; ++i) { vl[i] = vtr(ldsc + (vb_ ^ (unsigned)(64 * (i >> 2))) + (i & 3) * 4096); vh[i] = vtr(ldsc + (vb_ ^ (unsigned)(64 * (i >> 2) + 32)) + (i & 3) * 4096 + 2048); }
#pragma unroll
                    for (int i = 0; i < 16; ++i) {
                        const bf16x8 vf = (bf16x8){vl[i][0], vl[i][1], vl[i][2], vl[i][3], vh[i][0], vh[i][1], vh[i][2], vh[i][3]};
                        o[i >> 2] = __builtin_amdgcn_mfma_f32_32x32x16_bf16(pa[i & 3], vf, o[i >> 2], 0, 0, 0); }
                    __builtin_amdgcn_sched_group_barrier(0x100, 8, 0);
#pragma unroll
                    for (int i = 0; i < 12; ++i) { __builtin_amdgcn_sched_group_barrier(0x8, 1, 0); __builtin_amdgcn_sched_group_barrier(0x100, 2, 0); }
#pragma unroll
                    for (int i = 0; i < 4; ++i) __builtin_amdgcn_sched_group_barrier(0x8, 1, 0);
                }
                __builtin_amdgcn_sched_barrier(0);
                if (doqk) {
                    const float tb = slope2 * (float)(64 * t + 4 * hi - qrow) - cref;
#pragma unroll
                    for (int r = 0; r < 16; ++r) { p0[r] = __builtin_fmaf(slope2, (float)((r & 3) + 8 * (r >> 2)), tb); p1[r] = __builtin_fmaf(slope2, (float)(32 + (r & 3) + 8 * (r >> 2)), tb); }
                    unsigned kb_ = kbx + (tr & 3) * RSLOT; asm volatile("" : "+v"(kb_));
#pragma unroll
                    for (int blk = 0; blk < NKS / 4; ++blk) {
                        unsigned ka[4];
#pragma unroll
                        for (int j = 0; j < 4; ++j) ka[j] = kb_ ^ (unsigned)(32 * (4 * blk + j));
                        bf16x8 kb0[4], kb1[4];
#pragma unroll
                        for (int j = 0; j < 4; ++j) { ATT_LAS const char* kp = ldsc + ka[j]; kb0[j] = *(ATT_LAS const bf16x8*)kp; kb1[j] = *(ATT_LAS const bf16x8*)(kp + 32 * DK * 2); }
                        __builtin_amdgcn_sched_barrier(0);
#pragma unroll
                        for (int j = 0; j < 4; ++j) { p0 = __builtin_amdgcn_mfma_f32_32x32x16_bf16(kb0[j], qr[4 * blk + j], p0, 0, 0, 0); p1 = __builtin_amdgcn_mfma_f32_32x32x16_bf16(kb1[j], qr[4 * blk + j], p1, 0, 0, 0); }
                        __builtin_amdgcn_sched_barrier(0);
                    }
                }
            } else if (tr < NT && ATT_NEED(t)) {
                if (64 * t + 63 > qmin_w || 64 * t < qmax_w - win) {
                    const int kb = 64 * t + 4 * hi, lo = qrow - win;
#pragma unroll
                    for (int r = 0; r < 16; ++r) { const int kv = kb + (r & 3) + 8 * (r >> 2);
                        if (kv > qrow || kv < lo) p0[r] = -INFINITY; if (kv + 32 > qrow || kv + 32 < lo) p1[r] = -INFINITY; }
                }
                float sa = 0.f, sb = 0.f, sc = 0.f, sd = 0.f;
#pragma unroll
                for (int r = 0; r < 16; r += 2) { p0[r] = __builtin_amdgcn_exp2f(p0[r]); p0[r + 1] = __builtin_amdgcn_exp2f(p0[r + 1]); p1[r] = __builtin_amdgcn_exp2f(p1[r]); p1[r + 1] = __builtin_amdgcn_exp2f(p1[r + 1]);
                    sa += p0[r]; sb += p0[r + 1]; sc += p1[r]; sd += p1[r + 1]; }
                l_run += (sa + sb) + (sc + sd);
                { u32x4 w;
                  w.x = cvtpk(p0[0], p0[1]); w.y = cvtpk(p0[2], p0[3]); w.z = cvtpk(p0[4], p0[5]); w.w = cvtpk(p0[6], p0[7]); pa[0] = __builtin_bit_cast(bf16x8, w);
                  w.x = cvtpk(p0[8], p0[9]); w.y = cvtpk(p0[10], p0[11]); w.z = cvtpk(p0[12], p0[13]); w.w = cvtpk(p0[14], p0[15]); pa[1] = __builtin_bit_cast(bf16x8, w);
                  w.x = cvtpk(p1[0], p1[1]); w.y = cvtpk(p1[2], p1[3]); w.z = cvtpk(p1[4], p1[5]); w.w = cvtpk(p1[6], p1[7]); pa[2] = __builtin_bit_cast(bf16x8, w);
                  w.x = cvtpk(p1[8], p1[9]); w.y = cvtpk(p1[10], p1[11]); w.z = cvtpk(p1[12], p1[13]); w.w = cvtpk(p1[14], p1[15]); pa[3] = __builtin_bit_cast(bf16x8, w); }
            }
        }
#if MK_DBG
        const unsigned long long dbg_t1 = __builtin_amdgcn_s_memtime();
        if (k >= 0 && k <= 2 * NT) { if ((k & 1) == 0) dbg_a += dbg_t1 - dbg_pp; else dbg_b += dbg_t1 - dbg_pp; }
#endif
        if (s & 1) { if ((s >> 1) + 2 < NT) { if (NKW * ATT_KDUP == 1) asm volatile("s_waitcnt vmcnt(3)" ::: "memory"); else if (NKW * ATT_KDUP == 2) asm volatile("s_waitcnt vmcnt(4)" ::: "memory"); else asm volatile("s_waitcnt vmcnt(6)" ::: "memory"); } else asm volatile("s_waitcnt vmcnt(0)" ::: "memory"); }
        asm volatile("s_waitcnt lgkmcnt(0)\n\ts_barrier" ::: "memory");
#if MK_DBG
        dbg_w += __builtin_amdgcn_s_memtime() - dbg_t1;
#endif
    }
#if MK_DBG
    if (dbgp != nullptr && tid == 0) { const unsigned long long tt = __builtin_amdgcn_s_memtime() - dbg_t0; dbgp[0] = (unsigned)(tt / (unsigned long long)nslots); dbgp[1] = (unsigned)(dbg_w / (unsigned long long)nslots); dbgp[2] = (unsigned)nslots; dbgp[3] = (unsigned)(dbg_a / (unsigned long long)(NT + 1)); dbgp[4] = (unsigned)(dbg_b / (unsigned long long)NT); }
#endif
#endif
#undef ATT_DMA
#undef ATT_NEED
    int lane_e = lane; asm volatile("" : "+v"(lane_e));
    const int r32e = lane_e & 31, hie = lane_e >> 5;
    int nticket = 0;
    if (qhead != nullptr && tid == 0) nticket = (int)atomicAdd(qhead, 1u);
    if (TWO && sp_cnt != nullptr) {
        typedef float f32x4_t __attribute__((ext_vector_type(4)));
        f32x4_t* dst = (f32x4_t*)sp_mine + (size_t)(wid * 17) * 64 + lane_e;
#pragma unroll
        for (int d = 0; d < 4; ++d)
#pragma unroll
            for (int q4 = 0; q4 < 4; ++q4) { const f32x4_t v = (f32x4_t){o[d][4 * q4], o[d][4 * q4 + 1], o[d][4 * q4 + 2], o[d][4 * q4 + 3]}; f32x4_t* pp = dst + (d * 4 + q4) * 64;
                asm volatile("global_store_dwordx4 %0, %1, off sc1" :: "v"(pp), "v"(v) : "memory"); }
        { const f32x4_t v = (f32x4_t){l_run, 0.f, 0.f, 0.f}; f32x4_t* pp = dst + 16 * 64; asm volatile("global_store_dwordx4 %0, %1, off sc1" :: "v"(pp), "v"(v) : "memory"); }
        asm volatile("s_waitcnt vmcnt(0) lgkmcnt(0)\n\ts_barrier" ::: "memory");
        if (tid == 0) { wsbase[1024] = __uint_as_float(atomicAdd(sp_cnt, 1u)); if (qhead != nullptr) qslot[0] = nticket; }
        asm volatile("s_waitcnt vmcnt(0) lgkmcnt(0)\n\ts_barrier" ::: "memory");
        const unsigned prev = (unsigned)__builtin_amdgcn_readfirstlane(__float_as_uint(wsbase[1024]));
        if (prev == 0u) {
            int issued = 0; if (qhead != nullptr) issued = nf(__builtin_amdgcn_readfirstlane(qslot[0]));
            if (qhead != nullptr && tid == 0) qslot[1] = issued;
            asm volatile("s_waitcnt lgkmcnt(0)\n\ts_barrier" ::: "memory"); return; }
        __builtin_amdgcn_fence(__ATOMIC_ACQUIRE, "agent");
        const f32x4_t* src = (const f32x4_t*)sp_other + (size_t)(wid * 17) * 64 + lane_e;
#pragma unroll
        for (int d = 0; d < 4; ++d)
#pragma unroll
            for (int q4 = 0; q4 < 4; ++q4) { const f32x4_t v = src[(d * 4 + q4) * 64]; o[d][4 * q4] += v[0]; o[d][4 * q4 + 1] += v[1]; o[d][4 * q4 + 2] += v[2]; o[d][4 * q4 + 3] += v[3]; }
        l_run += src[16 * 64][0];
        asm volatile("s_waitcnt lgkmcnt(0)\n\ts_barrier" ::: "memory");
    }
    const float l_tot = swapsum(l_run);
    if (hie == 0) wsf[32 + r32e] = l_tot;
    if (!TWO && lsep != nullptr && hie == 0) lsep[(long)(i0 + 32 * wid + r32e) * lstride] = __builtin_amdgcn_logf(l_tot) + cref;
    {
        ATT_LAS unsigned short* stg = (ATT_LAS unsigned short*)(lds + wid * 8192);
#pragma unroll
        for (int r = 0; r < 16; ++r) { const int orow = crow(r, hie); const float rl = __builtin_amdgcn_rcpf(wsf[32 + orow]);
#pragma unroll
            for (int d0 = 0; d0 < 4; ++d0) stg[orow * 128 + d0 * 32 + r32e] = (unsigned short)(cvtpk(o[d0][r] * rl, 0.f) & 0xffffu); }
        asm volatile("s_waitcnt lgkmcnt(0)" ::: "memory");
        if constexpr (!TWO) {
            if (qhead != nullptr) {
                if (tid == 0) qslot[0] = nticket;
                asm volatile("s_waitcnt vmcnt(0) lgkmcnt(0)\n\ts_barrier" ::: "memory");
                const int issued = nf(__builtin_amdgcn_readfirstlane(qslot[0])); if (tid == 0) qslot[1] = issued; }
            bf16_t* Ow = Op + (long)(i0 + 32 * wid) * ostride;
#pragma unroll
            for (int i = 0; i < 8; ++i) { const int row = i * 4 + (lane_e >> 4), ch = lane_e & 15; const u32x4 v = *(ATT_LAS const u32x4*)(stg + row * 128 + ch * 8); *(u32x4*)(Ow + (long)row * ostride + ch * 8) = v; }
        } else {
            const int ch = lane_e & 15; float sg[8];
#pragma unroll
            for (int j = 0; j < 8; ++j) sg[j] = sgain[ch * 8 + j] * sgscale;
            if (qhead != nullptr && tid == 0) qslot[0] = nticket;
            asm volatile("s_waitcnt vmcnt(0) lgkmcnt(0)\n\ts_barrier" ::: "memory");
            { int issued = 0; if (qhead != nullptr) issued = nf(__builtin_amdgcn_readfirstlane(qslot[0])); if (qhead != nullptr && tid == 0) qslot[1] = issued; }
            if (mp == 0) {
                ATT_LAS const unsigned short* st1 = (ATT_LAS const unsigned short*)(lds + (wid + 4) * 8192);
                bf16_t* Ow = Op + (long)(i0 + 32 * wid) * ostride;
#pragma unroll
                for (int i = 0; i < 8; ++i) { const int row = i * 4 + (lane_e >> 4);
                    const u32x4 v0 = *(ATT_LAS const u32x4*)(stg + row * 128 + ch * 8), v1 = *(ATT_LAS const u32x4*)(st1 + row * 128 + ch * 8);
                    float d[8]; float ss = 0.f;
#pragma unroll
                    for (int j = 0; j < 4; ++j) { const float a0 = __uint_as_float(v0[j] << 16), a1 = __uint_as_float(v0[j] & 0xffff0000u), b0 = __uint_as_float(v1[j] << 16), b1 = __uint_as_float(v1[j] & 0xffff0000u);
                        d[2 * j] = a0 - lam * b0; d[2 * j + 1] = a1 - lam * b1; ss += d[2 * j] * d[2 * j] + d[2 * j + 1] * d[2 * j + 1]; }
                    ss += __shfl_xor(ss, 1); ss += __shfl_xor(ss, 2); ss += __shfl_xor(ss, 4); ss += __shfl_xor(ss, 8);
                    const float rstd = 1.0f / sqrtf(ss * (1.f / 128.f) + eps);
                    u32x4 w; w.x = cvtpk(d[0] * rstd * sg[0], d[1] * rstd * sg[1]); w.y = cvtpk(d[2] * rstd * sg[2], d[3] * rstd * sg[3]); w.z = cvtpk(d[4] * rstd * sg[4], d[5] * rstd * sg[5]); w.w = cvtpk(d[6] * rstd * sg[6], d[7] * rstd * sg[7]);
                    *(u32x4*)(Ow + (long)row * ostride + ch * 8) = w; }
            }
        }
    }
    asm volatile("s_waitcnt lgkmcnt(0)\n\ts_barrier" ::: "memory");
}
}
constexpr int NWAVES = 8;
constexpr int BATCH = 2, SEQ = 8192, DM = 2048, M = BATCH * SEQ;
constexpr int NIN = 11776;
#ifndef MK_NINP
#define MK_NINP 11776
#endif
constexpr int NINP = MK_NINP;
constexpr int C_DAQ = 0, C_DAK = 1024, C_DAV = 2048, C_DLQ = 3072, C_DLK = 4608, C_DLV = 6144, C_GA = 7680, C_GB = 9728;
constexpr int NE = 32, DFF = 1024, TK = 2 * M;
constexpr int XS_ROWS = TK + NE * 256;
constexpr float EPS = 1e-6f, LOG2E = 1.4426950408889634f;
constexpr float LAM_INIT = 0.2f;

#ifndef MK_N_LAUNCHES
#define MK_N_LAUNCHES 1
#endif
constexpr int N_PHASES = 12;
#ifndef MK_DBG_Q
#define MK_DBG_Q 250u
#endif
#ifndef MK_DBG_THR
#define MK_DBG_THR 0u
#endif
#ifndef MK_DBG_UNIT
#define MK_DBG_UNIT 0
#endif
#ifndef MK_SPLIT_AT
#define MK_SPLIT_AT (-1)
#endif
#ifndef MK_REPEAT_SUB
#define MK_REPEAT_SUB 3
#endif

constexpr size_t MiB = 1u << 20;
constexpr size_t WS_CTL = 0, CTL_ZERO_BYTES = 256 * 1024;
constexpr size_t WS_WR   = 1 * MiB;
constexpr size_t WS_GAIN = 1 * MiB + 512 * 1024;
constexpr size_t WS_ROUTE = 2 * MiB;
constexpr size_t WS_LSE  = 3 * MiB;
constexpr size_t WS_WIN  = 4 * MiB;
constexpr size_t WS_WIN8 = 36 * MiB;
constexpr size_t WS_XN8  = 672 * MiB;
constexpr size_t WS_WA   = 50 * MiB;
constexpr size_t WS_WB   = 54 * MiB;
constexpr size_t WS_WO   = 56 * MiB;
constexpr size_t WS_WGU  = 64 * MiB;
constexpr size_t WS_WD   = 320 * MiB;
constexpr size_t WS_XN   = 448 * MiB;
constexpr size_t WS_ODA  = 512 * MiB;
constexpr size_t WS_ODL  = 576 * MiB;
constexpr size_t WS_OA   = 624 * MiB;
constexpr size_t WS_OB   = 656 * MiB;
constexpr size_t WS_MIX  = 672 * MiB;
constexpr size_t WS_PROJ = 736 * MiB;
constexpr size_t WS_XS   = WS_PROJ;
constexpr size_t WS_Y8   = WS_PROJ + 240 * MiB;
constexpr size_t WS_HB   = WS_PROJ + 160 * MiB;
constexpr size_t WS_LIST = WS_PROJ + 376 * MiB;
constexpr size_t WS_RSL  = WS_LIST + 2 * MiB;
constexpr size_t WS_END  = WS_RSL + 2 * MiB;
static_assert((size_t)XS_ROWS * 2048 * 2 <= 160 * MiB && (size_t)XS_ROWS * 1024 * 2 <= 80 * MiB && (size_t)M * NINP * 2 <= 376 * MiB, "ws map");
constexpr int CW_TMO = 0, CW_CODE = 1;
constexpr int CW_BAR = 4096;
constexpr int CW_CNTP = 32768;
constexpr int CW_CNT = 16384, CW_FILL = 16384 + 64;
static_assert(true, "");
constexpr int CW_TQ = 24576;
constexpr int CW_DBG = 20480;
constexpr int CW_SPLIT = 21000;
constexpr int CW_QUEUE = 20544;

constexpr int RING_OFF = 0, RING_BYTES = 131072;
constexpr int LDSCTL_OFF = RING_BYTES, MISC_OFF = LDSCTL_OFF + 320;
constexpr int TILE_E_OFF = LDSCTL_OFF + 1024;
constexpr int XCH_OFF = LDSCTL_OFF + 2048;
constexpr int LDS_BYTES = 147456;
static_assert(XCH_OFF + 8192 <= LDS_BYTES && att::ATT_LDS_BYTES <= RING_BYTES, "LDS map");

#define GAS __attribute__((address_space(1)))
#define LAS __attribute__((address_space(3)))
typedef unsigned short bf16;
typedef unsigned v4u __attribute__((ext_vector_type(4)));
typedef float f32x4 __attribute__((ext_vector_type(4)));
typedef short bf16x8 __attribute__((ext_vector_type(8)));
typedef GAS unsigned gu32;
typedef GAS unsigned long long gu64;
#define RLX_AGENT __ATOMIC_RELAXED, __HIP_MEMORY_SCOPE_AGENT
#define LDS_WAIT() asm volatile("s_waitcnt lgkmcnt(0)" ::: "memory")
#define VM_WAIT() asm volatile("s_waitcnt vmcnt(0)" ::: "memory")
__device__ __forceinline__ unsigned long long rt() { return __builtin_amdgcn_s_memrealtime(); }
__device__ __forceinline__ unsigned f2bf(float f) { unsigned u = __builtin_bit_cast(unsigned, f); return (u + 0x7fffu + ((u >> 16) & 1u)) >> 16; }
__device__ __forceinline__ unsigned pk2(float lo, float hi) { return f2bf(lo) | (f2bf(hi) << 16); }

#define XB_TMO      128
#define XB_XCNT(j)  (256  + 64 * (j))
#define XB_XSUB(j)  (1280 + 64 * (j))
#define XB_XGEN(j)  (2304 + 64 * (j))
#define XB_TOP      3328
#define XB_TOPGEN   3392
#define XCD_BAR_WORDS 3456
#define XB_SPIN_CAP (1u << 18)

__device__ __forceinline__ unsigned xb_ld(unsigned* p)              { return __hip_atomic_load(p, __ATOMIC_RELAXED, __HIP_MEMORY_SCOPE_AGENT); }
__device__ __forceinline__ unsigned xb_add(unsigned* p, unsigned v) { return __hip_atomic_fetch_add(p, v, __ATOMIC_RELAXED, __HIP_MEMORY_SCOPE_AGENT); }
__device__ __forceinline__ unsigned xb_xcc_id() { return (unsigned)__builtin_amdgcn_s_getreg((3 << 11) | 20) & 0xFu; }
#define XB_SPIN(cond, bar) do { unsigned _sp = 0; while (cond) { __builtin_amdgcn_s_sleep(1); \
    if ((++_sp & 255u) == 0u) { if (xb_ld(&(bar)[XB_TMO])) break; if (_sp > XB_SPIN_CAP) { atomicAdd(&(bar)[XB_TMO], 1u); break; } } } } while (0)

struct XcdBarrier {
    unsigned* bar; unsigned x; unsigned w0;
    volatile LAS unsigned* st;
};

__device__ __forceinline__ XcdBarrier xcd_barrier_post(unsigned* bar, volatile LAS unsigned* st, unsigned w0) {
    XcdBarrier b; b.bar = bar; b.x = xb_xcc_id(); b.st = st; b.w0 = w0;
    if (w0 && mk_lane() == 0) (void)xb_add(&bar[XB_XCNT(b.x)], 1u);
    return b;
}
__device__ __forceinline__ void xcd_barrier_complete(unsigned* bar, unsigned x, unsigned& nloc, unsigned& nx) {
    const unsigned G = gridDim.x * gridDim.y * gridDim.z;
    unsigned sum, cnt, mine, sp = 0u;
    for (;;) {
        sum = 0u; cnt = 0u; mine = 0u;
#pragma unroll
        for (unsigned j = 0; j < 16; ++j) { const unsigned c = xb_ld(&bar[XB_XCNT(j)]); sum += c; cnt += (c > 0u) ? 1u : 0u; mine = (j == x) ? c : mine; }
        if (sum == G) break;
        __builtin_amdgcn_s_sleep(1);
        if ((++sp & 255u) == 0u) { if (xb_ld(&bar[XB_TMO])) break; if (sp > XB_SPIN_CAP) { atomicAdd(&bar[XB_TMO], 1u); break; } }
    }
    nloc = mine > 0u ? mine : 1u; nx = cnt > 0u ? cnt : 1u;
}

__device__ __forceinline__ void xcd_barrier(const XcdBarrier& b) {
    asm volatile("s_waitcnt vmcnt(0)" ::: "memory");
    __syncthreads();
    if (b.w0 && mk_lane() == 0) {
        unsigned* bar = b.bar;
        __builtin_amdgcn_s_waitcnt(0);
        unsigned nloc = b.st[0], nx = b.st[1];
        if (nloc == 0u) { xcd_barrier_complete(bar, b.x, nloc, nx); b.st[0] = nloc; b.st[1] = nx; }
        const unsigned old = xb_add(&bar[XB_XSUB(b.x)], 1u);
        const unsigned gen = old / nloc;
        if (old + 1u == (gen + 1u) * nloc) {
            __builtin_amdgcn_fence(__ATOMIC_RELEASE, "agent");
            asm volatile("s_waitcnt vmcnt(0)" ::: "memory");
            const unsigned og = xb_add(&bar[XB_TOP], 1u);
            const unsigned tg = og / nx;
            if (og + 1u == (tg + 1u) * nx) xb_add(&bar[XB_TOPGEN], 1u);
            else XB_SPIN(xb_ld(&bar[XB_TOPGEN]) == tg, bar);
            __builtin_amdgcn_fence(__ATOMIC_ACQUIRE, "agent");
            xb_add(&bar[XB_XGEN(b.x)], 1u);
            asm volatile("s_waitcnt vmcnt(0)" ::: "memory");
        } else {
            XB_SPIN(xb_ld(&bar[XB_XGEN(b.x)]) == gen, bar);
            __builtin_amdgcn_fence(__ATOMIC_ACQUIRE, "agent");
            asm volatile("s_waitcnt vmcnt(0)" ::: "memory");
        }
    }
    __syncthreads();
}
struct Args { const float* in[18]; float* out; unsigned char* ws; int ph_lo, ph_hi, li, sub; };
struct Frame {
    const Args* ka;
    LAS unsigned char* lds;
    volatile LAS unsigned* MISC;
    gu32* ctl;
    int wave;
    int vcu, G, li;
    unsigned char* ws;
    float* out;
};
__device__ __forceinline__ float wave_sum(float v) {
#pragma unroll
    for (int o = 1; o < 64; o <<= 1) v += __shfl_xor(v, o);
    return v;
}
__device__ __forceinline__ void p0_transpose_item(const float* W, int K, int N, bf16* WT, int k0, int n0, int dst_row0, LAS unsigned char* scr, int lane, int kdst = -1) {
    if (kdst < 0) kdst = k0;
    const int q = lane >> 4, m = lane & 15;
    const GAS f32x4* src = (const GAS f32x4*)(W + (size_t)(k0 + 2 * q) * N + n0) + m;
    f32x4 v[16];
#pragma unroll
    for (int i = 0; i < 16; ++i) v[i] = __builtin_nontemporal_load(src + (((size_t)(8 * (i >> 1) + (i & 1)) * N) >> 2));
#pragma unroll
    for (int j = 0; j < 8; ++j) {
#pragma unroll
        for (int c = 0; c < 4; ++c) {
            const int n = 4 * m + c, col = (4 * j + q) ^ ((m & 7) << 2);
            *(LAS unsigned*)(scr + n * 128 + col * 4) = pg8::cvt_pk_bf16(v[2 * j][c], v[2 * j + 1][c]);
        }
    }
    LDS_WAIT(); asm volatile("" ::: "memory");
    const int ch = lane & 7;
#pragma unroll
    for (int i = 0; i < 8; ++i) { const int n = 8 * i + (lane >> 3);
        const v4u o = *(const LAS v4u*)(scr + n * 128 + ((ch ^ ((n >> 2) & 7)) << 4));
        *(GAS v4u*)(WT + (size_t)(dst_row0 + n) * K + kdst + 8 * ch) = o; }
    LDS_WAIT(); asm volatile("" ::: "memory");
}
__device__ __forceinline__ void p0_item_load(const float* W, int N, int k0, int n0, int lane, f32x4 (&v)[16]) {
    const int q = lane >> 4, m = lane & 15;
    const GAS f32x4* src = (const GAS f32x4*)(W + (size_t)(k0 + 2 * q) * N + n0) + m;
#pragma unroll
    for (int i = 0; i < 16; ++i) v[i] = __builtin_nontemporal_load(src + (((size_t)(8 * (i >> 1) + (i & 1)) * N) >> 2));
}
__device__ __forceinline__ void p0_item_store(const f32x4 (&v)[16], int K, bf16* WT, int k0, int dst_row0, LAS unsigned char* scr, int lane) {
    const int q = lane >> 4, m = lane & 15;
#pragma unroll
    for (int j = 0; j < 8; ++j) {
#pragma unroll
        for (int c = 0; c < 4; ++c) {
            const int n = 4 * m + c, col = (4 * j + q) ^ ((m & 7) << 2);
            *(LAS unsigned*)(scr + n * 128 + col * 4) = pg8::cvt_pk_bf16(v[2 * j][c], v[2 * j + 1][c]);
        }
    }
    LDS_WAIT(); asm volatile("" ::: "memory");
    const int ch = lane & 7;
#pragma unroll
    for (int i = 0; i < 8; ++i) { const int n = 8 * i + (lane >> 3);
        const v4u o = *(const LAS v4u*)(scr + n * 128 + ((ch ^ ((n >> 2) & 7)) << 4));
        *(GAS v4u*)(WT + (size_t)(dst_row0 + n) * K + k0 + 8 * ch) = o; }
    LDS_WAIT(); asm volatile("" ::: "memory");
}
__device__ __forceinline__ void p0_item_store_fp8(const f32x4 (&v)[16], int K, unsigned char* WT, int k0, int dst_row0, LAS unsigned char* scr, int lane, const LAS float* gk = nullptr) {
    const int q = lane >> 4, m = lane & 15;
#pragma unroll
    for (int j = 0; j < 8; ++j) {
#pragma unroll
        for (int c = 0; c < 4; ++c) {
            const int n = 4 * m + c, kb = 8 * j + 2 * q;
            const float s0 = gk ? gk[k0 + kb] * pg8::WSCALE : pg8::WSCALE, s1 = gk ? gk[k0 + kb + 1] * pg8::WSCALE : pg8::WSCALE;
            const int p = __builtin_amdgcn_cvt_pk_fp8_f32(v[2 * j][c] * s0, v[2 * j + 1][c] * s1, 0, false);
            *(LAS unsigned short*)(scr + n * 64 + ((((kb >> 4) ^ (m & 3)) << 4) | (kb & 15))) = (unsigned short)p;
        }
    }
    LDS_WAIT(); asm volatile("" ::: "memory");
    const int ch = lane & 3;
#pragma unroll
    for (int i = 0; i < 4; ++i) { const int n = 16 * i + (lane >> 2);
        const v4u o = *(const LAS v4u*)(scr + n * 64 + ((ch ^ ((n >> 2) & 3)) << 4));
        __builtin_nontemporal_store(o, (GAS v4u*)(WT + (size_t)(dst_row0 + n) * K + k0 + 16 * ch)); }
    LDS_WAIT(); asm volatile("" ::: "memory");
}
struct MoeItem { const float* W; bf16* WT; int K, N, k0, n0, drow, f8; const LAS float* gk; };
__device__ __forceinline__ MoeItem moe_item(Frame& F, int r) {
    constexpr int I_GU1 = (DM / 64) * (2048 / 64), I_GU = NE * I_GU1, I_D1 = (DFF / 64) * (DM / 64);
    MoeItem it;
    if (r < I_GU) { const int e = r / I_GU1, q = r % I_GU1, nblk = 2048 / 64, kb = q / nblk, nb = (q % nblk + kb) % nblk, n0 = 64 * nb, j = n0 & 1023, up = n0 >> 10;
        it.W = F.ka->in[16] + (size_t)e * DM * 2048; it.WT = (bf16*)(F.ws + WS_WGU + (size_t)e * 2048 * DM); it.K = DM; it.N = 2048; it.k0 = 64 * kb; it.n0 = n0; it.drow = 256 * (j >> 7) + 128 * up + (j & 127); it.f8 = 1; it.gk = (const LAS float*)(F.lds + RING_OFF + 65536); }
    else { r -= I_GU; const int e = r / I_D1, q = r % I_D1, nblk = DM / 64, kb = q / nblk, nb = (q % nblk + kb) % nblk;
        it.W = F.ka->in[17] + (size_t)e * DFF * DM; it.WT = (bf16*)(F.ws + WS_WD + (size_t)e * DM * DFF); it.K = DFF; it.N = DM; it.k0 = 64 * kb; it.n0 = 64 * nb; it.drow = 64 * nb; it.f8 = 1; it.gk = nullptr; }
    return it;
}
__device__ __forceinline__ void p0_moe_weights(Frame& F, int gw, int NGW) {
    constexpr int NIT = NE * ((DM / 64) * (2048 / 64) + (DFF / 64) * (DM / 64));
    LAS unsigned char* scr = F.lds + RING_OFF + F.wave * 8192;
    { LAS float* gl = (LAS float*)(F.lds + RING_OFF + 65536); for (int k = F.wave * 64 + mk_lane(); k < DM; k += NWAVES * 64) gl[k] = F.ka->in[13][k]; __syncthreads(); }
    f32x4 va[16], vb[16];
    int r = gw;
    if (r < NIT) { const MoeItem a = moe_item(F, r); p0_item_load(a.W, a.N, a.k0, a.n0, mk_lane(), va); }
    for (; r < NIT; r += 2 * NGW) {
        const MoeItem a = moe_item(F, r);
        const bool hb = r + NGW < NIT; MoeItem b = a;
        if (hb) { b = moe_item(F, r + NGW); p0_item_load(b.W, b.N, b.k0, b.n0, mk_lane(), vb); }
        if (a.f8) p0_item_store_fp8(va, a.K, (unsigned char*)a.WT, a.k0, a.drow, scr, mk_lane(), a.gk); else p0_item_store(va, a.K, a.WT, a.k0, a.drow, scr, mk_lane());
        if (r + 2 * NGW < NIT) { const MoeItem c = moe_item(F, r + 2 * NGW); p0_item_load(c.W, c.N, c.k0, c.n0, mk_lane(), va); }
        if (hb) { if (b.f8) p0_item_store_fp8(vb, b.K, (unsigned char*)b.WT, b.k0, b.drow, scr, mk_lane(), b.gk); else p0_item_store(vb, b.K, b.WT, b.k0, b.drow, scr, mk_lane()); }
    }
}
__device__ __forceinline__ void p0_prologue(Frame& F, int which, int gw, int NGW) {
    LAS unsigned char* scr = F.lds + RING_OFF + F.wave * 8192;
    constexpr int I_IN = (DM / 64) * (NIN / 64), I_A = (1024 / 64) * (DM / 64), I_B = (512 / 64) * (DM / 64), I_O = (DM / 64) * (DM / 64);
    constexpr int I_GU1 = (DM / 64) * (2048 / 64), I_GU = NE * I_GU1, I_D1 = (DFF / 64) * (DM / 64), I_D = NE * I_D1;
    constexpr int NITEMS = I_IN + I_A + I_B + I_O + I_GU + I_D;
    bf16* WIN = (bf16*)(F.ws + WS_WIN); bf16* WA = (bf16*)(F.ws + WS_WA); bf16* WB = (bf16*)(F.ws + WS_WB); bf16* WO = (bf16*)(F.ws + WS_WO); bf16* WGU = (bf16*)(F.ws + WS_WGU); bf16* WD = (bf16*)(F.ws + WS_WD);
    for (int it = gw; it < NITEMS; it += NGW) {
        int r = it;
        if (!(which & 1) && r < I_IN + I_A + I_B + I_O) continue;
        if (!(which & 2) && r >= I_IN + I_A + I_B + I_O) break;
        if (r < I_IN) { const int nblk = NIN / 64, kb = r / nblk, nb = r % nblk;
            const int n0 = 64 * nb, r8 = (n0 >= C_GA) ? n0 - C_GA : (n0 >= C_DAV && n0 < C_DLQ) ? 4096 + (n0 - C_DAV) : (n0 >= C_DLV) ? 5120 + (n0 - C_DLV) : -1;
            if (r8 < 0) p0_transpose_item(F.ka->in[2], DM, NIN, WIN, 64 * kb, n0, n0, scr, mk_lane());
            else { f32x4 v[16]; p0_item_load(F.ka->in[2], NIN, 64 * kb, n0, mk_lane(), v); p0_item_store_fp8(v, DM, (unsigned char*)(F.ws + WS_WIN8), 64 * kb, r8, scr, mk_lane()); }
            continue; } r -= I_IN;
        if (r < I_A)  { const int nblk = DM / 64, kb = r / nblk, nb = r % nblk; p0_transpose_item(F.ka->in[10], 1536, DM, WA, 64 * kb, 64 * nb, 64 * nb, scr, mk_lane()); continue; } r -= I_A;
        if (r < I_B)  { const int nblk = DM / 64, kb = r / nblk, nb = r % nblk; p0_transpose_item(F.ka->in[11], 1536, DM, WA, 64 * kb, 64 * nb, 64 * nb, scr, mk_lane(), 1024 + 64 * kb); continue; } r -= I_B;
        if (r < I_O)  { const int nblk = DM / 64, kb = r / nblk, nb = r % nblk; p0_transpose_item(F.ka->in[12], DM, DM, WO, 64 * kb, 64 * nb, 64 * nb, scr, mk_lane()); continue; } r -= I_O;
        if (r < I_GU) { const int e = r / I_GU1, q = r % I_GU1, nblk = 2048 / 64, kb = q / nblk, nb = q % nblk, n0 = 64 * nb, j = n0 & 1023, up = n0 >> 10;
                        p0_transpose_item(F.ka->in[16] + (size_t)e * DM * 2048, DM, 2048, WGU + (size_t)e * 2048 * DM, 64 * kb, n0, 256 * (j >> 7) + 128 * up + (j & 127), scr, mk_lane()); continue; } r -= I_GU;
        { const int e = r / I_D1, q = r % I_D1, nblk = DM / 64, kb = q / nblk, nb = q % nblk;
          p0_transpose_item(F.ka->in[17] + (size_t)e * DFF * DM, DFF, DM, WD + (size_t)e * DM * DFF, 64 * kb, 64 * nb, 64 * nb, scr, mk_lane()); }
    }
    bf16* XN = (bf16*)(F.ws + WS_XN);
    if (which & 4) {
        f32x4 g[8];
#pragma unroll
        for (int j = 0; j < 8; ++j) g[j] = *((const GAS f32x4*)F.ka->in[1] + mk_lane() + 64 * j);
        for (int m = gw; m < M; m += 2 * NGW) {
            const int m2 = (m + NGW < M) ? m + NGW : m;
            const GAS f32x4* xr = (const GAS f32x4*)(F.ka->in[0] + (size_t)m * DM) + mk_lane(); const GAS f32x4* xr2 = (const GAS f32x4*)(F.ka->in[0] + (size_t)m2 * DM) + mk_lane();
            f32x4 v[8], w[8]; float s = 0.f, s2 = 0.f;
#pragma unroll
            for (int j = 0; j < 8; ++j) { v[j] = __builtin_nontemporal_load(xr + 64 * j); w[j] = __builtin_nontemporal_load(xr2 + 64 * j); }
#pragma unroll
            for (int j = 0; j < 8; ++j) { s += (v[j].x * v[j].x + v[j].y * v[j].y) + (v[j].z * v[j].z + v[j].w * v[j].w); s2 += (w[j].x * w[j].x + w[j].y * w[j].y) + (w[j].z * w[j].z + w[j].w * w[j].w); }
            const float rstd = 1.0f / sqrtf(wave_sum(s) * (1.f / DM) + EPS), rstd2 = 1.0f / sqrtf(wave_sum(s2) * (1.f / DM) + EPS);
            GAS unsigned long long* o8 = (GAS unsigned long long*)(XN + (size_t)m * DM) + mk_lane(); GAS unsigned long long* o82 = (GAS unsigned long long*)(XN + (size_t)m2 * DM) + mk_lane();
            GAS unsigned* q8 = (GAS unsigned*)((unsigned char*)(F.ws + WS_XN8) + (size_t)m * DM) + mk_lane(); GAS unsigned* q82 = (GAS unsigned*)((unsigned char*)(F.ws + WS_XN8) + (size_t)m2 * DM) + mk_lane();
#pragma unroll
            for (int j = 0; j < 8; ++j) { const f32x4 t = v[j] * rstd * g[j]; o8[64 * j] = (unsigned long long)pk2(t.x, t.y) | ((unsigned long long)pk2(t.z, t.w) << 32); q8[64 * j] = pg8::pk_fp8x4(t.x * pg8::XSCALE, t.y * pg8::XSCALE, t.z * pg8::XSCALE, t.w * pg8::XSCALE);
                                          const f32x4 t2 = w[j] * rstd2 * g[j]; o82[64 * j] = (unsigned long long)pk2(t2.x, t2.y) | ((unsigned long long)pk2(t2.z, t2.w) << 32); q82[64 * j] = pg8::pk_fp8x4(t2.x * pg8::XSCALE, t2.y * pg8::XSCALE, t2.z * pg8::XSCALE, t2.w * pg8::XSCALE); }
        }
    }
    if ((which & 4) && F.vcu == 0 && (F.wave * 64 + mk_lane()) < 384) { float* GN = (float*)(F.ws + WS_GAIN); const int t = (F.wave * 64 + mk_lane()); GN[t] = (t < 64) ? F.ka->in[3][t] : (t < 128) ? F.ka->in[4][t - 64] : (t < 256) ? F.ka->in[8][t - 128] : F.ka->in[9][t - 256]; }
    if (which & 4) { float* WR = (float*)(F.ws + WS_WR);
      for (int i = (F.vcu * NWAVES * 64) + (F.wave * 64 + mk_lane()); i < DM * 48; i += F.G * NWAVES * 64) { const int k = i / 48, c = i % 48; const float gn = F.ka->in[13][k];
          WR[i] = (c < 32) ? F.ka->in[15][k * 32 + c] * gn : (c < 36) ? F.ka->in[14][k * 4 + (c - 32)] * gn : 0.f; } }
}
__device__ __forceinline__ void p2_attention(Frame& F, int which) {
    const bf16* PROJ = (const bf16*)(F.ws + WS_PROJ);
    bf16* ODA = (bf16*)(F.ws + WS_ODA); bf16* ODL = (bf16*)(F.ws + WS_ODL); float* LSE = (float*)(F.ws + WS_LSE);
    float gq = fabsf(F.ka->in[3][mk_lane()]), gk = fabsf(F.ka->in[4][mk_lane()]);
#pragma unroll
    for (int o = 1; o < 64; o <<= 1) { gq = fmaxf(gq, __shfl_xor(gq, o)); gk = fmaxf(gk, __shfl_xor(gk, o)); }
    const float Bq = 8.0f * gq * gk * 1.02f;
    float g1 = fmaxf(fabsf(F.ka->in[8][mk_lane()]), fabsf(F.ka->in[8][64 + mk_lane()])), g2 = fmaxf(fabsf(F.ka->in[9][mk_lane()]), fabsf(F.ka->in[9][64 + mk_lane()]));
#pragma unroll
    for (int o = 1; o < 64; o <<= 1) { g1 = fmaxf(g1, __shfl_xor(g1, o)); g2 = fmaxf(g2, __shfl_xor(g2, o)); }
    const float Bl = 11.313708f * g1 * g2 * 1.02f;
    const float lam = expf(wave_sum(F.ka->in[5][mk_lane()] * F.ka->in[6][mk_lane()])) - expf(wave_sum(F.ka->in[5][64 + mk_lane()] * F.ka->in[6][64 + mk_lane()])) + LAM_INIT;
    constexpr int NDA = 1024 + 128;
    constexpr size_t SPLIT_DUMP_FLOATS = (size_t)8 * 17 * 64 * 4;
    volatile LAS int* QW = (volatile LAS int*)(F.MISC + 16);
    unsigned* const qhead = (unsigned*)(F.ctl + CW_QUEUE) + 64 * F.li;
    constexpr int NUNITS = NDA + 768;
    struct AUnit { int kind; const bf16* Q; const bf16* K; const bf16* V; int i0, t_lo, t_hi, wskip; float slope2; bf16* O; long ostride; float* lse; long lstride; float* spm; const float* spo; unsigned* spc; };
    auto decode = [&](int u, AUnit& A) {
        if (u < NDA) {
            int h, b, qb, sub = -1, sidx = 0;
            if (u < 256) { sub = u & 1; sidx = u >> 1; h = 7 - (sidx >> 6); b = (sidx >> 5) & 1; qb = 63 - (sidx & 31); }
            else { const int w = u - 256; if (w < 128) { h = 7 - (w >> 6); b = (w >> 5) & 1; qb = 31 - (w & 31); } else { const int v = w + 128; h = 7 - (v >> 7); b = (v >> 6) & 1; qb = 63 - (v & 63); } }
            const float slope = exp2f(-(float)(h + 1));
            const float Df = (2.0f * Bq + 20.0f) / slope;
            const int Dk = (Df < 1.0e6f) ? (int)Df + 1 : (1 << 20);
            int t_lo = (128 * qb - Dk) >> 6; if (t_lo < 0) t_lo = 0;
            int t_hi = 2 * (qb + 1);
            A.spm = nullptr; A.spo = nullptr; A.spc = nullptr;
            if (sub >= 0) { const int t_mid = t_lo + ((t_hi - t_lo) >> 1); if (sub == 0) t_hi = t_mid; else t_lo = t_mid;
                float* sbase = (float*)(F.ws + WS_ODA) + (size_t)sidx * 2 * SPLIT_DUMP_FLOATS; A.spm = sbase + (size_t)sub * SPLIT_DUMP_FLOATS; A.spo = sbase + (size_t)(1 - sub) * SPLIT_DUMP_FLOATS; A.spc = (unsigned*)(F.ctl + CW_SPLIT) + sidx + 128 * F.li; }
            A.kind = 0; A.Q = PROJ + pg8::PJ_QA + (size_t)((b * 8 + h) * 2) * SEQ * 64; A.K = PROJ + pg8::PJ_KA + (size_t)((b * 8 + h) * 2) * SEQ * 64; A.V = PROJ + pg8::PJ_VA + (size_t)(b * 8 + h) * SEQ * 128;
            A.i0 = 128 * qb; A.t_lo = t_lo; A.t_hi = t_hi; A.wskip = Dk; A.slope2 = slope * LOG2E; A.O = (bf16*)(F.ws + WS_OA) + (size_t)b * SEQ * 1536 + h * 128; A.ostride = 1536L; A.lse = nullptr; A.lstride = 0L;
        } else {
            const int v = u - NDA, b = v / 384, rem = v % 384, g = rem / 128, rem2 = rem % 128, h = rem2 / 32, j = rem2 % 32;
            const int d = (g == 0) ? 1 : (g == 1) ? 4 : 16, nblk = 32 / d, r = j / nblk, iblk = j % nblk, hh = g * 4 + h;
            const size_t hoff = ((size_t)(b * 12 + hh) * SEQ + (size_t)r * (SEQ / d)) * 128;
            A.kind = 1; A.Q = PROJ + pg8::PJ_QL + hoff; A.K = PROJ + pg8::PJ_KL + hoff; A.V = PROJ + pg8::PJ_VL + hoff; A.i0 = 256 * iblk; A.t_lo = (4 * iblk - 2 < 0) ? 0 : 4 * iblk - 2; A.t_hi = 4 * iblk + 4; A.wskip = 128;
            A.slope2 = exp2f(-8.0f * (float)(hh + 1) / 12.0f) * (float)d * LOG2E; A.O = ODL + (size_t)g * M * 512 + ((size_t)b * SEQ + r) * 512 + h * 128; A.ostride = 512L * d;
            A.lse = LSE + (size_t)g * M * 4 + ((size_t)b * SEQ + r) * 4 + h; A.lstride = 4L * d; A.spm = nullptr; A.spo = nullptr; A.spc = nullptr;
        }
    };
    auto nf = [&](int tk) -> int {
        if (tk >= NUNITS) return 0;
        AUnit N; decode(tk, N);
        if (!((N.kind == 0) ? (which & 1) : (which & 2))) return 0;
        const unsigned l0 = (unsigned)(uintptr_t)(F.lds + RING_OFF);
        if (N.kind == 0) att::att_issue_first<64, true>(N.K, N.V, (long)SEQ * 64, N.t_lo, N.t_hi - N.t_lo, l0, F.wave, mk_lane());
        else att::att_issue_first<128, false>(N.K, N.V, 0L, N.t_lo, N.t_hi - N.t_lo, l0, F.wave, mk_lane());
        return 1;
    };
    if ((F.wave * 64 + mk_lane()) == 0) { QW[0] = (int)atomicAdd(qhead, 1u); QW[1] = 0; }
    __syncthreads();
    for (;;) {
        const int u = __builtin_amdgcn_readfirstlane(QW[0]); const bool pre = __builtin_amdgcn_readfirstlane(QW[1]) != 0;
        if (u >= NUNITS) break;
        AUnit A; decode(u, A);
        bool ran = false;
        if (A.kind == 0) { if (which & 1) { ran = true;
            att::attn_unit<64, true>(A.Q, A.K, A.V, A.i0, A.t_lo, A.t_hi, 1 << 30, A.wskip, A.slope2, Bq * LOG2E - 20.0f, A.O, A.ostride, nullptr, 0L, F.lds + RING_OFF, (LAS float*)(F.lds + XCH_OFF), F.wave, nullptr,
                                     (long)SEQ * 64, lam, F.ka->in[7], 1.0f - LAM_INIT, EPS, A.spm, A.spo, A.spc, qhead, QW, pre, nf); } }
        else { if (which & 2) { ran = true;
            att::attn_unit<128, false>(A.Q, A.K, A.V, A.i0, A.t_lo, A.t_hi, 128, 128, A.slope2, Bl * LOG2E - 20.0f, A.O, A.ostride, A.lse, A.lstride, F.lds + RING_OFF, (LAS float*)(F.lds + XCH_OFF), F.wave, nullptr,
                                       0L, 0.f, nullptr, 1.f, 0.f, nullptr, nullptr, nullptr, qhead, QW, pre, nf); } }
        if (!ran) { __syncthreads(); if ((F.wave * 64 + mk_lane()) == 0) { QW[0] = (int)atomicAdd(qhead, 1u); QW[1] = 0; } __syncthreads(); }
    }
}
__device__ __forceinline__ void p3_merge(Frame& F) {
    const int gw = F.vcu * NWAVES + F.wave, NGW = F.G * NWAVES, lane = mk_lane();
    const bf16* ODA = (const bf16*)(F.ws + WS_ODA); const bf16* ODL = (const bf16*)(F.ws + WS_ODL); const float* LSE = (const float*)(F.ws + WS_LSE);
    bf16* OA = (bf16*)(F.ws + WS_OA); bf16* OB = (bf16*)(F.ws + WS_OB);
    for (int m = gw; m < M; m += NGW) {
        {
            const int h = lane >> 4;
            const float l0 = LSE[(size_t)m * 4 + h], l1 = LSE[(size_t)M * 4 + (size_t)m * 4 + h], l2 = LSE[(size_t)2 * M * 4 + (size_t)m * 4 + h];
            const float mx = fmaxf(l0, fmaxf(l1, l2)); float w0 = exp2f(l0 - mx), w1 = exp2f(l1 - mx), w2 = exp2f(l2 - mx); const float inv = 1.0f / (w0 + w1 + w2); w0 *= inv; w1 *= inv; w2 *= inv;
            float a[8], b[8], c[8];
            pg8::unpack8(__builtin_nontemporal_load((const v4u*)(ODL + (size_t)m * 512 + lane * 8)), a); pg8::unpack8(__builtin_nontemporal_load((const v4u*)(ODL + (size_t)M * 512 + (size_t)m * 512 + lane * 8)), b); pg8::unpack8(__builtin_nontemporal_load((const v4u*)(ODL + (size_t)2 * M * 512 + (size_t)m * 512 + lane * 8)), c);
            v4u o;
            o.x = pk2(w0 * a[0] + w1 * b[0] + w2 * c[0], w0 * a[1] + w1 * b[1] + w2 * c[1]); o.y = pk2(w0 * a[2] + w1 * b[2] + w2 * c[2], w0 * a[3] + w1 * b[3] + w2 * c[3]);
            o.z = pk2(w0 * a[4] + w1 * b[4] + w2 * c[4], w0 * a[5] + w1 * b[5] + w2 * c[5]); o.w = pk2(w0 * a[6] + w1 * b[6] + w2 * c[6], w0 * a[7] + w1 * b[7] + w2 * c[7]);
            *(v4u*)(OA + (size_t)m * 1536 + 1024 + lane * 8) = o;
        }
    }
}
__device__ __forceinline__ f32x4 bf4_to_f32(unsigned long long a) {
    f32x4 r; r.x = __uint_as_float((unsigned)a << 16); r.y = __uint_as_float((unsigned)a & 0xffff0000u); r.z = __uint_as_float((unsigned)(a >> 32) << 16); r.w = __uint_as_float((unsigned)(a >> 32) & 0xffff0000u); return r; }
__device__ __forceinline__ void p7_router(Frame& F) {
    typedef float f32x4v __attribute__((ext_vector_type(4)));
    LAS float* LG = (LAS float*)(F.lds);
    LAS float* SS = (LAS float*)(F.lds + 98304);
    LAS float* RS = (LAS float*)(F.lds + 25088);
    const float* WR = (const float*)(F.ws + WS_WR);
    int* EIDX = (int*)(F.ws + WS_ROUTE); float* EW = (float*)(F.ws + WS_ROUTE + 131072); int* POS = (int*)(F.ws + WS_ROUTE + 262144); int* HISTG = (int*)(F.ws + WS_ROUTE + 524288); float* RSTD = (float*)(F.ws + WS_ROUTE + 393216);
    unsigned char* XQ = (unsigned char*)(F.ws + WS_XS);
    bf16* XN2 = (bf16*)(F.ws + WS_XN); const bf16* DELTA = (const bf16*)(F.ws + WS_ODA);
    const int lane = mk_lane(), wave = F.wave, i = lane & 15, kq = lane >> 4;
    for (int it = F.vcu; it < M / 64; it += F.G) {
        const int row0 = 64 * it;
        const size_t eo = (size_t)(row0 + i) * DM + 64 * wave + 16 * kq;
        const float* xr = F.ka->in[0] + eo;
        const bf16* dr = DELTA + eo;
        unsigned char* xq = XQ + eo;
        const float* wr = WR + (size_t)(64 * wave + 16 * kq) * 48 + i;
        f32x4v a[4][3]; float ssq[4];
#pragma unroll
        for (int g4 = 0; g4 < 4; ++g4) { ssq[g4] = 0.f;
#pragma unroll
            for (int j = 0; j < 3; ++j) a[g4][j] = (f32x4v){0.f, 0.f, 0.f, 0.f}; }
        float wv[4][4][3];
        f32x4 xb[4][4]; unsigned long long db[4][4];
#define P7_LOADX(b_, T_, g_) do { const size_t no_ = (size_t)(16 * (g_)) * DM + 512 * (T_); _Pragma("unroll") for (int tt = 0; tt < 4; ++tt) { xb[b_][tt] = __builtin_nontemporal_load((const f32x4*)(xr + no_ + 4 * tt)); db[b_][tt] = __builtin_nontemporal_load((const unsigned long long*)(dr + no_ + 4 * tt)); } } while (0)
        P7_LOADX(0, 0, 0); P7_LOADX(1, 0, 1); P7_LOADX(2, 0, 2);
#pragma unroll
        for (int tt = 0; tt < 4; ++tt) {
#pragma unroll
            for (int c = 0; c < 4; ++c) { const float* w = wr + (size_t)(4 * tt + c) * 48; wv[tt][c][0] = w[0]; wv[tt][c][1] = w[16]; wv[tt][c][2] = w[32]; } }
#pragma unroll 1
        for (int T = 0; T < 4; ++T) {
            const int Tn = (T < 3) ? T + 1 : 3;
#pragma unroll
            for (int g4 = 0; g4 < 4; ++g4) {
                if (g4 == 0) P7_LOADX(3, T, 3); else P7_LOADX(g4 - 1, Tn, g4 - 1);
#pragma unroll
                for (int tt = 0; tt < 4; ++tt) {
                    const f32x4 xv = xb[g4][tt] + bf4_to_f32(db[g4][tt]);
                    ssq[g4] += (xv.x * xv.x + xv.y * xv.y) + (xv.z * xv.z + xv.w * xv.w);
                    *(unsigned*)(xq + (size_t)(16 * g4) * DM + 512 * T + 4 * tt) = pg8::pk_fp8x4(xv.x * pg8::XSCALE, xv.y * pg8::XSCALE, xv.z * pg8::XSCALE, xv.w * pg8::XSCALE);
#pragma unroll
                    for (int c = 0; c < 4; ++c) { const float xa = xv[c];
                        a[g4][0] = __builtin_amdgcn_mfma_f32_16x16x4f32(xa, wv[tt][c][0], a[g4][0], 0, 0, 0); a[g4][1] = __builtin_amdgcn_mfma_f32_16x16x4f32(xa, wv[tt][c][1], a[g4][1], 0, 0, 0); a[g4][2] = __builtin_amdgcn_mfma_f32_16x16x4f32(xa, wv[tt][c][2], a[g4][2], 0, 0, 0); }
                    if (g4 == 3) {
#pragma unroll
                        for (int c = 0; c < 4; ++c) { const float* w = wr + (size_t)(512 * Tn + 4 * tt + c) * 48; wv[tt][c][0] = w[0]; wv[tt][c][1] = w[16]; wv[tt][c][2] = w[32]; }
                    }
                }
            }
        }
#undef P7_LOADX
#pragma unroll
        for (int g4 = 0; g4 < 4; ++g4) { float s = ssq[g4]; s += __shfl_xor(s, 16); s += __shfl_xor(s, 32);
#pragma unroll
            for (int reg = 0; reg < 4; ++reg) { LAS float* p = LG + (wave * 64 + 16 * g4 + 4 * kq + reg) * 48 + i; p[0] = a[g4][0][reg]; p[16] = a[g4][1][reg]; p[32] = a[g4][2][reg]; }
            if (kq == 0) SS[wave * 64 + 16 * g4 + i] = s; }
        __syncthreads();
        if ((F.wave * 64 + mk_lane()) < 64) {
            const int r = (F.wave * 64 + mk_lane());
            float sst = 0.f;
#pragma unroll
            for (int w8 = 0; w8 < 8; ++w8) sst += SS[w8 * 64 + r];
            const float rstd = 1.0f / sqrtf(sst * (1.f / DM) + EPS);
            const LAS float* l0 = LG + r * 48;
#define P7_L(c) (((l0[(c)] + l0[64 * 48 + (c)]) + (l0[2 * 64 * 48 + (c)] + l0[3 * 64 * 48 + (c)])) + ((l0[4 * 64 * 48 + (c)] + l0[5 * 64 * 48 + (c)]) + (l0[6 * 64 * 48 + (c)] + l0[7 * 64 * 48 + (c)])))
            float gl[4];
#pragma unroll
            for (int j = 0; j < 4; ++j) gl[j] = P7_L(32 + j) * rstd;
            int g = 0; float gmax = gl[0];
#pragma unroll
            for (int j = 1; j < 4; ++j) if (gl[j] > gmax) { gmax = gl[j]; g = j; }
            float gs = 0.f;
#pragma unroll
            for (int j = 0; j < 4; ++j) gs += expf(gl[j] - gmax);
            const float gw = 1.0f / gs;
            float t0 = -INFINITY, t1 = -INFINITY; int i0 = 0, i1 = 0;
#pragma unroll
            for (int j = 0; j < 8; ++j) { const float v = P7_L(8 * g + j) * rstd;
                if (v > t0) { t1 = t0; i1 = i0; t0 = v; i0 = j; } else if (v > t1) { t1 = v; i1 = j; } }
            const float e1 = expf(t1 - t0), w0 = gw / (1.0f + e1), w1 = gw * e1 / (1.0f + e1);
            const int e0i = 8 * g + i0, e1i = 8 * g + i1, row = row0 + r;
            EIDX[2 * row] = e0i; EIDX[2 * row + 1] = e1i; EW[2 * row] = w0; EW[2 * row + 1] = w1;
            if (!(MK_SPLIT_AT == 7 && F.li == 1)) {
                LAS int* HI = (LAS int*)(F.lds + 98304 + 2048);
                if (r < 32) HI[r] = 0;
                asm volatile("s_waitcnt lgkmcnt(0)" ::: "memory");
                const int p0l = __hip_atomic_fetch_add(HI + e0i, 1, __ATOMIC_RELAXED, __HIP_MEMORY_SCOPE_WORKGROUP);
                asm volatile("s_waitcnt lgkmcnt(0)" ::: "memory");
                const int p1l = __hip_atomic_fetch_add(HI + e1i, 1, __ATOMIC_RELAXED, __HIP_MEMORY_SCOPE_WORKGROUP);
                asm volatile("s_waitcnt lgkmcnt(0)" ::: "memory");
                if (r < 32) HISTG[it * 32 + r] = HI[r];
                POS[2 * row] = p0l; POS[2 * row + 1] = p1l; RSTD[row] = rstd;
            }
        }
        __syncthreads();
        __syncthreads();
    }
#undef P7_L
}
__device__ __forceinline__ void build_tables(Frame& F, LAS int* PS, LAS int* CN, LAS int* TE) {
    const int* HISTG = (const int*)(F.ws + WS_ROUTE + 524288);
    LAS int* TOTS = (LAS int*)(F.lds + XCH_OFF + 1024);
    const int tid = F.wave * 64 + mk_lane();
    { const int e = tid & 31, seg = tid >> 5; int s = 0;
#pragma unroll
      for (int j = 0; j < 16; ++j) s += HISTG[(16 * seg + j) * 32 + e];
      TOTS[seg * 32 + e] = s; }
    __syncthreads();
    if (tid < 32) { int c = 0;
#pragma unroll
        for (int seg = 0; seg < 16; ++seg) c += TOTS[seg * 32 + tid];
        CN[tid] = c; }
    __syncthreads();
    if (tid == 0) {
        int acc = 0, t = 0;
        for (int e = 0; e < NE; ++e) { PS[e] = acc; const int c = CN[e]; const int nt = (c + 255) >> 8; for (int k = 0; k < nt; ++k) TE[t++] = e; acc += nt << 8; }
        PS[NE] = acc; TE[160] = t;
    }
    __syncthreads();
}
__device__ __forceinline__ void p8_finalize(Frame& F) {
    static_assert(M / 64 == 256, "p8 / build_tables: 256 items in 16 segments of 16");
    const int* HISTG = (const int*)(F.ws + WS_ROUTE + 524288); const LAS int* TOTS = (const LAS int*)(F.lds + XCH_OFF + 1024);
    LAS int* BASE = (LAS int*)(F.lds + XCH_OFF + 1024 + 2048);
    const int* EIDX = (const int*)(F.ws + WS_ROUTE); int* POS = (int*)(F.ws + WS_ROUTE + 262144); const float* RSTD = (const float*)(F.ws + WS_ROUTE + 393216);
    int* LIST = (int*)(F.ws + WS_LIST); float* RSL = (float*)(F.ws + WS_RSL);
    const int tid = F.wave * 64 + mk_lane();
    for (int it = F.vcu; it < M / 64; it += F.G) {
        if (tid < 32) { int b = 0; const int sg = it >> 4;
            for (int seg = 0; seg < sg; ++seg) b += TOTS[seg * 32 + tid];
            for (int j = 16 * sg; j < it; ++j) b += HISTG[j * 32 + tid];
            BASE[tid] = b; }
        __syncthreads();
        if (tid < 64) { const int row = 64 * it + tid, e0 = EIDX[2 * row], e1 = EIDX[2 * row + 1];
            const int p0 = BASE[e0] + POS[2 * row], p1 = BASE[e1] + POS[2 * row + 1]; const float rstd = RSTD[row];
            POS[2 * row] = p0; POS[2 * row + 1] = p1;
            LIST[(size_t)e0 * M + p0] = row; LIST[(size_t)e1 * M + p1] = row; RSL[(size_t)e0 * M + p0] = rstd; RSL[(size_t)e1 * M + p1] = rstd; }
        __syncthreads();
    }
}
__device__ __forceinline__ void p11_combine(Frame& F) {
    const int gw = F.vcu * NWAVES + F.wave, NGW = F.G * NWAVES, lane = mk_lane();
    const float* EW = (const float*)(F.ws + WS_ROUTE + 131072); const int* POS = (const int*)(F.ws + WS_ROUTE + 262144); const int* EIDX = (const int*)(F.ws + WS_ROUTE);
    const LAS int* PS = (const LAS int*)(F.lds + XCH_OFF);
    const unsigned char* Y = (const unsigned char*)(F.ws + WS_Y8); const bf16* DELTA = (const bf16*)(F.ws + WS_ODA);
    typedef float f32x2c __attribute__((ext_vector_type(2)));
    for (int m = gw; m < M; m += NGW) {
        const int s0 = PS[EIDX[2 * m]] + POS[2 * m], s1 = PS[EIDX[2 * m + 1]] + POS[2 * m + 1]; const float w0 = EW[2 * m] * (1.0f / pg8::YSCALE), w1 = EW[2 * m + 1] * (1.0f / pg8::YSCALE);
        GAS f32x4* op = (GAS f32x4*)(F.out + (size_t)m * DM) + lane; const GAS f32x4* xp = (const GAS f32x4*)(F.ka->in[0] + (size_t)m * DM) + lane; const GAS unsigned long long* dp = (const GAS unsigned long long*)(DELTA + (size_t)m * DM) + lane;
        const GAS unsigned* y0 = (const GAS unsigned*)(Y + (size_t)s0 * DM) + lane; const GAS unsigned* y1 = (const GAS unsigned*)(Y + (size_t)s1 * DM) + lane;
#pragma unroll
        for (int j = 0; j < 8; ++j) { f32x4 v = __builtin_nontemporal_load(xp + 64 * j) + bf4_to_f32(__builtin_nontemporal_load(dp + 64 * j)); const unsigned a = __builtin_nontemporal_load(y0 + 64 * j), b = __builtin_nontemporal_load(y1 + 64 * j);
            const f32x2c a0 = __builtin_amdgcn_cvt_pk_f32_fp8((int)a, false), a1 = __builtin_amdgcn_cvt_pk_f32_fp8((int)a, true), b0 = __builtin_amdgcn_cvt_pk_f32_fp8((int)b, false), b1 = __builtin_amdgcn_cvt_pk_f32_fp8((int)b, true);
            v.x += w0 * a0.x + w1 * b0.x; v.y += w0 * a0.y + w1 * b0.y; v.z += w0 * a1.x + w1 * b1.x; v.w += w0 * a1.y + w1 * b1.y;
            __builtin_nontemporal_store(v, (f32x4*)(op + 64 * j)); }
    }
}

__global__ void __launch_bounds__(NWAVES * 64, 2) mk_fwd(Args args) {
    extern __shared__ __attribute__((aligned(16))) unsigned char lds[];
    Frame F;
    F.lds = (LAS unsigned char*)lds;
    F.MISC = (volatile LAS unsigned*)(F.lds + MISC_OFF);
    F.wave = __builtin_amdgcn_readfirstlane((int)threadIdx.x >> 6);
    F.G = gridDim.x; { const int bx = blockIdx.x; F.vcu = (F.G % 8 == 0) ? (bx % 8) * (F.G / 8) + bx / 8 : bx; }
    F.ws = args.ws; F.ctl = (gu32*)(args.ws + WS_CTL); F.out = args.out; F.li = args.li;
    F.ka = &args;
    for (int u = (F.wave * 64 + mk_lane()); u < (LDS_BYTES - LDSCTL_OFF) / 4; u += NWAVES * 64) ((LAS unsigned*)(F.lds + LDSCTL_OFF))[u] = 0u;
    __syncthreads();
    XcdBarrier bar; bar.bar = (unsigned*)(F.ctl + CW_BAR) + args.li * XCD_BAR_WORDS; bar.x = 0; bar.st = nullptr; bar.w0 = 0;
    if (MK_N_LAUNCHES == 1) bar = xcd_barrier_post((unsigned*)(F.ctl + CW_BAR) + args.li * XCD_BAR_WORDS, F.MISC + 8, F.wave == 0 ? 1u : 0u);
    const int lo = args.ph_lo, hi = args.ph_hi;
#define IN(k) (lo <= (k) && (k) < hi)
#define SEAM(k) do { if (IN(k) && IN((k) + 1)) xcd_barrier(bar); } while (0)
    bf16* XN = (bf16*)(F.ws + WS_XN); bf16* PROJ = (bf16*)(F.ws + WS_PROJ); bf16* MIX = (bf16*)(F.ws + WS_MIX);

    #ifndef MK_NCONV
#define MK_NCONV 80
#endif
    const bool conv_wg = (F.G == 256) && ((int)blockIdx.x >> 3) >= 32 - MK_NCONV / 8; const int conv_idx = ((int)blockIdx.x & 7) * (MK_NCONV / 8) + (((int)blockIdx.x >> 3) - (32 - MK_NCONV / 8));
    if (IN(0)) { p0_prologue(F, ((args.li == 1) ? args.sub : 7) & 5, F.vcu * NWAVES + F.wave, F.G * NWAVES); } SEAM(0);
    if (IN(1)) {
        if (conv_wg && !(MK_SPLIT_AT == 1 && args.li == 1)) { p0_moe_weights(F, conv_idx * NWAVES + F.wave, MK_NCONV * NWAVES); __syncthreads(); }
        if (F.G != 256 && !(MK_SPLIT_AT == 1 && args.li == 1)) { p0_moe_weights(F, F.vcu * NWAVES + F.wave, F.G * NWAVES); __syncthreads(); }
        pg8::EpiProj E{PROJ, (const float*)(F.ws + WS_GAIN), (LAS float*)(F.lds + XCH_OFF), 0.125f * LOG2E, 0.08838834764831845f * LOG2E, EPS};
        if (F.G == 256) {
            { pg8::Gemm g{XN, (const bf16*)(F.ws + WS_WIN), M, C_GA, DM, 0};
              pg8::TicketOrder S{(unsigned*)(F.ctl + CW_TQ) + 64 * ((int)blockIdx.x & 7) + 1024 * F.li, (int)blockIdx.x & 7, 8 * 20, (volatile LAS int*)(F.MISC + 20), F.wave, 1};
              pg8::gemm_phase<pg8::EpiProj, pg8::TicketOrder, true, true>(F.wave, F.lds + RING_OFF, g, S, E); }
            { pg8::Gemm g{(const bf16*)(F.ws + WS_XN8), (const bf16*)(F.ws + WS_WIN8), M, 6656, DM / 2, 0};
              pg8::TicketOrder S{(unsigned*)(F.ctl + CW_TQ) + 512 + 64 * ((int)blockIdx.x & 7) + 1024 * F.li, (int)blockIdx.x & 7, 8 * 26, (volatile LAS int*)(F.MISC + 22), F.wave, 0};
              pg8::EpiGateSig EG{(unsigned char*)(PROJ + pg8::PJ_G), 1.0f / (pg8::XSCALE * pg8::WSCALE), PROJ};
              pg8::gemm_phase<pg8::EpiGateSig, pg8::TicketOrder, true, true, false, true>(F.wave, F.lds + RING_OFF, g, S, EG); }
        } else {
            pg8::Gemm g{XN, (const bf16*)(F.ws + WS_WIN), M, C_GA, DM, 0}; pg8::SkipOrder S0; S0.base.init(M, 20 * 256, F.G, (int)blockIdx.x); pg8::gemm_phase<pg8::EpiProj, pg8::SkipOrder, true, true>(F.wave, F.lds + RING_OFF, g, S0, E);
            pg8::Gemm g2{(const bf16*)(F.ws + WS_XN8), (const bf16*)(F.ws + WS_WIN8), M, 6656, DM / 2, 0}; pg8::StaticOrder S1; S1.init(M, 6656, F.G, (int)blockIdx.x);
            pg8::EpiGateSig EG{(unsigned char*)(PROJ + pg8::PJ_G), 1.0f / (pg8::XSCALE * pg8::WSCALE), PROJ}; pg8::gemm_phase<pg8::EpiGateSig, pg8::StaticOrder, true, true, false, true>(F.wave, F.lds + RING_OFF, g2, S1, EG);
        }
    } SEAM(1);
    if (IN(2)) { p2_attention(F, (args.li == 1 && lo == 2) ? args.sub : 3); } SEAM(2);
    if (IN(3)) { p3_merge(F); } SEAM(3);
    if (IN(4)) {
        pg8::Gemm g{(const bf16*)(F.ws + WS_OA), (const bf16*)(F.ws + WS_WA), M, DM, 1536, 0}; pg8::MixOrder S; S.base.init(M, DM, F.G, (int)blockIdx.x);
        pg8::EpiMix E{MIX, DM, (const unsigned char*)(PROJ + pg8::PJ_G)};
        pg8::gemm_phase<pg8::EpiMix, pg8::MixOrder, true, true>(F.wave, F.lds + RING_OFF, g, S, E);
    }
    if (IN(4) && IN(6)) xcd_barrier(bar);
    if (IN(6)) {
        pg8::Gemm g{MIX, (const bf16*)(F.ws + WS_WO), M, DM, DM, 0}; pg8::StaticOrder S; S.init(M, DM, F.G, (int)blockIdx.x);
        pg8::EpiPlain E{(bf16*)(F.ws + WS_ODA), DM, 1.0f};
        pg8::gemm_phase<pg8::EpiPlain, pg8::StaticOrder, true, true>(F.wave, F.lds + RING_OFF, g, S, E);
    } SEAM(6);
    if (IN(7)) { p7_router(F); }
    if (IN(7) && (IN(8) || IN(9))) xcd_barrier(bar);
    LAS int* TE = (LAS int*)(F.lds + TILE_E_OFF); LAS int* PS = (LAS int*)(F.lds + XCH_OFF); LAS int* CN = (LAS int*)(F.lds + XCH_OFF + 256);
    if (hi > 8 && lo <= 11) build_tables(F, PS, CN, TE);
    if (IN(8)) { p8_finalize(F); } SEAM(8);
    if (IN(9)) {
        pg8::Gemm g{(const bf16*)(F.ws + WS_XS), (const bf16*)(F.ws + WS_WGU), M, 2048, DM / 2, (size_t)2048 * DM};
        pg8::GroupOrder S{TE[160], F.G, (int)blockIdx.x, TE, PS, CN, (const int*)(F.ws + WS_LIST), M};
        pg8::EpiSwiglu E{(unsigned char*)(F.ws + WS_HB), DFF, 1.0f / (pg8::XSCALE * pg8::WSCALE), (const float*)(F.ws + WS_RSL), PS, M};
        pg8::gemm_phase<pg8::EpiSwiglu, pg8::GroupOrder, true, true, true, true>(F.wave, F.lds + RING_OFF, g, S, E);
    } SEAM(9);
    if (IN(10)) {
        pg8::Gemm g{(const bf16*)(F.ws + WS_HB), (const bf16*)(F.ws + WS_WD), XS_ROWS, DM, DFF / 2, (size_t)DM * DFF};
        pg8::GroupOrder S{TE[160], F.G, (int)blockIdx.x, TE, PS, CN, (const int*)(F.ws + WS_LIST), M};
        pg8::EpiFp8 E{(unsigned char*)(F.ws + WS_Y8), DM, pg8::YSCALE / (pg8::HSCALE * pg8::WSCALE)};
        pg8::gemm_phase<pg8::EpiFp8, pg8::GroupOrder, true, true, false, true>(F.wave, F.lds + RING_OFF, g, S, E);
    } SEAM(10);
    if (IN(11)) { p11_combine(F); }
#undef IN
#undef SEAM
}

extern "C" void kernel_launch(void* const* d_in, const int* in_sizes, int n_in, void* d_out, int out_size, void* d_ws, size_t ws_size, hipStream_t stream) {
    static int grid = 0;
    if (grid == 0) {
        if (n_in != 18 || out_size != M * DM || ws_size < WS_END) { fprintf(stderr, "kernel_launch: unexpected problem shape or workspace (%d inputs, out %d, ws %zu < %zu)\n", n_in, out_size, ws_size, (size_t)WS_END); grid = -1; return; }
        int dev = 0, cus = 0, per_cu = 0;
        if (hipGetDevice(&dev) != hipSuccess || hipDeviceGetAttribute(&cus, hipDeviceAttributeMultiprocessorCount, dev) != hipSuccess) { grid = -1; return; }
        if (hipFuncSetAttribute((const void*)mk_fwd, hipFuncAttributeMaxDynamicSharedMemorySize, LDS_BYTES) != hipSuccess) { fprintf(stderr, "kernel_launch: hipFuncSetAttribute failed\n"); grid = -1; return; }
        if (hipOccupancyMaxActiveBlocksPerMultiprocessor(&per_cu, (const void*)mk_fwd, NWAVES * 64, LDS_BYTES) != hipSuccess || per_cu < 1) { fprintf(stderr, "kernel_launch: occupancy query says %d blocks per CU\n", per_cu); (void)hipGetLastError(); grid = -1; return; }
        grid = cus;
        if (grid != 256) fprintf(stderr, "kernel_launch: %d CUs (tuned for 256)\n", grid);
    }
    if (grid < 0) return;
    (void)hipMemsetAsync((char*)d_ws + WS_CTL, 0, CTL_ZERO_BYTES, stream);
    Args a{};
    for (int i = 0; i < 18; ++i) a.in[i] = (const float*)d_in[i];
    a.out = (float*)d_out; a.ws = (unsigned char*)d_ws;
    if (MK_N_LAUNCHES == 1) {
        if (MK_SPLIT_AT >= 0) {
            a.ph_lo = 0; a.ph_hi = MK_SPLIT_AT + 1 + (MK_SPLIT_AT == 4 ? 1 : 0); a.li = 0; a.sub = 3;
            hipLaunchKernelGGL(mk_fwd, dim3(grid), dim3(NWAVES * 64), LDS_BYTES, stream, a);
            a.ph_lo = MK_SPLIT_AT; a.ph_hi = N_PHASES; a.li = 1; a.sub = MK_REPEAT_SUB;
            hipLaunchKernelGGL(mk_fwd, dim3(grid), dim3(NWAVES * 64), LDS_BYTES, stream, a);
            return;
        }
        a.ph_lo = 0; a.ph_hi = N_PHASES; a.li = 0; a.sub = 3;
        hipLaunchKernelGGL(mk_fwd, dim3(grid), dim3(NWAVES * 64), LDS_BYTES, stream, a);
    } else {
        for (int p = 0; p < N_PHASES; ++p) {
            if (p == 5) continue;
            a.ph_lo = p; a.ph_hi = (p == 4) ? 6 : p + 1; a.li = 0; a.sub = 3;
            hipLaunchKernelGGL(mk_fwd, dim3(grid), dim3(NWAVES * 64), LDS_BYTES, stream, a);
        }
    }
}
```
